# Optimizing an MI355X kernel written in HIP

```python
import math
import jax
import jax.numpy as jnp
from jax import lax
import numpy as np

D_MODEL = 1024
BATCH = 4
SEQ = 4096
DEPTH = 2

GRID_W = 64
CTX_LEN = 256
HEAD_DIM = 64
ATT_HEADS = 6
ATT_KV_HEADS = 2
ATT_W = ATT_HEADS * HEAD_DIM
ATT_KV_W = ATT_KV_HEADS * HEAD_DIM
ATT_WINDOW = 128
ATT_BLOCK = 128
ROPE_THETA = 10000.0
ROPE_FREQS = HEAD_DIM // 4
RWKV_HEADS = 4
RWKV_W = RWKV_HEADS * HEAD_DIM
RWKV_LORA = 64
RWKV_SHIFT_W = 3 * RWKV_W + 4 * RWKV_LORA
RWKV_GN_EPS = 64e-5
SSM_HEADS = 6
SSM_W = SSM_HEADS * HEAD_DIM
SSM_STATE = 128
SSM_GROUPS = 2
SSM_CONV = 3
SSM_CHUNK = 128
SSM_CONV_W = SSM_W + 2 * SSM_GROUPS * SSM_STATE
SSM_NORM_EPS = 1e-5
MIX_W = ATT_W + RWKV_W + SSM_W
IN_SIZES = (ATT_W, ATT_KV_W, ATT_KV_W, ATT_W, RWKV_SHIFT_W, RWKV_W, SSM_W, SSM_CONV_W, 2 * SSM_HEADS)
N_IN = sum(IN_SIZES)
NORM_EPS = 1e-6

kernel_name = 'hybrid_parallel_groups_diffusion_block'


def split_cols(h, sizes):
    return jnp.split(h, [int(i) for i in np.cumsum(sizes)[:-1]], axis=-1)


def to_heads(t):
    return t.reshape(t.shape[:-1] + (-1, HEAD_DIM))


def flip_time(ts):
    return tuple(jnp.flip(t, axis=1) for t in ts)


def rms_norm(x, w, eps=NORM_EPS):
    xf = x.astype(jnp.float32)
    y = xf * lax.rsqrt(jnp.mean(xf * xf, axis=-1, keepdims=True) + eps)
    return (y * w.astype(jnp.float32)).astype(x.dtype)


def axial_rope_tables(rows, dtype):
    row = jnp.repeat(jnp.arange(rows), GRID_W)
    col = jnp.tile(jnp.arange(GRID_W), rows)
    pos = jnp.stack([row, col], axis=-1).astype(jnp.float32)
    inv = ROPE_THETA ** (-jnp.arange(ROPE_FREQS, dtype=jnp.float32) / ROPE_FREQS)
    ang = pos[:, :, None] * inv
    return jnp.cos(ang).astype(dtype), jnp.sin(ang).astype(dtype)


def apply_axial_rope(u, cos, sin):
    shp = u.shape
    u = u.reshape(shp[:-1] + (2, 2, ROPE_FREQS))
    u0, u1 = u[..., 0, :], u[..., 1, :]
    cs, sn = cos[None, :, None], sin[None, :, None]
    return jnp.stack([u0 * cs - u1 * sn, u0 * sn + u1 * cs], axis=-2).reshape(shp)


def centred_shift(u, mu):
    prev = jnp.pad(u[:, :-1], ((0, 0), (1, 0), (0, 0)))
    nxt = jnp.pad(u[:, 1:], ((0, 0), (0, 1), (0, 0)))
    return u + mu[0] * (prev - u) + mu[1] * (nxt - u)


def centred_dwconv(u, w, b):
    k = w.shape[0]
    y = lax.conv_general_dilated(u, w[:, None, :], window_strides=(1,), padding=[(k // 2, k // 2)],
                                 dimension_numbers=('NWC', 'WIO', 'NWC'), feature_group_count=u.shape[-1])
    return y + b


def sink_softmax(logits, sink):
    sink_col = jnp.broadcast_to(sink.astype(jnp.float32).reshape(ATT_KV_HEADS, -1, 1, 1), logits.shape[:-1] + (1,))
    return jax.nn.softmax(jnp.concatenate([logits, sink_col], axis=-1), axis=-1)[..., :-1]


def windowed_attention(q, k, v, k_c, v_c, sink):
    bsz, t = q.shape[:2]
    nb = t // ATT_BLOCK
    span = 3 * ATT_BLOCK
    qb = q.reshape(bsz, nb, ATT_BLOCK, ATT_KV_HEADS, -1, HEAD_DIM)

    def band(u):
        up = jnp.pad(u, ((0, 0), (ATT_BLOCK, ATT_BLOCK), (0, 0), (0, 0)))
        up = up.reshape(bsz, nb + 2, ATT_BLOCK, ATT_KV_HEADS, HEAD_DIM)
        return jnp.concatenate([up[:, :-2], up[:, 1:-1], up[:, 2:]], axis=2)

    kb, vb = band(k), band(v)
    scale = HEAD_DIM ** -0.5
    s_loc = jnp.einsum('bnqhgd,bnshd->bnhgqs', qb, kb).astype(jnp.float32) * scale
    s_ctx = jnp.einsum('bnqhgd,bchd->bnhgqc', qb, k_c).astype(jnp.float32) * scale
    qi = jnp.arange(ATT_BLOCK)[:, None]
    kj = jnp.arange(span)[None, :]
    key_pos = jnp.arange(nb)[:, None, None] * ATT_BLOCK + kj - ATT_BLOCK
    valid = (jnp.abs(kj - ATT_BLOCK - qi) <= ATT_WINDOW) & (key_pos >= 0) & (key_pos < t)
    s_loc = jnp.where(valid[None, :, None, None], s_loc, -jnp.inf)
    p = sink_softmax(jnp.concatenate([s_loc, s_ctx], axis=-1), sink).astype(v.dtype)
    o = (jnp.einsum('bnhgqs,bnshd->bnqhgd', p[..., :span], vb)
         + jnp.einsum('bnhgqc,bchd->bnqhgd', p[..., span:], v_c))
    return o.reshape(bsz, t, ATT_W)


def context_attention(q_c, k_c, v_c, sink):
    bsz, lc = q_c.shape[:2]
    qg = q_c.reshape(bsz, lc, ATT_KV_HEADS, -1, HEAD_DIM)
    s = jnp.einsum('bqhgd,bshd->bhgqs', qg, k_c).astype(jnp.float32) * HEAD_DIM ** -0.5
    p = sink_softmax(s, sink).astype(v_c.dtype)
    return jnp.einsum('bhgqs,bshd->bqhgd', p, v_c).reshape(bsz, lc, ATT_W)


def attention_mixer(q, k, v, g, q_c, k_c, v_c, g_c, sink, cos, sin, ctx_out):
    bsz, t = q.shape[:2]
    q = apply_axial_rope(q.reshape(bsz, t, ATT_HEADS, HEAD_DIM), cos, sin)
    k = apply_axial_rope(k.reshape(bsz, t, ATT_KV_HEADS, HEAD_DIM), cos, sin)
    v = v.reshape(bsz, t, ATT_KV_HEADS, HEAD_DIM)
    k_c = k_c.reshape(bsz, -1, ATT_KV_HEADS, HEAD_DIM)
    v_c = v_c.reshape(bsz, -1, ATT_KV_HEADS, HEAD_DIM)
    o_lat = windowed_attention(q, k, v, k_c, v_c, sink) * jax.nn.silu(g)
    o_ctx = None
    if ctx_out:
        o_ctx = context_attention(q_c.reshape(bsz, -1, ATT_HEADS, HEAD_DIM), k_c, v_c, sink) * jax.nn.silu(g_c)
    return o_lat, o_ctx


def rwkv_scan_inputs(r, k, v, wd, ad, w0, w_up, a0, a_up, k_k, k_a):
    w_log = -jax.nn.softplus(-(w0 + jnp.tanh(wd) @ w_up)) - 0.5
    decay = jnp.exp(-jnp.exp(w_log))
    a = jax.nn.sigmoid(a0 + ad @ a_up)
    kk = to_heads(k * k_k)
    kk = kk / jnp.maximum(jnp.sqrt(jnp.sum(kk * kk, axis=-1, keepdims=True)), 1e-12)
    kd = k * (1.0 + (a - 1.0) * k_a)
    return to_heads(r), to_heads(decay), to_heads(kd), to_heads(v), kk, to_heads(a)


def rwkv7_scan(r, w, k, v, kk, a, s0):
    def step(s, inp):
        rt, wt, kt, vt, kkt, at = inp
        sa = jnp.einsum('bhvk,bhk->bhv', s, kkt)
        s = s * wt[:, :, None, :] - sa[..., None] * (kkt * at)[:, :, None, :] + vt[..., None] * kt[:, :, None, :]
        return s, jnp.einsum('bhvk,bhk->bhv', s, rt)

    xs = tuple(jnp.moveaxis(t, 1, 0) for t in (r, w, k, v, kk, a))
    s_final, y = lax.scan(step, s0, xs)
    return jnp.moveaxis(y, 0, 1), s_final


def rwkv_mixer(u_lat, g_lat, u_ctx, g_ctx, mu, w0, w_up, a0, a_up, k_k, k_a, r_k, ln_w, ln_b, ctx_out):
    streams = []
    for u in (u_ctx, u_lat):
        u = centred_shift(u, mu).astype(jnp.float32)
        streams.append(split_cols(u, (RWKV_W, RWKV_W, RWKV_W, 2 * RWKV_LORA, 2 * RWKV_LORA)))
    bsz = u_lat.shape[0]
    y_ctx, y_lat = 0.0, 0.0
    for d in range(2):
        lo = slice(d * RWKV_LORA, (d + 1) * RWKV_LORA)
        ins = [rwkv_scan_inputs(r, k, v, wd[..., lo], ad[..., lo], w0[d], w_up[d], a0[d], a_up[d], k_k[d], k_a[d])
               for r, k, v, wd, ad in streams]
        if d == 1:
            ins = [flip_time(s) for s in ins]
        s0 = jnp.zeros((bsz, RWKV_HEADS, HEAD_DIM, HEAD_DIM), jnp.float32)
        yc, s_ctx = rwkv7_scan(*ins[0], s0)
        yl, _ = rwkv7_scan(*ins[1], s_ctx)
        if d == 1:
            yc, yl = flip_time((yc, yl))
        y_ctx, y_lat = y_ctx + yc, y_lat + yl

    def finish(y, stream, g):
        r, k, v = (to_heads(t) for t in stream[:3])
        mean = jnp.mean(y, axis=-1, keepdims=True)
        var = jnp.mean(jnp.square(y - mean), axis=-1, keepdims=True)
        y = (y - mean) * lax.rsqrt(var + RWKV_GN_EPS)
        bonus = jnp.sum(r * k * r_k, axis=-1, keepdims=True) * v
        out = y.reshape(y.shape[:2] + (RWKV_W,)) * ln_w + ln_b + bonus.reshape(y.shape[:2] + (RWKV_W,))
        return out.astype(g.dtype) * jax.nn.silu(g)

    o_lat = finish(y_lat, streams[1], g_lat)
    o_ctx = finish(y_ctx, streams[0], g_ctx) if ctx_out else None
    return o_lat, o_ctx


def ssd_scan(x, dt, a_neg, b_mat, c_mat, s0):
    bsz, t, h, p = x.shape
    n = b_mat.shape[-1]
    nc, cl = t // SSM_CHUNK, SSM_CHUNK
    rep = h // b_mat.shape[2]
    bh = jnp.repeat(b_mat, rep, axis=2).reshape(bsz, nc, cl, h, n)
    ch = jnp.repeat(c_mat, rep, axis=2).reshape(bsz, nc, cl, h, n)
    xdt = (x * dt[..., None]).reshape(bsz, nc, cl, h, p)
    cum = jnp.cumsum((dt * a_neg).reshape(bsz, nc, cl, h), axis=2)
    idx = jnp.arange(cl)
    lower = (idx[:, None] >= idx[None, :])[None, None, :, :, None]
    decay = jnp.exp(jnp.where(lower, cum[:, :, :, None, :] - cum[:, :, None, :, :], -jnp.inf))
    scores = jnp.einsum('bcihn,bcjhn->bcijh', ch, bh) * decay
    y_diag = jnp.einsum('bcijh,bcjhp->bcihp', scores, xdt)
    tail = jnp.exp(cum[:, :, -1:, :] - cum)
    chunk_states = jnp.einsum('bcjhn,bcjh,bcjhp->bchpn', bh, tail, xdt)
    chunk_decay = jnp.exp(cum[:, :, -1, :])

    def step(s, inp):
        st, dec = inp
        return s * dec[:, :, None, None] + st, s

    s_final, prev = lax.scan(step, s0, (jnp.moveaxis(chunk_states, 1, 0), jnp.moveaxis(chunk_decay, 1, 0)))
    prev = jnp.moveaxis(prev, 0, 1)
    y_off = jnp.einsum('bcihn,bchpn->bcihp', ch, prev) * jnp.exp(cum)[..., None]
    return (y_diag + y_off).reshape(bsz, t, h, p), s_final


def ssd_mixer(z_lat, xbc_lat, dt_lat, z_ctx, xbc_ctx, dt_ctx, conv_w, conv_b, a_log, dt_bias, d_skip, norm_w,
              ctx_out):
    streams = []
    for xbc, dt in ((xbc_ctx, dt_ctx), (xbc_lat, dt_lat)):
        xbc = jax.nn.silu(centred_dwconv(xbc, conv_w, conv_b)).astype(jnp.float32)
        xs, bm, cm = split_cols(xbc, (SSM_W, SSM_GROUPS * SSM_STATE, SSM_GROUPS * SSM_STATE))
        bsz, t = xs.shape[:2]
        dtp = jax.nn.softplus(dt.astype(jnp.float32).reshape(bsz, t, 2, SSM_HEADS) + dt_bias)
        streams.append((to_heads(xs), bm.reshape(bsz, t, SSM_GROUPS, SSM_STATE),
                        cm.reshape(bsz, t, SSM_GROUPS, SSM_STATE), dtp))
    bsz = z_lat.shape[0]
    y_ctx, y_lat = 0.0, 0.0
    for d in range(2):
        a_neg = -jnp.exp(a_log[d].astype(jnp.float32))
        ins = [(xs, dtp[:, :, d], bm, cm) for xs, bm, cm, dtp in streams]
        if d == 1:
            ins = [flip_time(s) for s in ins]
        s0 = jnp.zeros((bsz, SSM_HEADS, HEAD_DIM, SSM_STATE), jnp.float32)
        yc, s_ctx = ssd_scan(ins[0][0], ins[0][1], a_neg, ins[0][2], ins[0][3], s0)
        yl, _ = ssd_scan(ins[1][0], ins[1][1], a_neg, ins[1][2], ins[1][3], s_ctx)
        if d == 1:
            yc, yl = flip_time((yc, yl))
        y_ctx, y_lat = y_ctx + yc, y_lat + yl

    def finish(y, xs, z):
        b_, t_ = y.shape[:2]
        y = (y + d_skip[:, None] * xs).reshape(b_, t_, SSM_W) * jax.nn.silu(z.astype(jnp.float32))
        yg = y.reshape(b_, t_, SSM_GROUPS, SSM_W // SSM_GROUPS)
        yg = yg * lax.rsqrt(jnp.mean(yg * yg, axis=-1, keepdims=True) + SSM_NORM_EPS)
        return (yg.reshape(b_, t_, SSM_W) * norm_w).astype(z.dtype)

    o_lat = finish(y_lat, streams[1][0], z_lat)
    o_ctx = finish(y_ctx, streams[0][0], z_ctx) if ctx_out else None
    return o_lat, o_ctx


def trunk_layer(x, ctx, c_act, cctx_act, cos, sin, ada_w, ada_b, norm_w, w_in, w_out, attn_sink,
                rwkv_mu, rwkv_w0, rwkv_w_up, rwkv_a0, rwkv_a_up, rwkv_k_k, rwkv_k_a, rwkv_r_k, rwkv_ln_w,
                rwkv_ln_b, ssm_conv_w, ssm_conv_b, ssm_a_log, ssm_dt_bias, ssm_d, ssm_norm_w, ctx_out):
    shift, scale, gate = jnp.split((c_act @ ada_w + ada_b)[:, None, :], 3, axis=-1)
    shift_c, scale_c, gate_c = jnp.split(cctx_act @ ada_w + ada_b, 3, axis=-1)
    h_lat = rms_norm(x, norm_w) * (1.0 + scale) + shift
    h_ctx = rms_norm(ctx, norm_w) * (1.0 + scale_c) + shift_c
    lat = split_cols(h_lat @ w_in, IN_SIZES)
    cx = split_cols(h_ctx @ w_in, IN_SIZES)
    att_lat, att_ctx = attention_mixer(lat[0], lat[1], lat[2], lat[3], cx[0], cx[1], cx[2], cx[3],
                                       attn_sink, cos, sin, ctx_out)
    rwkv_lat, rwkv_ctx = rwkv_mixer(lat[4], lat[5], cx[4], cx[5], rwkv_mu, rwkv_w0, rwkv_w_up, rwkv_a0,
                                    rwkv_a_up, rwkv_k_k, rwkv_k_a, rwkv_r_k, rwkv_ln_w, rwkv_ln_b, ctx_out)
    ssm_lat, ssm_ctx = ssd_mixer(lat[6], lat[7], lat[8], cx[6], cx[7], cx[8], ssm_conv_w, ssm_conv_b,
                                 ssm_a_log, ssm_dt_bias, ssm_d, ssm_norm_w, ctx_out)
    x = x + gate * (jnp.concatenate([att_lat, rwkv_lat, ssm_lat], axis=-1) @ w_out)
    if ctx_out:
        ctx = ctx + gate_c * (jnp.concatenate([att_ctx, rwkv_ctx, ssm_ctx], axis=-1) @ w_out)
    return x, ctx


def setup_inputs(seed: int = 0) -> dict:
    key = jax.random.key(seed)
    ks = iter(jax.random.split(key, 32))
    f32 = jnp.float32

    def nrm(shape, s):
        return jax.random.normal(next(ks), shape, f32) * s

    def uni(shape, lo, hi):
        return jax.random.uniform(next(ks), shape, f32, lo, hi)

    L = DEPTH
    x = nrm((BATCH, SEQ, D_MODEL), 1.0)
    c = nrm((BATCH, D_MODEL), 1.0)
    ctx = nrm((BATCH, CTX_LEN, D_MODEL), 1.0)
    c_ctx = nrm((D_MODEL,), 1.0)
    ada_w = nrm((L, D_MODEL, 3 * D_MODEL), 0.5 * D_MODEL ** -0.5)
    ada_b = nrm((L, 3 * D_MODEL), 0.02)
    norm_w = 1.0 + nrm((L, D_MODEL), 0.05)
    w_in = nrm((L, D_MODEL, N_IN), D_MODEL ** -0.5)
    w_out = nrm((L, MIX_W, D_MODEL), MIX_W ** -0.5)
    attn_sink = nrm((L, ATT_HEADS), 0.5)
    rwkv_mu = uni((L, 2, RWKV_SHIFT_W), 0.0, 0.5)
    rwkv_w0 = uni((L, 2, RWKV_W), -6.5, -1.5)
    rwkv_w_up = nrm((L, 2, RWKV_LORA, RWKV_W), 0.5 * RWKV_LORA ** -0.5)
    rwkv_a0 = nrm((L, 2, RWKV_W), 0.1)
    rwkv_a_up = nrm((L, 2, RWKV_LORA, RWKV_W), 0.5 * RWKV_LORA ** -0.5)
    rwkv_k_k = 0.85 + nrm((L, 2, RWKV_W), 0.05)
    rwkv_k_a = 1.0 + nrm((L, 2, RWKV_W), 0.05)
    rwkv_r_k = nrm((L, RWKV_HEADS, HEAD_DIM), 0.1)
    rwkv_ln_w = 1.0 + nrm((L, RWKV_W), 0.05)
    rwkv_ln_b = nrm((L, RWKV_W), 0.02)
    ssm_conv_w = nrm((L, SSM_CONV, SSM_CONV_W), SSM_CONV ** -0.5)
    ssm_conv_b = nrm((L, SSM_CONV_W), 0.02)
    ssm_a_log = jnp.log(uni((L, 2, SSM_HEADS), 1.0, 16.0))
    dt0 = jnp.exp(uni((L, 2, SSM_HEADS), math.log(1e-3), math.log(1e-1)))
    ssm_dt_bias = dt0 + jnp.log(-jnp.expm1(-dt0))
    ssm_d = 1.0 + nrm((L, SSM_HEADS), 0.1)
    ssm_norm_w = 1.0 + nrm((L, SSM_W), 0.05)
    final_norm_w = 1.0 + nrm((D_MODEL,), 0.05)
    return {'x': x, 'c': c, 'ctx': ctx, 'c_ctx': c_ctx, 'ada_w': ada_w, 'ada_b': ada_b, 'norm_w': norm_w,
            'w_in': w_in, 'w_out': w_out, 'attn_sink': attn_sink, 'rwkv_mu': rwkv_mu, 'rwkv_w0': rwkv_w0,
            'rwkv_w_up': rwkv_w_up, 'rwkv_a0': rwkv_a0, 'rwkv_a_up': rwkv_a_up, 'rwkv_k_k': rwkv_k_k,
            'rwkv_k_a': rwkv_k_a, 'rwkv_r_k': rwkv_r_k, 'rwkv_ln_w': rwkv_ln_w, 'rwkv_ln_b': rwkv_ln_b,
            'ssm_conv_w': ssm_conv_w, 'ssm_conv_b': ssm_conv_b, 'ssm_a_log': ssm_a_log,
            'ssm_dt_bias': ssm_dt_bias, 'ssm_d': ssm_d, 'ssm_norm_w': ssm_norm_w, 'final_norm_w': final_norm_w}


def reference(x, c, ctx, c_ctx, ada_w, ada_b, norm_w, w_in, w_out, attn_sink, rwkv_mu, rwkv_w0, rwkv_w_up,
              rwkv_a0, rwkv_a_up, rwkv_k_k, rwkv_k_a, rwkv_r_k, rwkv_ln_w, rwkv_ln_b, ssm_conv_w, ssm_conv_b,
              ssm_a_log, ssm_dt_bias, ssm_d, ssm_norm_w, final_norm_w):
    rows = x.shape[1] // GRID_W
    cos, sin = axial_rope_tables(rows, x.dtype)
    c_act = jax.nn.silu(c)
    cctx_act = jax.nn.silu(c_ctx)
    for i in range(DEPTH):
        x, ctx = trunk_layer(x, ctx, c_act, cctx_act, cos, sin, ada_w[i], ada_b[i], norm_w[i], w_in[i], w_out[i],
                             attn_sink[i], rwkv_mu[i], rwkv_w0[i], rwkv_w_up[i], rwkv_a0[i], rwkv_a_up[i],
                             rwkv_k_k[i], rwkv_k_a[i], rwkv_r_k[i], rwkv_ln_w[i], rwkv_ln_b[i], ssm_conv_w[i],
                             ssm_conv_b[i], ssm_a_log[i], ssm_dt_bias[i], ssm_d[i], ssm_norm_w[i],
                             ctx_out=(i < DEPTH - 1))
    return rms_norm(x, final_norm_w)
```

```cpp
#include <hip/hip_runtime.h>
#include <hip/hip_bf16.h>
#include <hip/hip_cooperative_groups.h>
#include <cstdio>
namespace cg = cooperative_groups;

#ifndef TEST_PH
#define TEST_PH -1
#endif
#ifndef ONE_LAUNCH
#define ONE_LAUNCH 0
#endif

typedef unsigned short bf16_t;
using bf16x8 = __attribute__((ext_vector_type(8))) short;
using f32x4 = __attribute__((ext_vector_type(4))) float;

#define TOK 17408
#define TPB 4352
#define NTHREADS 256
#define LDS_BYTES 76800
#define NPHASES 12
#ifndef LBW
#define LBW 2
#endif

struct Params {
  const float *x, *c, *ctx, *c_ctx, *ada_w, *ada_b, *norm_w, *w_in, *w_out, *attn_sink, *rwkv_mu, *rwkv_w0,
      *rwkv_w_up, *rwkv_a0, *rwkv_a_up, *rwkv_k_k, *rwkv_k_a, *rwkv_r_k, *rwkv_ln_w, *rwkv_ln_b, *ssm_conv_w,
      *ssm_conv_b, *ssm_a_log, *ssm_dt_bias, *ssm_d, *ssm_norm_w, *final_norm_w;
  float* out;
  bf16_t *WtIn, *WtOut, *WupT, *AupT;
  float *rope, *mod, *ctxcur;
  bf16_t *hbuf, *PA, *PR, *PG, *PS;
  float* yR;
  bf16_t* yS;
};

__device__ __forceinline__ float bf2f(bf16_t v) { return __uint_as_float(((unsigned)v) << 16); }
__device__ __forceinline__ bf16_t f2bf(float f) {
  unsigned u = __float_as_uint(f);
  u += 0x7fffu + ((u >> 16) & 1u);
  return (bf16_t)(u >> 16);
}
__device__ __forceinline__ unsigned pack2(float a, float b) { return (unsigned)f2bf(a) | ((unsigned)f2bf(b) << 16); }
__device__ __forceinline__ float sigmoidf_(float x) { return 1.f / (1.f + __expf(-x)); }
__device__ __forceinline__ float siluf_(float x) { return x / (1.f + __expf(-x)); }
__device__ __forceinline__ float softplusf_(float x) {
  if (x > 15.f) return x;
  float e = __expf(x);
  return (e < 0.01f) ? e * (1.f - e * (0.5f - e * 0.33333333f)) : __logf(1.f + e);
}
__device__ __forceinline__ float tanhf_(float x) {
  float e = __expf(2.f * x);
  return 1.f - 2.f / (e + 1.f);
}

template <int CTRL>
__device__ __forceinline__ float dppf(float x) {
  return __int_as_float(__builtin_amdgcn_update_dpp(0, __float_as_int(x), CTRL, 0xF, 0xF, true));
}
__device__ __forceinline__ float sum16(float x) {
  x += dppf<0xB1>(x);
  x += dppf<0x4E>(x);
  x += dppf<0x141>(x);
  x += dppf<0x140>(x);
  return x;
}
__device__ __forceinline__ float max16(float x) {
  x = fmaxf(x, dppf<0xB1>(x));
  x = fmaxf(x, dppf<0x4E>(x));
  x = fmaxf(x, dppf<0x141>(x));
  x = fmaxf(x, dppf<0x140>(x));
  return x;
}
__device__ __forceinline__ float sum64(float x) {
#pragma unroll
  for (int o = 32; o >= 1; o >>= 1) x += __shfl_xor(x, o);
  return x;
}
__device__ __forceinline__ float sum32(float x) {
#pragma unroll
  for (int o = 16; o >= 1; o >>= 1) x += __shfl_xor(x, o);
  return x;
}
__device__ __forceinline__ int launder(int x) { asm volatile("" : "+v"(x)); return x; }
#define MFMA(a, b, c) __builtin_amdgcn_mfma_f32_16x16x32_bf16(a, b, c, 0, 0, 0)

__device__ void transpose_tile(const float* __restrict__ W, int N, int Kdim, bf16_t* __restrict__ Wt, int k0, int n0,
                               unsigned char* smem) {
  float* T = (float*)smem;
  const int tid = launder(threadIdx.x);
#pragma unroll 4
  for (int it = 0; it < 16; ++it) {
    int kk = (tid >> 6) + 4 * it, nn = tid & 63, n = n0 + nn;
    T[kk * 65 + nn] = (n < N) ? W[(size_t)(k0 + kk) * N + n] : 0.f;
  }
  __syncthreads();
#pragma unroll
  for (int it = 0; it < 2; ++it) {
    int nn = (tid >> 3) + 32 * it, kc = tid & 7;
    uint4 o;
    o.x = pack2(T[(kc * 8 + 0) * 65 + nn], T[(kc * 8 + 1) * 65 + nn]);
    o.y = pack2(T[(kc * 8 + 2) * 65 + nn], T[(kc * 8 + 3) * 65 + nn]);
    o.z = pack2(T[(kc * 8 + 4) * 65 + nn], T[(kc * 8 + 5) * 65 + nn]);
    o.w = pack2(T[(kc * 8 + 6) * 65 + nn], T[(kc * 8 + 7) * 65 + nn]);
    *(uint4*)(Wt + (size_t)(n0 + nn) * Kdim + k0 + kc * 8) = o;
  }
  __syncthreads();
}

__device__ void sincos_d(double x, float& c, float& s) {
  double n = rint(x * 0.63661977236758134308);
  double r = x - n * 1.57079632679489661923;
  double r2 = r * r;
  double sn = r * (1.0 + r2 * (-1.0 / 6 + r2 * (1.0 / 120 + r2 * (-1.0 / 5040 + r2 * (1.0 / 362880 + r2 * (-1.0 / 39916800 + r2 * (1.0 / 6227020800.0)))))));
  double cs = 1.0 + r2 * (-0.5 + r2 * (1.0 / 24 + r2 * (-1.0 / 720 + r2 * (1.0 / 40320 + r2 * (-1.0 / 3628800 + r2 * (1.0 / 479001600.0 + r2 * (-1.0 / 87178291200.0)))))));
  int q = ((int)n) & 3;
  double co, so;
  if (q == 0) { co = cs; so = sn; }
  else if (q == 1) { co = -sn; so = cs; }
  else if (q == 2) { co = -cs; so = -sn; }
  else { co = sn; so = -cs; }
  c = (float)co;
  s = (float)so;
}

__device__ void phase_setup(const Params& p, unsigned char* smem) {
  const int T_WIN = 2 * 16 * 58, T_WOUT = 2 * 16 * 16, T_ADA = 2 * 96, T_MISC = 17;
  const int total = T_WIN + T_WOUT + T_ADA + T_MISC;
  const int tid = launder(threadIdx.x);
  for (int t = blockIdx.x; t < total; t += gridDim.x) {
    if (t < T_WIN) {
      int l = t / 928, r = t % 928, kt = r / 58, nt = r % 58;
      transpose_tile(p.w_in + (size_t)l * 1024 * 3596, 3596, 1024, p.WtIn + (size_t)l * 3712 * 1024, kt * 64, nt * 64, smem);
    } else if (t < T_WIN + T_WOUT) {
      int tt = t - T_WIN, l = tt / 256, r = tt % 256, kt = r / 16, nt = r % 16;
      transpose_tile(p.w_out + (size_t)l * 1024 * 1024, 1024, 1024, p.WtOut + (size_t)l * 1024 * 1024, kt * 64, nt * 64, smem);
    } else if (t < T_WIN + T_WOUT + T_ADA) {
      int tt = t - T_WIN - T_WOUT, l = tt / 96, n0 = (tt % 96) * 32;
      float* cact = (float*)smem;
      for (int i = tid; i < 5120; i += 256) {
        int j = i >> 10, k = i & 1023;
        float v = (j < 4) ? p.c[j * 1024 + k] : p.c_ctx[k];
        cact[i] = siluf_(v);
      }
      __syncthreads();
      int col = tid & 31, kg = tid >> 5;
      float a0 = 0, a1 = 0, a2 = 0, a3 = 0, a4 = 0;
      const float* wp = p.ada_w + ((size_t)l * 1024 + kg * 128) * 3072 + n0 + col;
#pragma unroll 8
      for (int k = 0; k < 128; ++k) {
        float w = wp[(size_t)k * 3072];
        int kk = kg * 128 + k;
        a0 += cact[kk] * w; a1 += cact[1024 + kk] * w; a2 += cact[2048 + kk] * w; a3 += cact[3072 + kk] * w; a4 += cact[4096 + kk] * w;
      }
      float* red = cact + 5120;
      red[(kg * 5 + 0) * 32 + col] = a0; red[(kg * 5 + 1) * 32 + col] = a1; red[(kg * 5 + 2) * 32 + col] = a2;
      red[(kg * 5 + 3) * 32 + col] = a3; red[(kg * 5 + 4) * 32 + col] = a4;
      __syncthreads();
      if (tid < 160) {
        int j = tid >> 5, cc = tid & 31;
        float s = 0;
#pragma unroll
        for (int g = 0; g < 8; ++g) s += red[(g * 5 + j) * 32 + cc];
        p.mod[(size_t)(l * 5 + j) * 3072 + n0 + cc] = s + p.ada_b[l * 3072 + n0 + cc];
      }
      __syncthreads();
    } else {
      int tt = t - T_WIN - T_WOUT - T_ADA;
      if (tt < 16) {
        for (int i = tid; i < 8192; i += 256) {
          int idx = tt * 8192 + i;
          int arr = idx >> 16, e = idx & 65535;
          int ld = e >> 14, rem = e & 16383, n = rem >> 6, k = rem & 63;
          const float* src = arr ? p.rwkv_a_up : p.rwkv_w_up;
          bf16_t* dst = arr ? p.AupT : p.WupT;
          dst[e] = f2bf(src[((size_t)ld * 64 + k) * 256 + n]);
        }
      } else {
        for (int i = tid; i < 1024; i += 256) {
          int pos = i >> 4, f = i & 15;
          double inv = exp2(-(double)f * (13.287712379549449 / 16.0));
          float inv32 = (float)inv;
          float c, s;
          sincos_d((double)((float)pos * inv32), c, s);
          p.rope[i * 2] = c;
          p.rope[i * 2 + 1] = s;
        }
      }
    }
  }
}

__device__ void phase_norm(const Params& p, int l) {
  const int tid = launder(threadIdx.x), lane = tid & 63, w = tid >> 6;
  for (int t = blockIdx.x; t < TOK / 4; t += gridDim.x) {
    int r = t * 4 + w, b = r / TPB, pp = r % TPB;
    const float* src;
    if (l == 0) src = (pp < 256) ? p.ctx + ((size_t)b * 256 + pp) * 1024 : p.x + ((size_t)b * 4096 + pp - 256) * 1024;
    else src = (pp < 256) ? p.ctxcur + ((size_t)b * 256 + pp) * 1024 : p.out + ((size_t)b * 4096 + pp - 256) * 1024;
    const float* md = p.mod + (size_t)(l * 5 + ((pp < 256) ? 4 : b)) * 3072;
    const float* nw = p.norm_w + l * 1024;
    float4 v[4];
    float ss = 0;
#pragma unroll
    for (int i = 0; i < 4; ++i) {
      v[i] = *(const float4*)(src + lane * 4 + 256 * i);
      ss += v[i].x * v[i].x + v[i].y * v[i].y + v[i].z * v[i].z + v[i].w * v[i].w;
    }
    ss = sum64(ss);
    float rstd = rsqrtf(ss * (1.f / 1024.f) + 1e-6f);
#pragma unroll
    for (int i = 0; i < 4; ++i) {
      int k = lane * 4 + 256 * i;
      float4 n4 = *(const float4*)(nw + k), sc = *(const float4*)(md + 1024 + k), sh = *(const float4*)(md + k);
      float h0 = v[i].x * rstd * n4.x * (1.f + sc.x) + sh.x;
      float h1 = v[i].y * rstd * n4.y * (1.f + sc.y) + sh.y;
      float h2 = v[i].z * rstd * n4.z * (1.f + sc.z) + sh.z;
      float h3 = v[i].w * rstd * n4.w * (1.f + sc.w) + sh.w;
      uint2 o;
      o.x = pack2(h0, h1);
      o.y = pack2(h2, h3);
      *(uint2*)(p.hbuf + (size_t)r * 1024 + k) = o;
    }
  }
}

__device__ void phase_final(const Params& p) {
  const int tid = launder(threadIdx.x), lane = tid & 63, w = tid >> 6;
  for (int t = blockIdx.x; t < 16384 / 4; t += gridDim.x) {
    int r = t * 4 + w;
    float* src = p.out + (size_t)r * 1024;
    float4 v[4];
    float ss = 0;
#pragma unroll
    for (int i = 0; i < 4; ++i) {
      v[i] = *(const float4*)(src + lane * 4 + 256 * i);
      ss += v[i].x * v[i].x + v[i].y * v[i].y + v[i].z * v[i].z + v[i].w * v[i].w;
    }
    ss = sum64(ss);
    float rstd = rsqrtf(ss * (1.f / 1024.f) + 1e-6f);
#pragma unroll
    for (int i = 0; i < 4; ++i) {
      int k = lane * 4 + 256 * i;
      float4 n4 = *(const float4*)(p.final_norm_w + k);
      float4 o;
      o.x = v[i].x * rstd * n4.x; o.y = v[i].y * rstd * n4.y; o.z = v[i].z * rstd * n4.z; o.w = v[i].w * rstd * n4.w;
      *(float4*)(src + k) = o;
    }
  }
}

template <int MODE>
__device__ void gemm_tile(const Params& p, int l, int mt_, int nt_, unsigned char* smem) {
  const bf16_t* A = p.hbuf;
  const bf16_t* Bt = (MODE == 0) ? p.WtIn + (size_t)l * 3712 * 1024 : p.WtOut + (size_t)l * 1024 * 1024;
  const int m0 = mt_ * 128, n0 = nt_ * 128;
  bf16_t* As = (bf16_t*)smem;
  bf16_t* Bs = As + 2 * 128 * 72;
  const int tid = launder(threadIdx.x), lane = tid & 63, w = tid >> 6, wr = w >> 1, wc = w & 1, fr = lane & 15, fq = lane >> 4;
  f32x4 acc[4][4];
#pragma unroll
  for (int i = 0; i < 4; ++i)
#pragma unroll
    for (int j = 0; j < 4; ++j) acc[i][j] = (f32x4){0.f, 0.f, 0.f, 0.f};
  uint4 ra[4], rb[4];
  const int lrow = tid >> 3, lkc = tid & 7;
  const bf16_t* Ag = A + (size_t)(m0 + lrow) * 1024 + lkc * 8;
  const bf16_t* Bg = Bt + (size_t)(n0 + lrow) * 1024 + lkc * 8;
#pragma unroll
  for (int i = 0; i < 4; ++i) {
    ra[i] = *(const uint4*)(Ag + (size_t)i * 32 * 1024);
    rb[i] = *(const uint4*)(Bg + (size_t)i * 32 * 1024);
  }
#pragma unroll
  for (int i = 0; i < 4; ++i) {
    *(uint4*)(As + (lrow + 32 * i) * 72 + lkc * 8) = ra[i];
    *(uint4*)(Bs + (lrow + 32 * i) * 72 + lkc * 8) = rb[i];
  }
  __syncthreads();
  for (int kt = 0; kt < 16; ++kt) {
    const int cur = kt & 1;
    if (kt + 1 < 16) {
#pragma unroll
      for (int i = 0; i < 4; ++i) {
        ra[i] = *(const uint4*)(Ag + (size_t)i * 32 * 1024 + (kt + 1) * 64);
        rb[i] = *(const uint4*)(Bg + (size_t)i * 32 * 1024 + (kt + 1) * 64);
      }
    }
    const bf16_t* Ac = As + cur * 128 * 72 + (wr * 64 + fr) * 72 + fq * 8;
    const bf16_t* Bc = Bs + cur * 128 * 72 + (wc * 64 + fr) * 72 + fq * 8;
#pragma unroll
    for (int ks = 0; ks < 2; ++ks) {
      bf16x8 a[4], b[4];
#pragma unroll
      for (int i = 0; i < 4; ++i) {
        a[i] = *(const bf16x8*)(Ac + i * 16 * 72 + ks * 32);
        b[i] = *(const bf16x8*)(Bc + i * 16 * 72 + ks * 32);
      }
#pragma unroll
      for (int i = 0; i < 4; ++i)
#pragma unroll
        for (int j = 0; j < 4; ++j) acc[i][j] = MFMA(a[i], b[j], acc[i][j]);
    }
    if (kt + 1 < 16) {
      const int nx = cur ^ 1;
#pragma unroll
      for (int i = 0; i < 4; ++i) {
        *(uint4*)(As + nx * 128 * 72 + (lrow + 32 * i) * 72 + lkc * 8) = ra[i];
        *(uint4*)(Bs + nx * 128 * 72 + (lrow + 32 * i) * 72 + lkc * 8) = rb[i];
      }
    }
    __syncthreads();
  }
  const int cbase = n0 + wc * 64;
  if (MODE == 0) {
    bf16_t* dst;
    int ld, coff;
    if (cbase < 1024) { dst = p.PA; ld = 1024; coff = cbase; }
    else if (cbase < 2048) { dst = p.PR; ld = 1024; coff = cbase - 1024; }
    else if (cbase < 2688) { dst = p.PG; ld = 640; coff = cbase - 2048; }
    else { dst = p.PS; ld = 912; coff = cbase - 2688; }
#pragma unroll
    for (int i = 0; i < 4; ++i) {
#pragma unroll
      for (int j = 0; j < 4; ++j) {
        const int r = m0 + wr * 64 + i * 16 + fq * 4 + j;
        const int pp = r % TPB;
        float v0 = acc[i][0][j], v1 = acc[i][1][j], v2 = acc[i][2][j], v3 = acc[i][3][j];
        if (cbase < 512 && pp >= 256) {
          const int tt = pp - 256, rp = tt >> 6, cp = tt & 63;
          const float2 cs0 = *(const float2*)(p.rope + (rp * 16 + fr) * 2);
          const float2 cs1 = *(const float2*)(p.rope + (cp * 16 + fr) * 2);
          float n0_ = v0 * cs0.x - v1 * cs0.y, n1_ = v0 * cs0.y + v1 * cs0.x;
          float n2_ = v2 * cs1.x - v3 * cs1.y, n3_ = v2 * cs1.y + v3 * cs1.x;
          v0 = n0_; v1 = n1_; v2 = n2_; v3 = n3_;
        }
        if (cbase < 384) { v0 *= 0.125f; v1 *= 0.125f; v2 *= 0.125f; v3 *= 0.125f; }
        bf16_t* o = dst + (size_t)r * ld + coff + fr;
        if (cbase + 64 <= 3596) {
          o[0] = f2bf(v0); o[16] = f2bf(v1); o[32] = f2bf(v2); o[48] = f2bf(v3);
        } else {
          if (cbase + fr < 3596) o[0] = f2bf(v0);
          if (cbase + 16 + fr < 3596) o[16] = f2bf(v1);
          if (cbase + 32 + fr < 3596) o[32] = f2bf(v2);
          if (cbase + 48 + fr < 3596) o[48] = f2bf(v3);
        }
      }
    }
  } else {
#pragma unroll
    for (int i = 0; i < 4; ++i) {
#pragma unroll
      for (int j = 0; j < 4; ++j) {
        const int r = m0 + wr * 64 + i * 16 + fq * 4 + j;
        const int b = r / TPB, pp = r % TPB;
        const bool isc = pp < 256;
        const float* gate = p.mod + (size_t)(l * 5 + (isc ? 4 : b)) * 3072 + 2048;
        const float* res;
        float* dstp;
        if (l == 0) {
          res = isc ? p.ctx + ((size_t)b * 256 + pp) * 1024 : p.x + ((size_t)b * 4096 + pp - 256) * 1024;
          dstp = isc ? p.ctxcur + ((size_t)b * 256 + pp) * 1024 : p.out + ((size_t)b * 4096 + pp - 256) * 1024;
        } else {
          res = p.out + ((size_t)b * 4096 + pp - 256) * 1024;
          dstp = p.out + ((size_t)b * 4096 + pp - 256) * 1024;
        }
#pragma unroll
        for (int nn = 0; nn < 4; ++nn) {
          const int n = cbase + nn * 16 + fr;
          dstp[n] = res[n] + gate[n] * acc[i][nn][j];
        }
      }
    }
  }
}

__device__ void phase_inproj(const Params& p, int l, unsigned char* smem) {
  for (int t = blockIdx.x; t < 136 * 29; t += gridDim.x) gemm_tile<0>(p, l, t / 29, t % 29, smem);
}
__device__ void phase_outproj(const Params& p, int l, unsigned char* smem) {
  for (int t = blockIdx.x; t < 136 * 8; t += gridDim.x) {
    int mt = t >> 3, nt = t & 7;
    if (l == 1 && (mt % 34) < 2) continue;
    gemm_tile<1>(p, l, mt, nt, smem);
  }
}

__device__ void rwkv_tile(const Params& p, int l, int tile, unsigned char* smem) {
  const int rg = tile & 3, h = (tile >> 2) & 3, b = (tile >> 4) & 3, d = tile >> 6;
  bf16_t* raw = (bf16_t*)smem;
  float* rec = (float*)(smem + 21760);
  bf16_t* Aw = (bf16_t*)rec;
  bf16_t* Aa = Aw + 32 * 72;
  float* ssq = (float*)(smem + 21760 + 49152);
  const int tid = launder(threadIdx.x), lane = tid & 63, w = tid >> 6, fr = lane & 15, fq = lane >> 4;
  const int row = rg * 16 + w * 4 + fq;
  const int c0 = fr * 4;
  const int ld2 = l * 2 + d;
  const bf16_t* wup = p.WupT + ((size_t)(ld2 * 256 + h * 64 + 16 * w + fr)) * 64;
  const bf16_t* aup = p.AupT + ((size_t)(ld2 * 256 + h * 64 + 16 * w + fr)) * 64;
  bf16x8 bw[2], ba[2];
#pragma unroll
  for (int ks = 0; ks < 2; ++ks) {
    bw[ks] = *(const bf16x8*)(wup + ks * 32 + fq * 8);
    ba[ks] = *(const bf16x8*)(aup + ks * 32 + fq * 8);
  }
  const int ch = h * 64 + 16 * w + fr;
  const float w0c = p.rwkv_w0[ld2 * 256 + ch], a0c = p.rwkv_a0[ld2 * 256 + ch];
  const float kkc = p.rwkv_k_k[ld2 * 256 + ch], kac = p.rwkv_k_a[ld2 * 256 + ch];
  const float* mu0 = p.rwkv_mu + (size_t)(l * 2 + 0) * 1024;
  const float* mu1 = p.rwkv_mu + (size_t)(l * 2 + 1) * 1024;
  const float m0r = mu0[ch], m1r = mu1[ch], m0k = mu0[256 + ch], m1k = mu1[256 + ch], m0v = mu0[512 + ch], m1v = mu1[512 + ch];
  const int ca = tid & 63;
  const float m0wd = mu0[768 + d * 64 + ca], m1wd = mu1[768 + d * 64 + ca];
  const float m0ad = mu0[896 + d * 64 + ca], m1ad = mu1[896 + d * 64 + ca];
  float s0 = 0.f, s1 = 0.f, s2 = 0.f, s3 = 0.f;
  const size_t rowbase = (size_t)b * TPB;
  uint4 pf[6];

  auto geom = [&](int cix, int& plo, int& slo, int& shi) {
    const int st0 = cix * 32;
    if (st0 < 256) { slo = 0; shi = 255; plo = (d == 0) ? st0 : 224 - st0; }
    else { slo = 256; shi = 4351; plo = (d == 0) ? st0 : 4576 - st0; }
  };
  const int pcc = tid % 40, prow = tid / 40;
  const bool pact = tid < 240;
  const int pcol = ((pcc >> 3) < 3) ? ((pcc >> 3) * 256 + h * 64 + (pcc & 7) * 8) : (768 + ((pcc >> 3) - 3) * 128 + d * 64 + (pcc & 7) * 8);
  const bf16_t* pbase = p.PR + rowbase * 1024 + pcol;
  bf16_t* sbase = raw + prow * 320 + pcc * 8;
  auto prefetch = [&](int cix) {
    int plo, slo, shi;
    geom(cix, plo, slo, shi);
#pragma unroll
    for (int i = 0; i < 6; ++i) {
      const int rr = prow + 6 * i;
      const int tr = plo - 1 + rr;
      pf[i] = make_uint4(0, 0, 0, 0);
      if (pact && rr < 34 && tr >= slo && tr <= shi) pf[i] = *(const uint4*)(pbase + (size_t)tr * 1024);
    }
  };
  auto stash = [&]() {
#pragma unroll
    for (int i = 0; i < 6; ++i) {
      if (pact && prow + 6 * i < 34) *(uint4*)(sbase + i * 6 * 320) = pf[i];
    }
  };
  prefetch(0);
  stash();
  __syncthreads();
  for (int cix = 0; cix < 136; ++cix) {
    int plo, slo, shi;
    geom(cix, plo, slo, shi);
    {
      const int rbase = (d == 0) ? 1 : 32, rsgn = (d == 0) ? 1 : -1;
#pragma unroll 2
      for (int it = 0; it < 8; ++it) {
        const int i = w + 4 * it;
        const bf16_t* r0 = raw + (rbase + rsgn * i) * 320 + ca;
        float u = bf2f(r0[192]), up = bf2f(r0[192 - 320]), un = bf2f(r0[192 + 320]);
        Aw[i * 72 + ca] = f2bf(tanhf_(u + m0wd * (up - u) + m1wd * (un - u)));
        u = bf2f(r0[256]); up = bf2f(r0[256 - 320]); un = bf2f(r0[256 + 320]);
        Aa[i * 72 + ca] = f2bf(u + m0ad * (up - u) + m1ad * (un - u));
      }
    }
    __syncthreads();
    f32x4 accw[2], acca[2];
#pragma unroll
    for (int mt = 0; mt < 2; ++mt) {
      accw[mt] = (f32x4){0.f, 0.f, 0.f, 0.f};
      acca[mt] = (f32x4){0.f, 0.f, 0.f, 0.f};
#pragma unroll
      for (int ks = 0; ks < 2; ++ks) {
        bf16x8 a1 = *(const bf16x8*)(Aw + (mt * 16 + fr) * 72 + ks * 32 + fq * 8);
        bf16x8 a2 = *(const bf16x8*)(Aa + (mt * 16 + fr) * 72 + ks * 32 + fq * 8);
        accw[mt] = MFMA(a1, bw[ks], accw[mt]);
        acca[mt] = MFMA(a2, ba[ks], acca[mt]);
      }
    }
    const int cc = 16 * w + fr;
#pragma unroll
    for (int e = 0; e < 8; ++e) {
      const int i = (e >> 2) * 16 + fq * 4 + (e & 3);
      const int ri = (d == 0) ? i + 1 : 32 - i;
      const bf16_t* r0 = raw + ri * 320 + cc;
      const float u = bf2f(r0[64]), up = bf2f(r0[64 - 320]), un = bf2f(r0[64 + 320]);
      const float kq = (u + m0k * (up - u) + m1k * (un - u)) * kkc;
      const float q = sum16(kq * kq);
      if (fr == 0) ssq[w * 32 + i] = q;
      if (e & 1) __builtin_amdgcn_sched_barrier(0);
    }
    __syncthreads();
#pragma unroll
    for (int e = 0; e < 8; ++e) {
      const int i = (e >> 2) * 16 + fq * 4 + (e & 3);
      const int ri = (d == 0) ? i + 1 : 32 - i;
      const bf16_t* r0 = raw + ri * 320 + cc;
      float u, up, un;
      u = bf2f(r0[0]); up = bf2f(r0[-320]); un = bf2f(r0[320]);
      const float rs = u + m0r * (up - u) + m1r * (un - u);
      u = bf2f(r0[64]); up = bf2f(r0[64 - 320]); un = bf2f(r0[64 + 320]);
      const float ksv = u + m0k * (up - u) + m1k * (un - u);
      u = bf2f(r0[128]); up = bf2f(r0[128 - 320]); un = bf2f(r0[128 + 320]);
      const float vs = u + m0v * (up - u) + m1v * (un - u);
      const float tot = ssq[i] + ssq[32 + i] + ssq[64 + i] + ssq[96 + i];
      const float inv = 1.f / fmaxf(sqrtf(tot), 1e-12f);
      const float xw = w0c + accw[e >> 2][e & 3];
      const float ew = 0.6065306597f / (1.f + __expf(-xw));
      const float decay = __expf(-ew);
      const float a = sigmoidf_(a0c + acca[e >> 2][e & 3]);
      const float kk = ksv * kkc * inv;
      float* rp = rec + i * 384 + cc;
      rp[0] = decay;
      rp[64] = kk;
      rp[128] = kk * a;
      rp[192] = ksv * (1.f + (a - 1.f) * kac);
      rp[256] = rs;
      rp[320] = vs;
      if (e & 1) __builtin_amdgcn_sched_barrier(0);
    }
    __syncthreads();
    if (cix + 1 < 136) prefetch(cix + 1);
    float ykeep = 0.f;
#pragma unroll 2
    for (int i = 0; i < 32; ++i) {
      const float* rp = rec + i * 384;
      const float4 w4 = *(const float4*)(rp + c0);
      const float4 kk4 = *(const float4*)(rp + 64 + c0);
      const float4 kb4 = *(const float4*)(rp + 128 + c0);
      const float4 kd4 = *(const float4*)(rp + 192 + c0);
      const float4 r4 = *(const float4*)(rp + 256 + c0);
      const float v = rp[320 + row];
      float sa = s0 * kk4.x + s1 * kk4.y + s2 * kk4.z + s3 * kk4.w;
      sa = sum16(sa);
      s0 = s0 * w4.x + (v * kd4.x - sa * kb4.x);
      s1 = s1 * w4.y + (v * kd4.y - sa * kb4.y);
      s2 = s2 * w4.z + (v * kd4.z - sa * kb4.z);
      s3 = s3 * w4.w + (v * kd4.w - sa * kb4.w);
      float y = s0 * r4.x + s1 * r4.y + s2 * r4.z + s3 * r4.w;
      y = sum16(y);
      if (fr == (i & 15)) ykeep = y;
      if ((i & 15) == 15) {
        const int ii = (i & 16) + fr;
        const int ri = (d == 0) ? ii + 1 : 32 - ii;
        const int pi = plo - 1 + ri;
        p.yR[((size_t)d * TOK + rowbase + pi) * 256 + h * 64 + row] = ykeep;
      }
    }
    if (cix + 1 < 136) stash();
    __syncthreads();
  }
}

__device__ void ssd_tile(const Params& p, int l, int tile, unsigned char* smem) {
  const int h = tile % 6, b = (tile / 6) & 3, d = tile / 24, g = h / 3;
  bf16_t* raw = (bf16_t*)smem;
  bf16_t* Cs = raw + 34 * 320;
  bf16_t* Bs = Cs + 32 * 136;
  bf16_t* BtT = Bs + 32 * 136;
  bf16_t* XdT = BtT + 128 * 40;
  bf16_t* Ms = XdT + 64 * 40;
  bf16_t* Sb = Ms + 32 * 40;
  float* cums = (float*)(Sb + 64 * 136);
  float* dts = cums + 32;
  const int tid = launder(threadIdx.x), lane = tid & 63, w = tid >> 6, fr = lane & 15, fq = lane >> 4;
  const size_t rowbase = (size_t)b * TPB;
  const float a_neg = -__expf(p.ssm_a_log[(l * 2 + d) * 6 + h]);
  const float dtb = p.ssm_dt_bias[(l * 2 + d) * 6 + h];
  auto pscol = [&](int col) { return (col < 64) ? (h * 64 + col) : ((col < 192) ? (384 + g * 128 + col - 64) : (640 + g * 128 + col - 192)); };
  const int colA = tid, colB = 256 + (tid & 63);
  const int pcA = pscol(colA), pcB = pscol(colB);
  const float* cw = p.ssm_conv_w + (size_t)l * 3 * 896;
  const float* cb = p.ssm_conv_b + (size_t)l * 896;
  const float wA0 = cw[pcA], wA1 = cw[896 + pcA], wA2 = cw[1792 + pcA], bA = cb[pcA];
  const float wB0 = cw[pcB], wB1 = cw[896 + pcB], wB2 = cw[1792 + pcB], bB = cb[pcB];
  f32x4 S[4][2];
#pragma unroll
  for (int i = 0; i < 4; ++i)
#pragma unroll
    for (int j = 0; j < 2; ++j) S[i][j] = (f32x4){0.f, 0.f, 0.f, 0.f};
  uint4 pf[6];
  float dtraw = 0.f;
  auto geom = [&](int cix, int& plo, int& slo, int& shi) {
    const int st0 = cix * 32;
    if (st0 < 256) { slo = 0; shi = 255; plo = (d == 0) ? st0 : 224 - st0; }
    else { slo = 256; shi = 4351; plo = (d == 0) ? st0 : 4576 - st0; }
  };
  const int pcc = tid % 40, prow = tid / 40;
  const bool pact = tid < 240;
  const int pcol = (pcc < 8) ? (h * 64 + pcc * 8) : ((pcc < 24) ? (384 + g * 128 + (pcc - 8) * 8) : (640 + g * 128 + (pcc - 24) * 8));
  const bf16_t* pbase = p.PS + rowbase * 912 + pcol;
  bf16_t* sbase = raw + prow * 320 + pcc * 8;
  const bf16_t* dtbase = p.PS + rowbase * 912 + 896 + d * 6 + h;
  auto prefetch = [&](int cix) {
    int plo, slo, shi;
    geom(cix, plo, slo, shi);
#pragma unroll
    for (int i = 0; i < 6; ++i) {
      const int rr = prow + 6 * i;
      const int tr = plo - 1 + rr;
      pf[i] = make_uint4(0, 0, 0, 0);
      if (pact && rr < 34 && tr >= slo && tr <= shi) pf[i] = *(const uint4*)(pbase + (size_t)tr * 912);
    }
    if (tid < 32) {
      const int ri = (d == 0) ? tid + 1 : 32 - tid;
      dtraw = bf2f(dtbase[(size_t)(plo - 1 + ri) * 912]);
    }
  };
  auto stash = [&]() {
#pragma unroll
    for (int i = 0; i < 6; ++i) {
      if (pact && prow + 6 * i < 34) *(uint4*)(sbase + i * 6 * 320) = pf[i];
    }
  };
  prefetch(0);
  stash();
  __syncthreads();
  for (int cix = 0; cix < 136; ++cix) {
    int plo, slo, shi;
    geom(cix, plo, slo, shi);
    if (w == 0) {
      float dt = (lane < 32) ? softplusf_(dtraw + dtb) : 0.f;
      float a = dt * a_neg;
#pragma unroll
      for (int o = 1; o < 32; o <<= 1) {
        float t = __shfl_up(a, o);
        if (lane >= o) a += t;
      }
      if (lane < 32) { dts[lane] = dt; cums[lane] = a; }
    }
    __syncthreads();
    {
      const float cl = cums[31];
      {
        float um = bf2f(raw[0 * 320 + colA]), u0 = bf2f(raw[1 * 320 + colA]);
#pragma unroll 2
        for (int ri = 1; ri <= 32; ++ri) {
          const float up = bf2f(raw[(ri + 1) * 320 + colA]);
          const float v = siluf_(wA0 * um + wA1 * u0 + wA2 * up + bA);
          const int i = (d == 0) ? ri - 1 : 32 - ri;
          if (colA < 64) XdT[colA * 40 + i] = f2bf(v * dts[i]);
          else if (colA < 192) {
            Bs[i * 136 + colA - 64] = f2bf(v);
            BtT[(colA - 64) * 40 + i] = f2bf(v * __expf(cl - cums[i]));
          } else Cs[i * 136 + colA - 192] = f2bf(v);
          um = u0; u0 = up;
        }
      }
      {
        const int rlo = 8 * w + 1;
        float um = bf2f(raw[(rlo - 1) * 320 + colB]), u0 = bf2f(raw[rlo * 320 + colB]);
#pragma unroll 2
        for (int ri = rlo; ri < rlo + 8; ++ri) {
          const float up = bf2f(raw[(ri + 1) * 320 + colB]);
          const float v = siluf_(wB0 * um + wB1 * u0 + wB2 * up + bB);
          const int i = (d == 0) ? ri - 1 : 32 - ri;
          Cs[i * 136 + colB - 192] = f2bf(v);
          um = u0; u0 = up;
        }
      }
#pragma unroll
      for (int mt = 0; mt < 4; ++mt)
#pragma unroll
        for (int t = 0; t < 2; ++t)
#pragma unroll
          for (int j = 0; j < 4; ++j) Sb[(mt * 16 + fq * 4 + j) * 136 + (2 * w + t) * 16 + fr] = f2bf(S[mt][t][j]);
    }
    __syncthreads();
    {
      const int mi = w >> 1, nj = w & 1;
      f32x4 acc = (f32x4){0.f, 0.f, 0.f, 0.f};
#pragma unroll
      for (int ks = 0; ks < 4; ++ks) {
        bf16x8 a = *(const bf16x8*)(Cs + (mi * 16 + fr) * 136 + ks * 32 + fq * 8);
        bf16x8 bb = *(const bf16x8*)(Bs + (nj * 16 + fr) * 136 + ks * 32 + fq * 8);
        acc = MFMA(a, bb, acc);
      }
      const int jj = nj * 16 + fr;
      const float cj = cums[jj];
#pragma unroll
      for (int j = 0; j < 4; ++j) {
        const int i = mi * 16 + fq * 4 + j;
        const float v = (jj <= i) ? acc[j] * __expf(cums[i] - cj) : 0.f;
        Ms[i * 40 + jj] = f2bf(v);
      }
    }
    __syncthreads();
    if (cix + 1 < 136) prefetch(cix + 1);
    {
      const int mi = w >> 1;
      bf16x8 am = *(const bf16x8*)(Ms + (mi * 16 + fr) * 40 + fq * 8);
      bf16x8 ac[4];
#pragma unroll
      for (int ks = 0; ks < 4; ++ks) ac[ks] = *(const bf16x8*)(Cs + (mi * 16 + fr) * 136 + ks * 32 + fq * 8);
#pragma unroll
      for (int t = 0; t < 2; ++t) {
        const int pt = 2 * (w & 1) + t;
        f32x4 y1 = (f32x4){0.f, 0.f, 0.f, 0.f}, y2 = (f32x4){0.f, 0.f, 0.f, 0.f};
        bf16x8 bx = *(const bf16x8*)(XdT + (pt * 16 + fr) * 40 + fq * 8);
        y1 = MFMA(am, bx, y1);
#pragma unroll
        for (int ks = 0; ks < 4; ++ks) {
          bf16x8 bs = *(const bf16x8*)(Sb + (pt * 16 + fr) * 136 + ks * 32 + fq * 8);
          y2 = MFMA(ac[ks], bs, y2);
        }
#pragma unroll
        for (int j = 0; j < 4; ++j) {
          const int i = mi * 16 + fq * 4 + j;
          const int ri = (d == 0) ? i + 1 : 32 - i;
          const int pi = plo - 1 + ri;
          const float y = y1[j] + __expf(cums[i]) * y2[j];
          p.yS[((size_t)d * TOK + rowbase + pi) * 384 + h * 64 + pt * 16 + fr] = f2bf(y);
        }
      }
    }
    {
      const float dec = __expf(cums[31]);
      bf16x8 bt[2];
#pragma unroll
      for (int t = 0; t < 2; ++t) bt[t] = *(const bf16x8*)(BtT + ((2 * w + t) * 16 + fr) * 40 + fq * 8);
#pragma unroll
      for (int mt = 0; mt < 4; ++mt) {
        bf16x8 ax = *(const bf16x8*)(XdT + (mt * 16 + fr) * 40 + fq * 8);
#pragma unroll
        for (int t = 0; t < 2; ++t) {
          S[mt][t] *= dec;
          S[mt][t] = MFMA(ax, bt[t], S[mt][t]);
        }
      }
    }
    if (cix + 1 < 136) stash();
    __syncthreads();
  }
}

__device__ void attn_tile(const Params& p, int l, int tile, unsigned char* smem) {
  const bool isctx = tile >= 768;
  int qt, head, b;
  if (!isctx) { qt = tile & 31; head = (tile >> 5) % 6; b = tile / 192; }
  else { int tt = tile - 768; qt = tt & 1; head = (tt >> 1) % 6; b = tt / 12; }
  const int hkv = head / 3;
  const int tid = launder(threadIdx.x), lane = tid & 63, w = tid >> 6, fr = lane & 15, fq = lane >> 4;
  bf16_t* Ks = (bf16_t*)smem;
  bf16_t* Vt = Ks + 64 * 72;
  bf16_t* Ps = Vt + 64 * 72 + w * 32 * 72;
  const int q0 = qt * 128;
  const size_t rowb = (size_t)b * TPB;
  const size_t rowq0 = rowb + (isctx ? q0 : 256 + q0);
  bf16x8 qf[2][2];
  float m[2][4], ls[2][4];
  f32x4 o[2][4];
  const float sk = p.attn_sink[l * 6 + head];
#pragma unroll
  for (int mt = 0; mt < 2; ++mt) {
    const int qi0 = (2 * w + mt) * 16;
#pragma unroll
    for (int ks = 0; ks < 2; ++ks) qf[mt][ks] = *(const bf16x8*)(p.PA + (rowq0 + qi0 + fr) * 1024 + head * 64 + ks * 32 + fq * 8);
#pragma unroll
    for (int j = 0; j < 4; ++j) { m[mt][j] = sk; ls[mt][j] = 1.f; }
#pragma unroll
    for (int nt = 0; nt < 4; ++nt) o[mt][nt] = (f32x4){0.f, 0.f, 0.f, 0.f};
  }
  int klo = 0, nb = 0;
  if (!isctx) {
    klo = max(0, q0 - 128);
    const int khi = min(4096, q0 + 256);
    nb = (khi - klo) >> 6;
  }
  const int ntile = nb + 4;
  const int lr = tid >> 3, lc = tid & 7;
  uint4 kr0, kr1, vr0, vr1;
#define KVLOAD(kt_)                                                                              \
  {                                                                                              \
    const size_t kr0_ = ((kt_) < nb) ? rowb + 256 + klo + (kt_) * 64 : rowb + ((kt_) - nb) * 64; \
    const bf16_t* src0 = p.PA + (kr0_ + lr) * 1024 + 384 + hkv * 64 + lc * 8;                    \
    const bf16_t* src1 = src0 + 32 * 1024;                                                       \
    kr0 = *(const uint4*)src0;                                                                   \
    vr0 = *(const uint4*)(src0 + 128);                                                           \
    kr1 = *(const uint4*)src1;                                                                   \
    vr1 = *(const uint4*)(src1 + 128);                                                           \
  }
#define VTSTORE(vr_, rr_)                                                 \
  {                                                                       \
    Vt[(lc * 8 + 0) * 72 + (rr_)] = (bf16_t)((vr_).x & 0xffffu);          \
    Vt[(lc * 8 + 1) * 72 + (rr_)] = (bf16_t)((vr_).x >> 16);              \
    Vt[(lc * 8 + 2) * 72 + (rr_)] = (bf16_t)((vr_).y & 0xffffu);          \
    Vt[(lc * 8 + 3) * 72 + (rr_)] = (bf16_t)((vr_).y >> 16);              \
    Vt[(lc * 8 + 4) * 72 + (rr_)] = (bf16_t)((vr_).z & 0xffffu);          \
    Vt[(lc * 8 + 5) * 72 + (rr_)] = (bf16_t)((vr_).z >> 16);              \
    Vt[(lc * 8 + 6) * 72 + (rr_)] = (bf16_t)((vr_).w & 0xffffu);          \
    Vt[(lc * 8 + 7) * 72 + (rr_)] = (bf16_t)((vr_).w >> 16);              \
  }
  KVLOAD(0);
  for (int kt = 0; kt < ntile; ++kt) {
    __syncthreads();
    *(uint4*)(Ks + lr * 72 + lc * 8) = kr0;
    *(uint4*)(Ks + (lr + 32) * 72 + lc * 8) = kr1;
    VTSTORE(vr0, lr);
    VTSTORE(vr1, lr + 32);
    __syncthreads();
    if (kt + 1 < ntile) KVLOAD(kt + 1);
    f32x4 s[2][4];
#pragma unroll
    for (int mt = 0; mt < 2; ++mt)
#pragma unroll
      for (int nt = 0; nt < 4; ++nt) s[mt][nt] = (f32x4){0.f, 0.f, 0.f, 0.f};
#pragma unroll
    for (int ks = 0; ks < 2; ++ks) {
#pragma unroll
      for (int nt = 0; nt < 4; ++nt) {
        bf16x8 kb = *(const bf16x8*)(Ks + (nt * 16 + fr) * 72 + ks * 32 + fq * 8);
#pragma unroll
        for (int mt = 0; mt < 2; ++mt) s[mt][nt] = MFMA(qf[mt][ks], kb, s[mt][nt]);
      }
    }
    const bool band = kt < nb;
    const int kp0 = klo + kt * 64 + fr;
#pragma unroll
    for (int mt = 0; mt < 2; ++mt) {
      const int qi0 = (2 * w + mt) * 16;
#pragma unroll
      for (int j = 0; j < 4; ++j) {
        const int qp = q0 + qi0 + fq * 4 + j;
        float sv0 = s[mt][0][j], sv1 = s[mt][1][j], sv2 = s[mt][2][j], sv3 = s[mt][3][j];
        if (band) {
          const int dlt = qp - kp0;
          if (dlt > 128 || dlt < -128) sv0 = -INFINITY;
          if (dlt - 16 > 128 || dlt - 16 < -128) sv1 = -INFINITY;
          if (dlt - 32 > 128 || dlt - 32 < -128) sv2 = -INFINITY;
          if (dlt - 48 > 128 || dlt - 48 < -128) sv3 = -INFINITY;
        }
        float mx = fmaxf(fmaxf(sv0, sv1), fmaxf(sv2, sv3));
        mx = max16(mx);
        const float mn = fmaxf(m[mt][j], mx);
        const float alpha = __expf(m[mt][j] - mn);
        const float p0 = __expf(sv0 - mn), p1 = __expf(sv1 - mn), p2 = __expf(sv2 - mn), p3 = __expf(sv3 - mn);
        bf16_t* pr = Ps + (mt * 16 + fq * 4 + j) * 72 + fr;
        pr[0] = f2bf(p0); pr[16] = f2bf(p1); pr[32] = f2bf(p2); pr[48] = f2bf(p3);
        const float rsum = sum16(p0 + p1 + p2 + p3);
        ls[mt][j] = ls[mt][j] * alpha + rsum;
        m[mt][j] = mn;
#pragma unroll
        for (int nt = 0; nt < 4; ++nt) o[mt][nt][j] *= alpha;
      }
    }
    __builtin_amdgcn_wave_barrier();
#pragma unroll
    for (int ks = 0; ks < 2; ++ks) {
      bf16x8 pa[2];
#pragma unroll
      for (int mt = 0; mt < 2; ++mt) pa[mt] = *(const bf16x8*)(Ps + (mt * 16 + fr) * 72 + ks * 32 + fq * 8);
#pragma unroll
      for (int nt = 0; nt < 4; ++nt) {
        bf16x8 vb = *(const bf16x8*)(Vt + (nt * 16 + fr) * 72 + ks * 32 + fq * 8);
#pragma unroll
        for (int mt = 0; mt < 2; ++mt) o[mt][nt] = MFMA(pa[mt], vb, o[mt][nt]);
      }
    }
    __builtin_amdgcn_wave_barrier();
  }
#pragma unroll
  for (int mt = 0; mt < 2; ++mt) {
    const int qi0 = (2 * w + mt) * 16;
#pragma unroll
    for (int j = 0; j < 4; ++j) {
      const size_t r = rowq0 + qi0 + fq * 4 + j;
      const float inv = 1.f / ls[mt][j];
#pragma unroll
      for (int nt = 0; nt < 4; ++nt) {
        const int dc = nt * 16 + fr;
        const float gt = bf2f(p.PA[r * 1024 + 640 + head * 64 + dc]);
        p.PA[r * 1024 + head * 64 + dc] = f2bf(o[mt][nt][j] * inv * siluf_(gt));
      }
    }
  }
  __syncthreads();
}

__device__ void phase_mixers(const Params& p, int l, unsigned char* smem) {
  const int natt = (l == 0) ? 816 : 768;
  const int bid = blockIdx.x, G = gridDim.x;
  const int total = 176 + natt;
  int t = bid, stride = G;
  if (G >= 208) stride = (bid < 176) ? total : G - 176;
  for (; t < total; t += stride) {
    if (t < 128) { if (TEST_PH < 7 || TEST_PH == 7) rwkv_tile(p, l, t, smem); }
    else if (t < 176) { if (TEST_PH < 7 || TEST_PH == 8) ssd_tile(p, l, t - 128, smem); }
    else { if (TEST_PH < 7 || TEST_PH == 9) attn_tile(p, l, t - 176, smem); }
  }
}

__device__ void phase_finish(const Params& p, int l) {
  const int tid = launder(threadIdx.x), lane = tid & 63, w = tid >> 6;
  bf16_t* mix = p.hbuf;
  for (int t = blockIdx.x; t < TOK / 4; t += gridDim.x) {
    const int r = t * 4 + w, pp = r % TPB;
    if (l == 1 && pp < 256) continue;
    const bool isc = pp < 256;
    const int slo = isc ? 0 : 256, shi = isc ? 255 : 4351;
    const bool hp = pp > slo, hn = pp < shi;
    {
      const bf16_t* s = p.PA + (size_t)r * 1024 + lane * 6;
      bf16_t* dd = mix + (size_t)r * 1024 + lane * 6;
      const unsigned* s32 = (const unsigned*)s;
      unsigned* d32 = (unsigned*)dd;
      d32[0] = s32[0]; d32[1] = s32[1]; d32[2] = s32[2];
    }
    {
      const int cg_ = lane * 4, hh = lane >> 4;
      const float4 ya = *(const float4*)(p.yR + (size_t)r * 256 + cg_);
      const float4 yb = *(const float4*)(p.yR + ((size_t)TOK + r) * 256 + cg_);
      float y[4] = {ya.x + yb.x, ya.y + yb.y, ya.z + yb.z, ya.w + yb.w};
      float sm = y[0] + y[1] + y[2] + y[3];
      sm = sum16(sm);
      const float mean = sm * (1.f / 64.f);
      float vq = 0.f;
#pragma unroll
      for (int e = 0; e < 4; ++e) { y[e] -= mean; vq += y[e] * y[e]; }
      vq = sum16(vq);
      const float rstd = rsqrtf(vq * (1.f / 64.f) + 64e-5f);
      const float* mu0 = p.rwkv_mu + (size_t)(l * 2) * 1024;
      const float* mu1 = mu0 + 1024;
      const bf16_t* pr = p.PR + (size_t)r * 1024;
      float rsv[4], ksv[4], vsv[4];
      float dot = 0.f;
#pragma unroll
      for (int e = 0; e < 4; ++e) {
        const int c = cg_ + e;
        float u, up, un;
        u = bf2f(pr[c]); up = hp ? bf2f(pr[c - 1024]) : 0.f; un = hn ? bf2f(pr[c + 1024]) : 0.f;
        rsv[e] = u + mu0[c] * (up - u) + mu1[c] * (un - u);
        u = bf2f(pr[256 + c]); up = hp ? bf2f(pr[256 + c - 1024]) : 0.f; un = hn ? bf2f(pr[256 + c + 1024]) : 0.f;
        ksv[e] = u + mu0[256 + c] * (up - u) + mu1[256 + c] * (un - u);
        u = bf2f(pr[512 + c]); up = hp ? bf2f(pr[512 + c - 1024]) : 0.f; un = hn ? bf2f(pr[512 + c + 1024]) : 0.f;
        vsv[e] = u + mu0[512 + c] * (up - u) + mu1[512 + c] * (un - u);
        dot += rsv[e] * ksv[e] * p.rwkv_r_k[l * 256 + hh * 64 + (c & 63)];
      }
      dot = sum16(dot);
      float o4[4];
#pragma unroll
      for (int e = 0; e < 4; ++e) {
        const int c = cg_ + e;
        const float gt = bf2f(p.PG[(size_t)r * 640 + c]);
        o4[e] = (y[e] * rstd * p.rwkv_ln_w[l * 256 + c] + p.rwkv_ln_b[l * 256 + c] + dot * vsv[e]) * siluf_(gt);
      }
      uint2 ov;
      ov.x = pack2(o4[0], o4[1]);
      ov.y = pack2(o4[2], o4[3]);
      *(uint2*)(mix + (size_t)r * 1024 + 384 + cg_) = ov;
    }
    {
      const int cs_ = lane * 6;
      const float* cw = p.ssm_conv_w + (size_t)l * 3 * 896;
      const float* cb = p.ssm_conv_b + (size_t)l * 896;
      const bf16_t* ps = p.PS + (size_t)r * 912;
      float y[6];
      float sq = 0.f;
#pragma unroll
      for (int e = 0; e < 6; ++e) {
        const int c = cs_ + e, hh = c >> 6;
        const float u = bf2f(ps[c]), up = hp ? bf2f(ps[c - 912]) : 0.f, un = hn ? bf2f(ps[c + 912]) : 0.f;
        const float xs = siluf_(cw[c] * up + cw[896 + c] * u + cw[1792 + c] * un + cb[c]);
        const float yy = bf2f(p.yS[(size_t)r * 384 + c]) + bf2f(p.yS[((size_t)TOK + r) * 384 + c]) + p.ssm_d[l * 6 + hh] * xs;
        const float z = bf2f(p.PG[(size_t)r * 640 + 256 + c]);
        y[e] = yy * siluf_(z);
        sq += y[e] * y[e];
      }
      sq = sum32(sq);
      const float rstd = rsqrtf(sq * (1.f / 192.f) + 1e-5f);
      unsigned ov[3];
#pragma unroll
      for (int e = 0; e < 3; ++e) {
        const int c = cs_ + 2 * e;
        ov[e] = pack2(y[2 * e] * rstd * p.ssm_norm_w[l * 384 + c], y[2 * e + 1] * rstd * p.ssm_norm_w[l * 384 + c + 1]);
      }
      unsigned* dd = (unsigned*)(mix + (size_t)r * 1024 + 640 + cs_);
      dd[0] = ov[0]; dd[1] = ov[1]; dd[2] = ov[2];
    }
  }
}

__global__ void __launch_bounds__(NTHREADS, LBW) mega(Params p, int ph_lo, int ph_hi) {
  extern __shared__ __attribute__((aligned(16))) unsigned char smem[];
  for (int ph = ph_lo; ph < ph_hi; ++ph) {
    if (ph > ph_lo) cg::this_grid().sync();
#ifndef TEST_PH
#define TEST_PH -1
#endif
    if (ph == 0) { if (TEST_PH < 0 || TEST_PH == 0) phase_setup(p, smem); }
    else if (ph == NPHASES - 1) { if (TEST_PH < 0 || TEST_PH == 6) phase_final(p); }
    else {
      const int l = (ph - 1) / 5, s = (ph - 1) % 5;
      if (s == 0) { if (TEST_PH < 0 || TEST_PH == 1) phase_norm(p, l); }
      else if (s == 1) { if (TEST_PH < 0 || TEST_PH == 2) phase_inproj(p, l, smem); }
      else if (s == 2) { if (TEST_PH < 0 || TEST_PH == 3 || TEST_PH >= 7) phase_mixers(p, l, smem); }
      else if (s == 3) { if (TEST_PH < 0 || TEST_PH == 4) phase_finish(p, l); }
      else { if (TEST_PH < 0 || TEST_PH == 5) phase_outproj(p, l, smem); }
    }
  }
}

extern "C" void kernel_launch(void* const* d_in, const int* in_sizes, int n_in, void* d_out, int out_size, void* d_ws,
                              size_t ws_size, hipStream_t stream) {
  static int grid_blocks = 0;
  if (!grid_blocks) {
    int dev = 0, cus = 0, per_cu = 0;
    hipGetDevice(&dev);
    hipDeviceGetAttribute(&cus, hipDeviceAttributeMultiprocessorCount, dev);
    hipFuncSetAttribute((const void*)mega, hipFuncAttributeMaxDynamicSharedMemorySize, LDS_BYTES);
    hipOccupancyMaxActiveBlocksPerMultiprocessor(&per_cu, (const void*)mega, NTHREADS, LDS_BYTES);
    if (per_cu < 1) per_cu = 1;
    if (per_cu > 2) per_cu = 2;
    grid_blocks = cus * per_cu;
  }
  Params p{};
  const float** fp = (const float**)&p;
  for (int i = 0; i < 27; ++i) fp[i] = (const float*)d_in[i];
  p.out = (float*)d_out;
  unsigned char* ws = (unsigned char*)d_ws;
  size_t off = 0;
  auto take = [&](size_t bytes) { unsigned char* r = ws + off; off += (bytes + 255) & ~(size_t)255; return r; };
  p.WtIn = (bf16_t*)take((size_t)2 * 3712 * 1024 * 2);
  p.WtOut = (bf16_t*)take((size_t)2 * 1024 * 1024 * 2);
  p.WupT = (bf16_t*)take((size_t)65536 * 2);
  p.AupT = (bf16_t*)take((size_t)65536 * 2);
  p.rope = (float*)take(1024 * 2 * 4);
  p.mod = (float*)take((size_t)2 * 5 * 3072 * 4);
  p.ctxcur = (float*)take((size_t)4 * 256 * 1024 * 4);
  p.hbuf = (bf16_t*)take((size_t)TOK * 1024 * 2);
  p.PA = (bf16_t*)take((size_t)TOK * 1024 * 2);
  p.PR = (bf16_t*)take((size_t)TOK * 1024 * 2);
  p.PG = (bf16_t*)take((size_t)TOK * 640 * 2);
  p.PS = (bf16_t*)take((size_t)TOK * 912 * 2);
  p.yR = (float*)take((size_t)2 * TOK * 256 * 4);
  p.yS = (bf16_t*)take((size_t)2 * TOK * 384 * 2);
  if (off > ws_size) { fprintf(stderr, "workspace too small: need %zu have %zu\n", off, ws_size); return; }
#if ONE_LAUNCH
  int lo = 0, hi = NPHASES;
  void* args[] = {&p, &lo, &hi};
  hipError_t e = hipLaunchCooperativeKernel((const void*)mega, dim3(grid_blocks), dim3(NTHREADS), args, LDS_BYTES, stream);
  if (e != hipSuccess) fprintf(stderr, "cooperative launch failed: %s (grid %d)\n", hipGetErrorString(e), grid_blocks);
#else
  for (int ph = 0; ph < NPHASES; ++ph)
    hipLaunchKernelGGL(mega, dim3(grid_blocks), dim3(NTHREADS), LDS_BYTES, stream, p, ph, ph + 1);
#endif
}
```

```cpp
#include <hip/hip_runtime.h>
#include <hip/hip_bf16.h>
#include <hip/hip_cooperative_groups.h>
#include <cstdio>
namespace cg = cooperative_groups;

#ifndef TEST_PH
#define TEST_PH -1
#endif
#ifndef ONE_LAUNCH
#define ONE_LAUNCH 1
#endif

typedef unsigned short bf16_t;
#define GLAS __attribute__((address_space(3)))
using bf16x8 = __attribute__((ext_vector_type(8))) short;
using f32x4 = __attribute__((ext_vector_type(4))) float;

#define TOK 17408
#define TPB 4352
#define NTHREADS 256
#define LDS_BYTES 76800
#define NPHASES 16
#define CSPLIT 78
#define NSEG1 ((136 - CSPLIT) * 32)
#ifndef LBW
#define LBW 2
#endif

struct Params {
  const float *x, *c, *ctx, *c_ctx, *ada_w, *ada_b, *norm_w, *w_in, *w_out, *attn_sink, *rwkv_mu, *rwkv_w0,
      *rwkv_w_up, *rwkv_a0, *rwkv_a_up, *rwkv_k_k, *rwkv_k_a, *rwkv_r_k, *rwkv_ln_w, *rwkv_ln_b, *ssm_conv_w,
      *ssm_conv_b, *ssm_a_log, *ssm_dt_bias, *ssm_d, *ssm_norm_w, *final_norm_w;
  float* out;
  bf16_t *WtIn, *WtOut, *WupT, *AupT;
  float *rope, *mod, *ctxcur;
  bf16_t *hbuf, *PA, *PR, *PG, *PS;
  bf16_t* yR;
  bf16_t* yS;
  bf16_t* PRE;
  bf16_t* HALO;
  float2* DTC;
  bf16_t* GID;
  float* SMID;
  unsigned* ctrs;
  unsigned* bar;
  float* rstd;
};

__device__ __forceinline__ float bf2f(bf16_t v) { return __uint_as_float(((unsigned)v) << 16); }
typedef __bf16 hbf2 __attribute__((ext_vector_type(2)));
typedef float hf2 __attribute__((ext_vector_type(2)));
__device__ __forceinline__ unsigned pack2(float a, float b) {
  hf2 v = {a, b};
  hbf2 r = __builtin_convertvector(v, hbf2);
  return *(unsigned*)&r;
}
__device__ __forceinline__ bf16_t f2bf(float f) { return (bf16_t)(pack2(f, 0.f) & 0xffffu); }
__device__ __forceinline__ float frcp(float x) { return __builtin_amdgcn_rcpf(x); }
__device__ __forceinline__ float sigmoidf_(float x) { return frcp(1.f + __expf(-x)); }
__device__ __forceinline__ float siluf_(float x) { return x * frcp(1.f + __expf(-x)); }
__device__ __forceinline__ float softplusf_(float x) {
  if (x > 15.f) return x;
  float e = __expf(x);
  return (e < 0.01f) ? e * (1.f - e * (0.5f - e * 0.33333333f)) : __logf(1.f + e);
}
__device__ __forceinline__ float tanhf_(float x) {
  float e = __expf(2.f * x);
  return 1.f - 2.f * frcp(e + 1.f);
}

template <int CTRL>
__device__ __forceinline__ float dppf(float x) {
  return __int_as_float(__builtin_amdgcn_update_dpp(0, __float_as_int(x), CTRL, 0xF, 0xF, true));
}
__device__ __forceinline__ float sum16(float x) {
  x += dppf<0xB1>(x);
  x += dppf<0x4E>(x);
  x += dppf<0x141>(x);
  x += dppf<0x140>(x);
  return x;
}
__device__ __forceinline__ float max16(float x) {
  x = fmaxf(x, dppf<0xB1>(x));
  x = fmaxf(x, dppf<0x4E>(x));
  x = fmaxf(x, dppf<0x141>(x));
  x = fmaxf(x, dppf<0x140>(x));
  return x;
}
__device__ __forceinline__ float sum64(float x) {
#pragma unroll
  for (int o = 32; o >= 1; o >>= 1) x += __shfl_xor(x, o);
  return x;
}
__device__ __forceinline__ float sum32(float x) {
#pragma unroll
  for (int o = 16; o >= 1; o >>= 1) x += __shfl_xor(x, o);
  return x;
}
__device__ __forceinline__ int launder(int x) { asm volatile("" : "+v"(x)); return x; }
#define MFMA(a, b, c) __builtin_amdgcn_mfma_f32_16x16x32_bf16(a, b, c, 0, 0, 0)

__device__ __forceinline__ void transpose_tile(const float* __restrict__ W, int N, int Kdim, bf16_t* __restrict__ Wt, int k0, int n0,
                               unsigned char* smem) {
  float* T = (float*)smem;
  const int tid = launder(threadIdx.x);
#pragma unroll 4
  for (int it = 0; it < 16; ++it) {
    int kk = (tid >> 6) + 4 * it, nn = tid & 63, n = n0 + nn;
    T[kk * 65 + nn] = (n < N) ? W[(size_t)(k0 + kk) * N + n] : 0.f;
  }
  __syncthreads();
#pragma unroll
  for (int it = 0; it < 2; ++it) {
    int nn = (tid >> 3) + 32 * it, kc = tid & 7;
    uint4 o;
    o.x = pack2(T[(kc * 8 + 0) * 65 + nn], T[(kc * 8 + 1) * 65 + nn]);
    o.y = pack2(T[(kc * 8 + 2) * 65 + nn], T[(kc * 8 + 3) * 65 + nn]);
    o.z = pack2(T[(kc * 8 + 4) * 65 + nn], T[(kc * 8 + 5) * 65 + nn]);
    o.w = pack2(T[(kc * 8 + 6) * 65 + nn], T[(kc * 8 + 7) * 65 + nn]);
    *(uint4*)(Wt + (size_t)(n0 + nn) * Kdim + k0 + kc * 8) = o;
  }
  __syncthreads();
}

__device__ void sincos_d(double x, float& c, float& s) {
  double n = rint(x * 0.63661977236758134308);
  double r = x - n * 1.57079632679489661923;
  double r2 = r * r;
  double sn = r * (1.0 + r2 * (-1.0 / 6 + r2 * (1.0 / 120 + r2 * (-1.0 / 5040 + r2 * (1.0 / 362880 + r2 * (-1.0 / 39916800 + r2 * (1.0 / 6227020800.0)))))));
  double cs = 1.0 + r2 * (-0.5 + r2 * (1.0 / 24 + r2 * (-1.0 / 720 + r2 * (1.0 / 40320 + r2 * (-1.0 / 3628800 + r2 * (1.0 / 479001600.0 + r2 * (-1.0 / 87178291200.0)))))));
  int q = ((int)n) & 3;
  double co, so;
  if (q == 0) { co = cs; so = sn; }
  else if (q == 1) { co = -sn; so = cs; }
  else if (q == 2) { co = -cs; so = -sn; }
  else { co = sn; so = -cs; }
  c = (float)co;
  s = (float)so;
}

__device__ __forceinline__ void deferred_transpose(const Params& p, int t, unsigned char* smem) {
  if (t < 928) {
    const int kt = t / 58, nt = t % 58;
    transpose_tile(p.w_in + (size_t)1024 * 3596, 3596, 1024, p.WtIn + (size_t)3712 * 1024, kt * 64, nt * 64, smem);
  } else {
    const int tt = t - 928, l = tt >> 8, r = tt & 255, kt = r >> 4, nt = r & 15;
    transpose_tile(p.w_out + (size_t)l * 1024 * 1024, 1024, 1024, p.WtOut + (size_t)l * 1024 * 1024, kt * 64, nt * 64, smem);
  }
}
__device__ __forceinline__ void phase_setup(const Params& p, unsigned char* smem) {
  const int T_WIN = 16 * 58, T_WOUT = 0, T_ADA = 2 * 96, T_MISC = 17;
  const int total = T_WIN + T_WOUT + T_ADA + T_MISC;
  const int tid = launder(threadIdx.x);
  if (blockIdx.x == 0 && tid < 8) p.ctrs[tid] = 0u;
  for (int t = blockIdx.x; t < total; t += gridDim.x) {
    if (t < T_WIN) {
      int kt = t / 58, nt = t % 58;
      transpose_tile(p.w_in, 3596, 1024, p.WtIn, kt * 64, nt * 64, smem);
    } else if (t < T_WIN + T_WOUT + T_ADA) {
      int tt = t - T_WIN - T_WOUT, l = tt / 96, n0 = (tt % 96) * 32;
      float* cact = (float*)smem;
      for (int i = tid; i < 5120; i += 256) {
        int j = i >> 10, k = i & 1023;
        float v = (j < 4) ? p.c[j * 1024 + k] : p.c_ctx[k];
        cact[i] = siluf_(v);
      }
      __syncthreads();
      int col = tid & 31, kg = tid >> 5;
      float a0 = 0, a1 = 0, a2 = 0, a3 = 0, a4 = 0;
      const float* wp = p.ada_w + ((size_t)l * 1024 + kg * 128) * 3072 + n0 + col;
#pragma unroll 8
      for (int k = 0; k < 128; ++k) {
        float w = wp[(size_t)k * 3072];
        int kk = kg * 128 + k;
        a0 += cact[kk] * w; a1 += cact[1024 + kk] * w; a2 += cact[2048 + kk] * w; a3 += cact[3072 + kk] * w; a4 += cact[4096 + kk] * w;
      }
      float* red = cact + 5120;
      red[(kg * 5 + 0) * 32 + col] = a0; red[(kg * 5 + 1) * 32 + col] = a1; red[(kg * 5 + 2) * 32 + col] = a2;
      red[(kg * 5 + 3) * 32 + col] = a3; red[(kg * 5 + 4) * 32 + col] = a4;
      __syncthreads();
      if (tid < 160) {
        int j = tid >> 5, cc = tid & 31;
        float s = 0;
#pragma unroll
        for (int g = 0; g < 8; ++g) s += red[(g * 5 + j) * 32 + cc];
        p.mod[(size_t)(l * 5 + j) * 3072 + n0 + cc] = s + p.ada_b[l * 3072 + n0 + cc];
      }
      __syncthreads();
    } else {
      int tt = t - T_WIN - T_WOUT - T_ADA;
      if (tt < 16) {
        for (int i = tid; i < 8192; i += 256) {
          int idx = tt * 8192 + i;
          int arr = idx >> 16, e = idx & 65535;
          int ld = e >> 14, rem = e & 16383, n = rem >> 6, k = rem & 63;
          const float* src = arr ? p.rwkv_a_up : p.rwkv_w_up;
          bf16_t* dst = arr ? p.AupT : p.WupT;
          dst[e] = f2bf(src[((size_t)ld * 64 + k) * 256 + n]);
        }
      } else {
        for (int i = tid; i < 1024; i += 256) {
          int pos = i >> 4, f = i & 15;
          float inv32 = exp2f(-(float)f * 0.83048202372184058f);
          float c, s;
          sincos_d((double)((float)pos * inv32), c, s);
          p.rope[i * 2] = c;
          p.rope[i * 2 + 1] = s;
        }
      }
    }
  }
}

__device__ __forceinline__ void phase_norm(const Params& p, int l) {
  const int tid = launder(threadIdx.x), lane = tid & 63, w = tid >> 6;
  for (int t = blockIdx.x; t < TOK / 4; t += gridDim.x) {
    int r = t * 4 + w, b = r / TPB, pp = r % TPB;
    const float* src;
    if (l == 0) src = (pp < 256) ? p.ctx + ((size_t)b * 256 + pp) * 1024 : p.x + ((size_t)b * 4096 + pp - 256) * 1024;
    else src = (pp < 256) ? p.ctxcur + ((size_t)b * 256 + pp) * 1024 : p.out + ((size_t)b * 4096 + pp - 256) * 1024;
    const float* md = p.mod + (size_t)(l * 5 + ((pp < 256) ? 4 : b)) * 3072;
    const float* nw = p.norm_w + l * 1024;
    float4 v[4];
    float ss = 0;
#pragma unroll
    for (int i = 0; i < 4; ++i) {
      v[i] = *(const float4*)(src + lane * 4 + 256 * i);
      ss += v[i].x * v[i].x + v[i].y * v[i].y + v[i].z * v[i].z + v[i].w * v[i].w;
    }
    ss = sum64(ss);
    float rstd = rsqrtf(ss * (1.f / 1024.f) + 1e-6f);
    if (lane == 0) p.rstd[r] = rstd;
#pragma unroll
    for (int i = 0; i < 4; ++i) {
      int k = lane * 4 + 256 * i;
      float4 n4 = *(const float4*)(nw + k), sc = *(const float4*)(md + 1024 + k), sh = *(const float4*)(md + k);
      float h0 = v[i].x * rstd * n4.x * (1.f + sc.x) + sh.x;
      float h1 = v[i].y * rstd * n4.y * (1.f + sc.y) + sh.y;
      float h2 = v[i].z * rstd * n4.z * (1.f + sc.z) + sh.z;
      float h3 = v[i].w * rstd * n4.w * (1.f + sc.w) + sh.w;
      uint2 o;
      o.x = pack2(h0, h1);
      o.y = pack2(h2, h3);
      *(uint2*)(p.hbuf + (size_t)r * 1024 + k) = o;
    }
  }
}

__device__ __forceinline__ void phase_final(const Params& p) {
  const int tid = launder(threadIdx.x), lane = tid & 63, w = tid >> 6;
  for (int t = blockIdx.x; t < 16384 / 4; t += gridDim.x) {
    int r = t * 4 + w;
    float* src = p.out + (size_t)r * 1024;
    float4 v[4];
    float ss = 0;
#pragma unroll
    for (int i = 0; i < 4; ++i) {
      v[i] = *(const float4*)(src + lane * 4 + 256 * i);
      ss += v[i].x * v[i].x + v[i].y * v[i].y + v[i].z * v[i].z + v[i].w * v[i].w;
    }
    ss = sum64(ss);
    float rstd = rsqrtf(ss * (1.f / 1024.f) + 1e-6f);
#pragma unroll
    for (int i = 0; i < 4; ++i) {
      int k = lane * 4 + 256 * i;
      float4 n4 = *(const float4*)(p.final_norm_w + k);
      float4 o;
      o.x = v[i].x * rstd * n4.x; o.y = v[i].y * rstd * n4.y; o.z = v[i].z * rstd * n4.z; o.w = v[i].w * rstd * n4.w;
      *(float4*)(src + k) = o;
    }
  }
}

template <int MODE>
__device__ __forceinline__ void gemm_tile(const Params& p, int l, int mt_, int nt_, unsigned char* smem) {
  const bf16_t* A = p.hbuf;
  const bf16_t* Bt = (MODE == 0) ? p.WtIn + (size_t)l * 3712 * 1024 : p.WtOut + (size_t)l * 1024 * 1024;
  const int m0 = mt_ * 128, n0 = nt_ * 128;
  bf16_t* As = (bf16_t*)smem;
  bf16_t* Bs = As + 2 * 128 * 72;
  const int tid = launder(threadIdx.x), lane = tid & 63, w = tid >> 6, wr = w >> 1, wc = w & 1, fr = lane & 15, fq = lane >> 4;
  f32x4 acc[4][4];
#pragma unroll
  for (int i = 0; i < 4; ++i)
#pragma unroll
    for (int j = 0; j < 4; ++j) acc[i][j] = (f32x4){0.f, 0.f, 0.f, 0.f};
  unsigned char* lds = smem;
  int sR[4], sC[4];
#pragma unroll
  for (int i = 0; i < 4; ++i) {
    const int bo = tid * 16 + i * 4096;
    const int st = bo >> 10, sb = bo & 1023, swz = sb ^ (((sb >> 9) & 1) << 5);
    sR[i] = (st >> 1) * 16 + (swz >> 6);
    sC[i] = (st & 1) * 32 + ((swz & 63) >> 1);
  }
  const bf16_t* Ag0 = A + (size_t)(m0 + sR[0]) * 1024 + sC[0];
  const bf16_t* Ag1 = A + (size_t)(m0 + sR[1]) * 1024 + sC[1];
  const bf16_t* Ag2 = A + (size_t)(m0 + sR[2]) * 1024 + sC[2];
  const bf16_t* Ag3 = A + (size_t)(m0 + sR[3]) * 1024 + sC[3];
  const bf16_t* Bg0 = Bt + (size_t)(n0 + sR[0]) * 1024 + sC[0];
  const bf16_t* Bg1 = Bt + (size_t)(n0 + sR[1]) * 1024 + sC[1];
  const bf16_t* Bg2 = Bt + (size_t)(n0 + sR[2]) * 1024 + sC[2];
  const bf16_t* Bg3 = Bt + (size_t)(n0 + sR[3]) * 1024 + sC[3];
#define GL_STAGE(q_, kt_)                                                                                                              \
  {                                                                                                                                    \
    unsigned char* base_ = lds + (q_) * 32768 + tid * 16;                                                                              \
    __builtin_amdgcn_global_load_lds((const unsigned*)(Ag0 + (kt_) * 64), (GLAS unsigned*)(base_), 16, 0, 0);                          \
    __builtin_amdgcn_global_load_lds((const unsigned*)(Ag1 + (kt_) * 64), (GLAS unsigned*)(base_ + 4096), 16, 0, 0);                   \
    __builtin_amdgcn_global_load_lds((const unsigned*)(Ag2 + (kt_) * 64), (GLAS unsigned*)(base_ + 8192), 16, 0, 0);                   \
    __builtin_amdgcn_global_load_lds((const unsigned*)(Ag3 + (kt_) * 64), (GLAS unsigned*)(base_ + 12288), 16, 0, 0);                  \
    __builtin_amdgcn_global_load_lds((const unsigned*)(Bg0 + (kt_) * 64), (GLAS unsigned*)(base_ + 16384), 16, 0, 0);                  \
    __builtin_amdgcn_global_load_lds((const unsigned*)(Bg1 + (kt_) * 64), (GLAS unsigned*)(base_ + 16384 + 4096), 16, 0, 0);           \
    __builtin_amdgcn_global_load_lds((const unsigned*)(Bg2 + (kt_) * 64), (GLAS unsigned*)(base_ + 16384 + 8192), 16, 0, 0);           \
    __builtin_amdgcn_global_load_lds((const unsigned*)(Bg3 + (kt_) * 64), (GLAS unsigned*)(base_ + 16384 + 12288), 16, 0, 0);          \
  }
  const int lo = (fr * 64 + fq * 16) ^ ((fr >> 3) << 5);
#define GL_COMPUTE(q_)                                                                                 \
  {                                                                                                    \
    const unsigned char* Ab = lds + (q_) * 32768 + (wr * 4) * 2048 + lo;                               \
    const unsigned char* Bb = lds + (q_) * 32768 + 16384 + (wc * 4) * 2048 + lo;                       \
    _Pragma("unroll") for (int ks = 0; ks < 2; ++ks) {                                                 \
      bf16x8 a[4], b[4];                                                                               \
      _Pragma("unroll") for (int i = 0; i < 4; ++i) {                                                  \
        a[i] = *(const bf16x8*)(Ab + i * 2048 + ks * 1024);                                            \
        b[i] = *(const bf16x8*)(Bb + i * 2048 + ks * 1024);                                            \
      }                                                                                                \
      _Pragma("unroll") for (int i = 0; i < 4; ++i)                                                    \
        _Pragma("unroll") for (int j = 0; j < 4; ++j) acc[i][j] = MFMA(a[i], b[j], acc[i][j]);         \
    }                                                                                                  \
  }
  GL_STAGE(0, 0);
  asm volatile("s_waitcnt vmcnt(0)" ::: "memory");
  __builtin_amdgcn_s_barrier();
  for (int kt = 0; kt < 16; ++kt) {
    const int q = kt & 1;
    if (kt + 1 < 16) GL_STAGE(q ^ 1, kt + 1);
    GL_COMPUTE(q);
    asm volatile("s_waitcnt vmcnt(0) lgkmcnt(0)" ::: "memory");
    __builtin_amdgcn_s_barrier();
  }
  const int cbase = n0 + wc * 64;
  if (MODE == 0) {
    bf16_t* dst;
    int ld, coff;
    if (cbase < 1024) { dst = p.PA; ld = 1024; coff = cbase; }
    else if (cbase < 2048) { dst = p.PR; ld = 1024; coff = cbase - 1024; }
    else if (cbase < 2688) { dst = p.PG; ld = 640; coff = cbase - 2048; }
    else { dst = p.PS; ld = 912; coff = cbase - 2688; }
#pragma unroll
    for (int i = 0; i < 4; ++i) {
#pragma unroll
      for (int j = 0; j < 4; ++j) {
        const int r = m0 + wr * 64 + i * 16 + fq * 4 + j;
        const int pp = r % TPB;
        float v0 = acc[i][0][j], v1 = acc[i][1][j], v2 = acc[i][2][j], v3 = acc[i][3][j];
        if (cbase < 512 && pp >= 256) {
          const int tt = pp - 256, rp = tt >> 6, cp = tt & 63;
          const float2 cs0 = *(const float2*)(p.rope + (rp * 16 + fr) * 2);
          const float2 cs1 = *(const float2*)(p.rope + (cp * 16 + fr) * 2);
          float n0_ = v0 * cs0.x - v1 * cs0.y, n1_ = v0 * cs0.y + v1 * cs0.x;
          float n2_ = v2 * cs1.x - v3 * cs1.y, n3_ = v2 * cs1.y + v3 * cs1.x;
          v0 = n0_; v1 = n1_; v2 = n2_; v3 = n3_;
        }
        if (cbase < 384) { v0 *= 0.125f; v1 *= 0.125f; v2 *= 0.125f; v3 *= 0.125f; }
        bf16_t* o = dst + (size_t)r * ld + coff + fr;
        if (cbase >= 2688 && cbase + 64 <= 3584) {
          const int q34 = pp % 34, t34 = pp / 34, bb = r / TPB;
          bf16_t* hb = nullptr;
          if (q34 == 33 && t34 + 1 < 128) hb = p.HALO + ((size_t)(bb * 128 + t34 + 1) * 2 + 0) * 896 + coff + fr;
          if (q34 == 0 && t34 >= 1) hb = p.HALO + ((size_t)(bb * 128 + t34 - 1) * 2 + 1) * 896 + coff + fr;
          if (hb) { hb[0] = f2bf(v0); hb[16] = f2bf(v1); hb[32] = f2bf(v2); hb[48] = f2bf(v3); }
        }
        if (cbase + 64 <= 3596) {
          o[0] = f2bf(v0); o[16] = f2bf(v1); o[32] = f2bf(v2); o[48] = f2bf(v3);
        } else {
          if (cbase + fr < 3596) o[0] = f2bf(v0);
          if (cbase + 16 + fr < 3596) o[16] = f2bf(v1);
          if (cbase + 32 + fr < 3596) o[32] = f2bf(v2);
          if (cbase + 48 + fr < 3596) o[48] = f2bf(v3);
        }
      }
    }
  } else {
#pragma unroll
    for (int i = 0; i < 4; ++i) {
#pragma unroll
      for (int j = 0; j < 4; ++j) {
        const int r = m0 + wr * 64 + i * 16 + fq * 4 + j;
        const int b = r / TPB, pp = r % TPB;
        const bool isc = pp < 256;
        const float* gate = p.mod + (size_t)(l * 5 + (isc ? 4 : b)) * 3072 + 2048;
        const float* res;
        float* dstp;
        if (l == 0) {
          res = isc ? p.ctx + ((size_t)b * 256 + pp) * 1024 : p.x + ((size_t)b * 4096 + pp - 256) * 1024;
          dstp = isc ? p.ctxcur + ((size_t)b * 256 + pp) * 1024 : p.out + ((size_t)b * 4096 + pp - 256) * 1024;
        } else {
          res = p.out + ((size_t)b * 4096 + pp - 256) * 1024;
          dstp = p.out + ((size_t)b * 4096 + pp - 256) * 1024;
        }
#pragma unroll
        for (int nn = 0; nn < 4; ++nn) {
          const int n = cbase + nn * 16 + fr;
          dstp[n] = res[n] + gate[n] * acc[i][nn][j];
        }
      }
    }
  }
}

#define G_COMPUTE(buf_)                                                                 \
  {                                                                                     \
    const bf16_t* Ac = As + (buf_) * 128 * 72 + (wr * 64 + fr) * 72 + fq * 8;           \
    const bf16_t* Bc = Bs + (buf_) * 128 * 72 + (wc * 64 + fr) * 72 + fq * 8;           \
    _Pragma("unroll") for (int ks = 0; ks < 2; ++ks) {                                  \
      bf16x8 a[4], b[4];                                                                \
      _Pragma("unroll") for (int i = 0; i < 4; ++i) {                                   \
        a[i] = *(const bf16x8*)(Ac + i * 16 * 72 + ks * 32);                            \
        b[i] = *(const bf16x8*)(Bc + i * 16 * 72 + ks * 32);                            \
      }                                                                                 \
      _Pragma("unroll") for (int i = 0; i < 4; ++i)                                     \
        _Pragma("unroll") for (int j = 0; j < 4; ++j) acc[i][j] = MFMA(a[i], b[j], acc[i][j]); \
    }                                                                                   \
  }
__device__ __forceinline__ void gemm_late_tile(const Params& p, int l, int mt_, int nt_, unsigned char* smem) {
  const bf16_t* Bt = p.WtIn + (size_t)l * 3712 * 1024;
  const int m0 = mt_ * 128, n0 = nt_ * 128;
  bf16_t* As = (bf16_t*)smem;
  bf16_t* Bs = As + 2 * 128 * 72;
  const int tid = launder(threadIdx.x), lane = tid & 63, w = tid >> 6, wr = w >> 1, wc = w & 1, fr = lane & 15, fq = lane >> 4;
  f32x4 acc[4][4];
#pragma unroll
  for (int i = 0; i < 4; ++i)
#pragma unroll
    for (int j = 0; j < 4; ++j) acc[i][j] = (f32x4){0.f, 0.f, 0.f, 0.f};
  const int lrow = tid >> 3, lkc = tid & 7;
  const int bb = m0 / TPB, pp0 = m0 % TPB;
  const bool isc0 = pp0 < 256;
  const float* xbase;
  if (l == 0) xbase = isc0 ? p.ctx + ((size_t)bb * 256 + pp0) * 1024 : p.x + ((size_t)bb * 4096 + pp0 - 256) * 1024;
  else xbase = isc0 ? p.ctxcur + ((size_t)bb * 256 + pp0) * 1024 : p.out + ((size_t)bb * 4096 + pp0 - 256) * 1024;
  const float* xr = xbase + (size_t)lrow * 1024 + lkc * 8;
  const float* md = p.mod + (size_t)(l * 5 + (isc0 ? 4 : bb)) * 3072 + lkc * 8;
  const float* nwp = p.norm_w + l * 1024 + lkc * 8;
  const float rs0 = p.rstd[m0 + lrow], rs1 = p.rstd[m0 + lrow + 32], rs2 = p.rstd[m0 + lrow + 64], rs3 = p.rstd[m0 + lrow + 96];
  const bf16_t* Bg = Bt + (size_t)(n0 + lrow) * 1024 + lkc * 8;
  float4 xa0, xb0, xa1, xb1, xa2, xb2, xa3, xb3, nwa, nwb, sca, scb, sha, shb;
  uint4 lb0, lb1, lb2, lb3;
#define L_LOAD(kt_)                                                                                   \
  {                                                                                                   \
    const int ko_ = (kt_) * 64;                                                                       \
    xa0 = *(const float4*)(xr + ko_); xb0 = *(const float4*)(xr + ko_ + 4);                            \
    xa1 = *(const float4*)(xr + 32 * 1024 + ko_); xb1 = *(const float4*)(xr + 32 * 1024 + ko_ + 4);    \
    xa2 = *(const float4*)(xr + 64 * 1024 + ko_); xb2 = *(const float4*)(xr + 64 * 1024 + ko_ + 4);    \
    xa3 = *(const float4*)(xr + 96 * 1024 + ko_); xb3 = *(const float4*)(xr + 96 * 1024 + ko_ + 4);    \
    lb0 = *(const uint4*)(Bg + ko_); lb1 = *(const uint4*)(Bg + (size_t)32 * 1024 + ko_);              \
    lb2 = *(const uint4*)(Bg + (size_t)64 * 1024 + ko_); lb3 = *(const uint4*)(Bg + (size_t)96 * 1024 + ko_); \
    nwa = *(const float4*)(nwp + ko_); nwb = *(const float4*)(nwp + ko_ + 4);                          \
    sca = *(const float4*)(md + 1024 + ko_); scb = *(const float4*)(md + 1024 + ko_ + 4);              \
    sha = *(const float4*)(md + ko_); shb = *(const float4*)(md + ko_ + 4);                            \
  }
#define L_ROW(xa_, xb_, rs_, i_, buf_)                                                                \
  {                                                                                                   \
    uint4 o_;                                                                                         \
    o_.x = pack2(xa_.x * rs_ * nwa.x * (1.f + sca.x) + sha.x, xa_.y * rs_ * nwa.y * (1.f + sca.y) + sha.y); \
    o_.y = pack2(xa_.z * rs_ * nwa.z * (1.f + sca.z) + sha.z, xa_.w * rs_ * nwa.w * (1.f + sca.w) + sha.w); \
    o_.z = pack2(xb_.x * rs_ * nwb.x * (1.f + scb.x) + shb.x, xb_.y * rs_ * nwb.y * (1.f + scb.y) + shb.y); \
    o_.w = pack2(xb_.z * rs_ * nwb.z * (1.f + scb.z) + shb.z, xb_.w * rs_ * nwb.w * (1.f + scb.w) + shb.w); \
    *(uint4*)(As + (buf_) * 128 * 72 + (lrow + 32 * (i_)) * 72 + lkc * 8) = o_;                       \
  }
#define L_STORE(buf_)                                                                                 \
  {                                                                                                   \
    L_ROW(xa0, xb0, rs0, 0, buf_) L_ROW(xa1, xb1, rs1, 1, buf_) L_ROW(xa2, xb2, rs2, 2, buf_) L_ROW(xa3, xb3, rs3, 3, buf_) \
    *(uint4*)(Bs + (buf_) * 128 * 72 + lrow * 72 + lkc * 8) = lb0;                                    \
    *(uint4*)(Bs + (buf_) * 128 * 72 + (lrow + 32) * 72 + lkc * 8) = lb1;                             \
    *(uint4*)(Bs + (buf_) * 128 * 72 + (lrow + 64) * 72 + lkc * 8) = lb2;                             \
    *(uint4*)(Bs + (buf_) * 128 * 72 + (lrow + 96) * 72 + lkc * 8) = lb3;                             \
  }
  L_LOAD(0);
  L_STORE(0);
  __syncthreads();
  for (int kt = 0; kt < 16; ++kt) {
    L_LOAD((kt + 1 < 16) ? kt + 1 : 15);
    G_COMPUTE(kt & 1);
    L_STORE((kt + 1) & 1);
    __syncthreads();
  }
  const int cbase = n0 + wc * 64;
    bf16_t* dst;
    int ld, coff;
    if (cbase < 1024) { dst = p.PA; ld = 1024; coff = cbase; }
    else if (cbase < 2048) { dst = p.PR; ld = 1024; coff = cbase - 1024; }
    else if (cbase < 2688) { dst = p.PG; ld = 640; coff = cbase - 2048; }
    else { dst = p.PS; ld = 912; coff = cbase - 2688; }
#pragma unroll
    for (int i = 0; i < 4; ++i) {
#pragma unroll
      for (int j = 0; j < 4; ++j) {
        const int r = m0 + wr * 64 + i * 16 + fq * 4 + j;
        const int pp = r % TPB;
        float v0 = acc[i][0][j], v1 = acc[i][1][j], v2 = acc[i][2][j], v3 = acc[i][3][j];
        if (cbase < 512 && pp >= 256) {
          const int tt = pp - 256, rp = tt >> 6, cp = tt & 63;
          const float2 cs0 = *(const float2*)(p.rope + (rp * 16 + fr) * 2);
          const float2 cs1 = *(const float2*)(p.rope + (cp * 16 + fr) * 2);
          float n0_ = v0 * cs0.x - v1 * cs0.y, n1_ = v0 * cs0.y + v1 * cs0.x;
          float n2_ = v2 * cs1.x - v3 * cs1.y, n3_ = v2 * cs1.y + v3 * cs1.x;
          v0 = n0_; v1 = n1_; v2 = n2_; v3 = n3_;
        }
        if (cbase < 384) { v0 *= 0.125f; v1 *= 0.125f; v2 *= 0.125f; v3 *= 0.125f; }
        bf16_t* o = dst + (size_t)r * ld + coff + fr;
        if (cbase >= 2688 && cbase + 64 <= 3584) {
          const int q34 = pp % 34, t34 = pp / 34, bb = r / TPB;
          bf16_t* hb = nullptr;
          if (q34 == 33 && t34 + 1 < 128) hb = p.HALO + ((size_t)(bb * 128 + t34 + 1) * 2 + 0) * 896 + coff + fr;
          if (q34 == 0 && t34 >= 1) hb = p.HALO + ((size_t)(bb * 128 + t34 - 1) * 2 + 1) * 896 + coff + fr;
          if (hb) { hb[0] = f2bf(v0); hb[16] = f2bf(v1); hb[32] = f2bf(v2); hb[48] = f2bf(v3); }
        }
        if (cbase + 64 <= 3596) {
          o[0] = f2bf(v0); o[16] = f2bf(v1); o[32] = f2bf(v2); o[48] = f2bf(v3);
        } else {
          if (cbase + fr < 3596) o[0] = f2bf(v0);
          if (cbase + 16 + fr < 3596) o[16] = f2bf(v1);
          if (cbase + 32 + fr < 3596) o[32] = f2bf(v2);
          if (cbase + 48 + fr < 3596) o[48] = f2bf(v3);
        }
      }
    }
}

__device__ __forceinline__ void phase_inproj(const Params& p, int l, unsigned char* smem) {
  if ((gridDim.x & 7) == 0) {
    const int x = blockIdx.x & 7, slot = blockIdx.x >> 3, nslot = gridDim.x >> 3;
    for (int j = slot; j < 17 * 24; j += nslot) { const int ne = j % 24; gemm_tile<0>(p, l, (j / 24) * 8 + x, (ne < 16) ? ne : ne + 5, smem); }
  } else {
    for (int t = blockIdx.x; t < 136 * 24; t += gridDim.x) { const int ne = t % 24; gemm_tile<0>(p, l, t / 24, (ne < 16) ? ne : ne + 5, smem); }
  }
}
__device__ __forceinline__ void phase_outproj(const Params& p, int l, unsigned char* smem) {
  if ((gridDim.x & 7) == 0) {
    const int x = blockIdx.x & 7, slot = blockIdx.x >> 3, nslot = gridDim.x >> 3;
    for (int j = slot; j < 17 * 8; j += nslot) {
      const int mt = (j >> 3) * 8 + x, nt = j & 7;
      if (l == 1 && (mt % 34) < 2) continue;
      gemm_tile<1>(p, l, mt, nt, smem);
    }
  } else {
    for (int t = blockIdx.x; t < 136 * 8; t += gridDim.x) {
      int mt = t >> 3, nt = t & 7;
      if (l == 1 && (mt % 34) < 2) continue;
      gemm_tile<1>(p, l, mt, nt, smem);
    }
  }
}

#define PRE_ARR ((size_t)TOK * 512)
__device__ __forceinline__ void rwkv_prep_tile(const Params& p, int l, int tile, unsigned char* smem) {
  const int d = tile & 1, tb = (tile >> 1) % 136, b = tile / 272;
  bf16_t* raw = (bf16_t*)smem;
  bf16_t* Aw = raw + 34 * 384;
  bf16_t* Aa = Aw + 32 * 72;
  const int tid = launder(threadIdx.x), lane = tid & 63, w = tid >> 6, fr = lane & 15, fq = lane >> 4;
  const int p0 = tb * 32;
  const int slo = (p0 < 256) ? 0 : 256, shi = (p0 < 256) ? 255 : 4351;
  const size_t rowbase = (size_t)b * TPB;
  const int ld2 = l * 2 + d;
  for (int q = tid; q < 34 * 48; q += 256) {
    const int rr = q / 48, cc = q % 48;
    const int tr = p0 - 1 + rr;
    const int col = (cc < 32) ? (256 + cc * 8) : ((cc < 40) ? (768 + d * 64 + (cc - 32) * 8) : (896 + d * 64 + (cc - 40) * 8));
    uint4 v = make_uint4(0, 0, 0, 0);
    if (tr >= slo && tr <= shi) v = *(const uint4*)(p.PR + (rowbase + tr) * 1024 + col);
    *(uint4*)(raw + rr * 384 + cc * 8) = v;
  }
  __syncthreads();
  const float* mu0 = p.rwkv_mu + (size_t)(l * 2 + 0) * 1024;
  const float* mu1 = p.rwkv_mu + (size_t)(l * 2 + 1) * 1024;
  {
    const int ca = tid & 63;
    const float m0wd = mu0[768 + d * 64 + ca], m1wd = mu1[768 + d * 64 + ca];
    const float m0ad = mu0[896 + d * 64 + ca], m1ad = mu1[896 + d * 64 + ca];
#pragma unroll 2
    for (int it = 0; it < 8; ++it) {
      const int i = w + 4 * it;
      const bf16_t* r0 = raw + (i + 1) * 384 + ca;
      float u = bf2f(r0[256]), up = bf2f(r0[256 - 384]), un = bf2f(r0[256 + 384]);
      Aw[i * 72 + ca] = f2bf(tanhf_(u + m0wd * (up - u) + m1wd * (un - u)));
      u = bf2f(r0[320]); up = bf2f(r0[320 - 384]); un = bf2f(r0[320 + 384]);
      Aa[i * 72 + ca] = f2bf(u + m0ad * (up - u) + m1ad * (un - u));
    }
  }
  __syncthreads();
  bf16x8 aw[2][2], aa[2][2];
#pragma unroll
  for (int mt = 0; mt < 2; ++mt)
#pragma unroll
    for (int ks = 0; ks < 2; ++ks) {
      aw[mt][ks] = *(const bf16x8*)(Aw + (mt * 16 + fr) * 72 + ks * 32 + fq * 8);
      aa[mt][ks] = *(const bf16x8*)(Aa + (mt * 16 + fr) * 72 + ks * 32 + fq * 8);
    }
  float kkr[2][4][4];
  float ssq[2][4];
#pragma unroll
  for (int mt = 0; mt < 2; ++mt)
#pragma unroll
    for (int j = 0; j < 4; ++j) ssq[mt][j] = 0.f;
#pragma unroll
  for (int nt = 0; nt < 4; ++nt) {
    const int c = w * 64 + nt * 16 + fr;
    const float m0k = mu0[256 + c], m1k = mu1[256 + c], kkc = p.rwkv_k_k[ld2 * 256 + c];
#pragma unroll
    for (int mt = 0; mt < 2; ++mt)
#pragma unroll
      for (int j = 0; j < 4; ++j) {
        const int i = mt * 16 + fq * 4 + j;
        const bf16_t* r0 = raw + (i + 1) * 384 + c;
        const float u = bf2f(r0[0]), up = bf2f(r0[-384]), un = bf2f(r0[384]);
        const float kq = (u + m0k * (up - u) + m1k * (un - u)) * kkc;
        kkr[mt][nt][j] = kq;
        ssq[mt][j] += kq * kq;
      }
  }
  float inv[2][4];
#pragma unroll
  for (int mt = 0; mt < 2; ++mt)
#pragma unroll
    for (int j = 0; j < 4; ++j) {
      const float tot = sum16(ssq[mt][j]);
      inv[mt][j] = frcp(fmaxf(__builtin_amdgcn_sqrtf(tot), 1e-12f));
    }
#pragma unroll
  for (int nt = 0; nt < 4; ++nt) {
    const int c = w * 64 + nt * 16 + fr;
    const bf16_t* wup = p.WupT + ((size_t)(ld2 * 256 + c)) * 64 + fq * 8;
    const bf16_t* aup = p.AupT + ((size_t)(ld2 * 256 + c)) * 64 + fq * 8;
    const bf16x8 bw0 = *(const bf16x8*)wup, bw1 = *(const bf16x8*)(wup + 32);
    const bf16x8 ba0 = *(const bf16x8*)aup, ba1 = *(const bf16x8*)(aup + 32);
    const float w0c = p.rwkv_w0[ld2 * 256 + c], a0c = p.rwkv_a0[ld2 * 256 + c];
#pragma unroll
    for (int mt = 0; mt < 2; ++mt) {
      f32x4 accw = (f32x4){0.f, 0.f, 0.f, 0.f}, acca = (f32x4){0.f, 0.f, 0.f, 0.f};
      accw = MFMA(aw[mt][0], bw0, accw);
      accw = MFMA(aw[mt][1], bw1, accw);
      acca = MFMA(aa[mt][0], ba0, acca);
      acca = MFMA(aa[mt][1], ba1, acca);
#pragma unroll
      for (int j = 0; j < 4; ++j) {
        const int i = mt * 16 + fq * 4 + j;
        const float ew = 0.6065306597f * sigmoidf_(w0c + accw[j]);
        const float a = sigmoidf_(a0c + acca[j]);
        const float kk = kkr[mt][nt][j] * inv[mt][j];
        const size_t o = ((rowbase + p0 + i) * 2 + d) * 256 + c;
        p.PRE[o] = f2bf(ew);
        p.PRE[PRE_ARR + o] = f2bf(a);
        p.PRE[2 * PRE_ARR + o] = f2bf(kk);
      }
    }
  }
  __syncthreads();
}
__device__ __forceinline__ void ssd_conv_tile(const Params& p, int l, int tile, unsigned char* smem);
__device__ __forceinline__ void ssd_dtcum_tile(const Params& p, int l, int tile, unsigned char* smem);
__device__ __forceinline__ void phase_rwkvprep(const Params& p, int l, unsigned char* smem) {
  for (int t = blockIdx.x; t < 1088 + 512 + 544; t += gridDim.x) {
    if (t < 1088) rwkv_prep_tile(p, l, t, smem);
    else if (t < 1600) ssd_conv_tile(p, l, t - 1088, smem);
    else ssd_dtcum_tile(p, l, t - 1600, smem);
  }
}

typedef float v2f __attribute__((ext_vector_type(2)));
template <bool DUAL>
__device__ __forceinline__ void rwkv_tile(const Params& p, int l, int tile, unsigned char* smem) {
  const int part = tile >> 7;
  const int rg = tile & 3, h = (tile >> 2) & 3, b = (tile >> 4) & 3, d = (tile >> 6) & 1;
  const int cbeg = (part == 0) ? 0 : CSPLIT, cend = (part == 0) ? CSPLIT : 136;
  bf16_t* raw = (bf16_t*)smem;
  bf16_t* pre = raw + 34 * 192;
  float* rec = (float*)(smem + 13056 + 12288);
  const int tid = launder(threadIdx.x), lane = tid & 63, w = tid >> 6, fr = lane & 15, fq = lane >> 4;
  const int row = rg * 16 + w * 4 + fq;
  const int c0 = fr * 4;
  const int ld2 = l * 2 + d;
  const size_t rowbase = (size_t)b * TPB;
  const int lc = (tid & 15) * 4;
  const float* mu0 = p.rwkv_mu + (size_t)(l * 2 + 0) * 1024 + h * 64 + lc;
  const float* mu1 = p.rwkv_mu + (size_t)(l * 2 + 1) * 1024 + h * 64 + lc;
  const float4 m0r = *(const float4*)mu0, m1r = *(const float4*)mu1;
  const float4 m0k = *(const float4*)(mu0 + 256), m1k = *(const float4*)(mu1 + 256);
  const float4 m0v = *(const float4*)(mu0 + 512), m1v = *(const float4*)(mu1 + 512);
  const float4 ka4 = *(const float4*)(p.rwkv_k_a + ld2 * 256 + h * 64 + lc);
  v2f sA = {0.f, 0.f}, sB = {0.f, 0.f};
  v2f iA = {(row == c0) ? 1.f : 0.f, (row == c0 + 1) ? 1.f : 0.f}, iB = {(row == c0 + 2) ? 1.f : 0.f, (row == c0 + 3) ? 1.f : 0.f};
  const int pcc = tid % 24, prow = tid / 24;
  const bool pact = tid < 240;
  const bf16_t* rbase_g = p.PR + rowbase * 1024 + (pcc >> 3) * 256 + h * 64 + (pcc & 7) * 8;
  const bf16_t* pbase_g = p.PRE + (size_t)(pcc >> 3) * PRE_ARR + (rowbase * 2 + d) * 256 + h * 64 + (pcc & 7) * 8;
  uint4 pf0, pf1, pf2, pf3, pg0, pg1, pg2, pg3;
#define RW_GEOM(cix_, plo_, slo_, shi_)                                                   \
  {                                                                                       \
    const int st0_ = (cix_) * 32;                                                         \
    if (st0_ < 256) { slo_ = 0; shi_ = 255; plo_ = (d == 0) ? st0_ : 224 - st0_; }         \
    else { slo_ = 256; shi_ = 4351; plo_ = (d == 0) ? st0_ : 4576 - st0_; }                \
  }
#define RW_PF1(dst_, rr_, plo_, slo_, shi_)                                                         \
  {                                                                                                 \
    const int tr_ = (plo_) - 1 + (rr_);                                                             \
    dst_ = make_uint4(0, 0, 0, 0);                                                                  \
    if (pact && (rr_) < 34 && tr_ >= (slo_) && tr_ <= (shi_)) dst_ = *(const uint4*)(rbase_g + (size_t)tr_ * 1024); \
  }
#define RW_PG1(dst_, rr_, plo_)                                                                     \
  {                                                                                                 \
    dst_ = make_uint4(0, 0, 0, 0);                                                                  \
    if (pact && (rr_) < 32) dst_ = *(const uint4*)(pbase_g + (size_t)((plo_) + (rr_)) * 512);       \
  }
#define RW_PREFETCH(cix_)                                                                 \
  {                                                                                       \
    int plo_, slo_, shi_;                                                                 \
    RW_GEOM(cix_, plo_, slo_, shi_);                                                      \
    RW_PF1(pf0, prow, plo_, slo_, shi_); RW_PF1(pf1, prow + 10, plo_, slo_, shi_);        \
    RW_PF1(pf2, prow + 20, plo_, slo_, shi_); RW_PF1(pf3, prow + 30, plo_, slo_, shi_);   \
    RW_PG1(pg0, prow, plo_); RW_PG1(pg1, prow + 10, plo_);                                \
    RW_PG1(pg2, prow + 20, plo_); RW_PG1(pg3, prow + 30, plo_);                           \
  }
#define RW_STASH()                                                                        \
  {                                                                                       \
    if (pact) {                                                                           \
      *(uint4*)(raw + prow * 192 + pcc * 8) = pf0;                                        \
      *(uint4*)(raw + (prow + 10) * 192 + pcc * 8) = pf1;                                 \
      *(uint4*)(raw + (prow + 20) * 192 + pcc * 8) = pf2;                                 \
      if (prow + 30 < 34) *(uint4*)(raw + (prow + 30) * 192 + pcc * 8) = pf3;             \
      *(uint4*)(pre + prow * 192 + pcc * 8) = pg0;                                        \
      *(uint4*)(pre + (prow + 10) * 192 + pcc * 8) = pg1;                                 \
      *(uint4*)(pre + (prow + 20) * 192 + pcc * 8) = pg2;                                 \
      if (prow + 30 < 32) *(uint4*)(pre + (prow + 30) * 192 + pcc * 8) = pg3;             \
    }                                                                                     \
  }
  RW_PREFETCH(cbeg);
  RW_STASH();
  __syncthreads();
  for (int cix = cbeg; cix < cend; ++cix) {
    int plo, slo, shi;
    RW_GEOM(cix, plo, slo, shi);
#pragma unroll
    for (int k = 0; k < 2; ++k) {
      const int i = (tid >> 4) + 16 * k;
      const int ri = (d == 0) ? i + 1 : 32 - i;
      const bf16_t* r0 = raw + ri * 192 + lc;
      const bf16_t* q0 = pre + (ri - 1) * 192 + lc;
      float rs[4], ksv[4], vs[4];
#pragma unroll
      for (int sl = 0; sl < 3; ++sl) {
        const uint2 uc = *(const uint2*)(r0 + sl * 64), up = *(const uint2*)(r0 + sl * 64 - 192), un = *(const uint2*)(r0 + sl * 64 + 192);
        const float4 m0 = (sl == 0) ? m0r : ((sl == 1) ? m0k : m0v);
        const float4 m1 = (sl == 0) ? m1r : ((sl == 1) ? m1k : m1v);
        float* dst = (sl == 0) ? rs : ((sl == 1) ? ksv : vs);
        float u, a, n;
        u = __uint_as_float(uc.x << 16); a = __uint_as_float(up.x << 16); n = __uint_as_float(un.x << 16);
        dst[0] = u + m0.x * (a - u) + m1.x * (n - u);
        u = __uint_as_float(uc.x & 0xffff0000u); a = __uint_as_float(up.x & 0xffff0000u); n = __uint_as_float(un.x & 0xffff0000u);
        dst[1] = u + m0.y * (a - u) + m1.y * (n - u);
        u = __uint_as_float(uc.y << 16); a = __uint_as_float(up.y << 16); n = __uint_as_float(un.y << 16);
        dst[2] = u + m0.z * (a - u) + m1.z * (n - u);
        u = __uint_as_float(uc.y & 0xffff0000u); a = __uint_as_float(up.y & 0xffff0000u); n = __uint_as_float(un.y & 0xffff0000u);
        dst[3] = u + m0.w * (a - u) + m1.w * (n - u);
      }
      const uint2 ue = *(const uint2*)(q0), ua = *(const uint2*)(q0 + 64), uk = *(const uint2*)(q0 + 128);
      const float ew[4] = {__uint_as_float(ue.x << 16), __uint_as_float(ue.x & 0xffff0000u), __uint_as_float(ue.y << 16), __uint_as_float(ue.y & 0xffff0000u)};
      const float av[4] = {__uint_as_float(ua.x << 16), __uint_as_float(ua.x & 0xffff0000u), __uint_as_float(ua.y << 16), __uint_as_float(ua.y & 0xffff0000u)};
      const float kk[4] = {__uint_as_float(uk.x << 16), __uint_as_float(uk.x & 0xffff0000u), __uint_as_float(uk.y << 16), __uint_as_float(uk.y & 0xffff0000u)};
      const float kav[4] = {ka4.x, ka4.y, ka4.z, ka4.w};
      float4 o0, o1, o2, o3, o4, o5;
      float* f0 = (float*)&o0; float* f1 = (float*)&o1; float* f2 = (float*)&o2; float* f3 = (float*)&o3; float* f4 = (float*)&o4; float* f5 = (float*)&o5;
#pragma unroll
      for (int e = 0; e < 4; ++e) {
        f0[e] = __expf(-ew[e]);
        f1[e] = kk[e];
        f2[e] = kk[e] * av[e];
        f3[e] = ksv[e] * (1.f + (av[e] - 1.f) * kav[e]);
        f4[e] = rs[e];
        f5[e] = vs[e];
      }
      float* rp = rec + i * 384 + lc;
      *(float4*)(rp) = o0; *(float4*)(rp + 64) = o1; *(float4*)(rp + 128) = o2;
      *(float4*)(rp + 192) = o3; *(float4*)(rp + 256) = o4; *(float4*)(rp + 320) = o5;
    }
    __syncthreads();
    if (cix + 1 < cend) RW_PREFETCH(cix + 1);
    {
      const float* rp = rec + c0;
      const float* vp = rec + 320 + row;
      float4 w4 = *(const float4*)(rp), kk4 = *(const float4*)(rp + 64), kb4 = *(const float4*)(rp + 128);
      float4 kd4 = *(const float4*)(rp + 192), r4 = *(const float4*)(rp + 256);
      float v = vp[0];
      float ykeep = 0.f, gkeep = 0.f;
#pragma unroll 2
      for (int i = 0; i < 32; ++i) {
        const int inx = (i + 1) & 31;
        const float4 nw4 = *(const float4*)(rp + inx * 384), nkk4 = *(const float4*)(rp + inx * 384 + 64), nkb4 = *(const float4*)(rp + inx * 384 + 128);
        const float4 nkd4 = *(const float4*)(rp + inx * 384 + 192), nr4 = *(const float4*)(rp + inx * 384 + 256);
        const float nv = vp[inx * 384];
        v2f t = sA * (v2f){kk4.x, kk4.y};
        t = sB * (v2f){kk4.z, kk4.w} + t;
        float sa = t.x + t.y, ia = 0.f;
        if (DUAL) {
          v2f ti = iA * (v2f){kk4.x, kk4.y};
          ti = iB * (v2f){kk4.z, kk4.w} + ti;
          ia = ti.x + ti.y;
          sa += dppf<0xB1>(sa); ia += dppf<0xB1>(ia);
          sa += dppf<0x4E>(sa); ia += dppf<0x4E>(ia);
          sa += dppf<0x141>(sa); ia += dppf<0x141>(ia);
          sa += dppf<0x140>(sa); ia += dppf<0x140>(ia);
        } else {
          sa = sum16(sa);
        }
        v2f cA = sA * (v2f){w4.x, w4.y} + (v2f){kd4.x, kd4.y} * v;
        v2f cB = sB * (v2f){w4.z, w4.w} + (v2f){kd4.z, kd4.w} * v;
        sA = cA - (v2f){kb4.x, kb4.y} * sa;
        sB = cB - (v2f){kb4.z, kb4.w} * sa;
        v2f u = sA * (v2f){r4.x, r4.y};
        u = sB * (v2f){r4.z, r4.w} + u;
        float y = u.x + u.y, g = 0.f;
        if (DUAL) {
          iA = iA * (v2f){w4.x, w4.y} - (v2f){kb4.x, kb4.y} * ia;
          iB = iB * (v2f){w4.z, w4.w} - (v2f){kb4.z, kb4.w} * ia;
          v2f ui = iA * (v2f){r4.x, r4.y};
          ui = iB * (v2f){r4.z, r4.w} + ui;
          g = ui.x + ui.y;
          y += dppf<0xB1>(y); g += dppf<0xB1>(g);
          y += dppf<0x4E>(y); g += dppf<0x4E>(g);
          y += dppf<0x141>(y); g += dppf<0x141>(g);
          y += dppf<0x140>(y); g += dppf<0x140>(g);
          if (fr == (i & 15)) gkeep = g;
        } else {
          y = sum16(y);
        }
        if (fr == (i & 15)) ykeep = y;
        if ((i & 15) == 15) {
          const int ii = (i & 16) + fr;
          const int ri = (d == 0) ? ii + 1 : 32 - ii;
          const int pi = plo - 1 + ri;
          p.yR[((size_t)d * TOK + rowbase + pi) * 256 + h * 64 + row] = f2bf(ykeep);
          if (DUAL) p.GID[((size_t)(d * 4 + b) * NSEG1 + (cix - CSPLIT) * 32 + ii) * 256 + h * 64 + row] = f2bf(gkeep);
        }
        w4 = nw4; kk4 = nkk4; kb4 = nkb4; kd4 = nkd4; r4 = nr4; v = nv;
      }
    }
    if (cix + 1 < cend) RW_STASH();
    __syncthreads();
  }
  if (part == 0) *(float4*)(p.SMID + ((size_t)(((d * 4 + b) * 4 + h) * 64 + row)) * 64 + c0) = make_float4(sA.x, sA.y, sB.x, sB.y);
}

__device__ __forceinline__ void rwkv_fix_tile(const Params& p, int tile) {
  const int mb = tile % (NSEG1 / 64), dbh = tile / (NSEG1 / 64), h = dbh & 3, b = (dbh >> 2) & 3, d = dbh >> 4;
  const int tid = launder(threadIdx.x), lane = tid & 63, w = tid >> 6, fr = lane & 15, fq = lane >> 4;
  const size_t rowbase = (size_t)b * TPB;
  const int s0 = mb * 64 + 16 * w;
  const bf16_t* gp = p.GID + ((size_t)(d * 4 + b) * NSEG1 + s0 + fr) * 256 + h * 64 + fq * 8;
  const bf16x8 a0 = *(const bf16x8*)gp, a1 = *(const bf16x8*)(gp + 32);
#pragma unroll
  for (int nt = 0; nt < 4; ++nt) {
    const float* sp = p.SMID + ((size_t)(dbh * 64 + nt * 16 + fr)) * 64 + fq * 8;
    const float4 f0 = *(const float4*)sp, f1 = *(const float4*)(sp + 4), f2 = *(const float4*)(sp + 32), f3 = *(const float4*)(sp + 36);
    union { unsigned u[4]; bf16x8 v; } b0, b1;
    b0.u[0] = pack2(f0.x, f0.y); b0.u[1] = pack2(f0.z, f0.w); b0.u[2] = pack2(f1.x, f1.y); b0.u[3] = pack2(f1.z, f1.w);
    b1.u[0] = pack2(f2.x, f2.y); b1.u[1] = pack2(f2.z, f2.w); b1.u[2] = pack2(f3.x, f3.y); b1.u[3] = pack2(f3.z, f3.w);
    f32x4 acc = (f32x4){0.f, 0.f, 0.f, 0.f};
    acc = MFMA(a0, b0.v, acc);
    acc = MFMA(a1, b1.v, acc);
#pragma unroll
    for (int j = 0; j < 4; ++j) {
      const int st = CSPLIT * 32 + s0 + fq * 4 + j;
      const int pp = (d == 0) ? st : ((st < 256) ? 255 - st : 4607 - st);
      bf16_t* yp = p.yR + ((size_t)d * TOK + rowbase + pp) * 256 + h * 64 + nt * 16 + fr;
      *yp = f2bf(bf2f(*yp) + acc[j]);
    }
  }
}
__device__ __forceinline__ void phase_rwkvfix(const Params& p) {
  for (int t = blockIdx.x; t < 32 * (NSEG1 / 64); t += gridDim.x) rwkv_fix_tile(p, t);
}

__device__ __forceinline__ void ssd_conv_tile(const Params& p, int l, int tile, unsigned char* smem) {
  const int b = tile >> 7, t34 = tile & 127, pp0 = t34 * 34;
  const size_t r0 = (size_t)b * TPB + pp0;
  bf16_t* T = (bf16_t*)smem;
  const int tid = launder(threadIdx.x);
  for (int q = tid; q < 34 * 112; q += 256) {
    const int rr = q / 112, cc = q % 112;
    *(uint4*)(T + (rr + 1) * 896 + cc * 8) = *(const uint4*)(p.PS + (r0 + rr) * 912 + cc * 8);
  }
  if (tid < 224) {
    const int which = tid / 112, cc = tid % 112;
    const bool ex = (which == 0) ? (t34 >= 1) : (t34 + 1 < 128);
    uint4 v = make_uint4(0, 0, 0, 0);
    if (ex) v = *(const uint4*)(p.HALO + ((size_t)(b * 128 + t34) * 2 + which) * 896 + cc * 8);
    *(uint4*)(T + (which ? 35 : 0) * 896 + cc * 8) = v;
  }
  __syncthreads();
  const float* cw = p.ssm_conv_w + (size_t)l * 3 * 896;
  const float* cb = p.ssm_conv_b + (size_t)l * 896;
  for (int c = tid; c < 896; c += 256) {
    const float w0 = cw[c], w1 = cw[896 + c], w2 = cw[1792 + c], bs = cb[c];
    float um = bf2f(T[c]), u0 = bf2f(T[896 + c]);
#pragma unroll 2
    for (int rr = 0; rr < 34; ++rr) {
      const float up = bf2f(T[(rr + 2) * 896 + c]);
      const int pp = pp0 + rr;
      const bool pv = (pp != 0) && (pp != 256), nv = (pp != 255) && (pp != 4351);
      const float v = w0 * (pv ? um : 0.f) + w1 * u0 + w2 * (nv ? up : 0.f) + bs;
      p.PS[(r0 + rr) * 912 + c] = f2bf(siluf_(v));
      um = u0; u0 = up;
    }
  }
  __syncthreads();
}
__device__ __forceinline__ void ssd_dtcum_tile(const Params& p, int l, int tile, unsigned char* smem) {
  const int b = tile / 136, c32 = tile % 136, p0 = c32 * 32;
  float* draw = (float*)smem;
  const int tid = launder(threadIdx.x);
  for (int q = tid; q < 384; q += 256) {
    const int i = q / 12, dh = q % 12;
    draw[q] = bf2f(p.PS[((size_t)b * TPB + p0 + i) * 912 + 896 + dh]);
  }
  __syncthreads();
  if (tid < 12) {
    const int dh = tid, d = dh / 6, h = dh % 6;
    const float a_neg = -__expf(p.ssm_a_log[(l * 2 + d) * 6 + h]);
    const float bias = p.ssm_dt_bias[(l * 2 + d) * 6 + h];
    float cum = 0.f;
    for (int k = 0; k < 32; ++k) {
      const int it = (d == 0) ? k : 31 - k;
      const float dt = softplusf_(draw[it * 12 + dh] + bias);
      cum += dt * a_neg;
      p.DTC[(size_t)dh * TOK + (size_t)b * TPB + p0 + it] = make_float2(dt, cum);
    }
  }
  __syncthreads();
}

__device__ __forceinline__ void ssd_tile(const Params& p, int l, int tile, unsigned char* smem) {
  const int h = tile % 6, b = (tile / 6) & 3, d = tile / 24, g = h / 3;
  bf16_t* Cs0 = (bf16_t*)smem;
  bf16_t* Bs = Cs0 + 2 * 32 * 136;
  bf16_t* Xs = Bs + 32 * 136;
  bf16_t* BtT = Xs + 32 * 72;
  bf16_t* XdT = BtT + 128 * 40;
  bf16_t* Ms = XdT + 64 * 40;
  bf16_t* Sb = Ms + 32 * 40;
  float* dc = (float*)(Sb + 64 * 136);
  const int tid = launder(threadIdx.x), lane = tid & 63, w = tid >> 6, fr = lane & 15, fq = lane >> 4;
  const size_t rowbase = (size_t)b * TPB;
  f32x4 S[4][2];
#pragma unroll
  for (int i = 0; i < 4; ++i)
#pragma unroll
    for (int j = 0; j < 2; ++j) S[i][j] = (f32x4){0.f, 0.f, 0.f, 0.f};
  const int pcc = tid % 40, prow = tid / 40;
  const bool pact = tid < 240;
  const int pcol = (pcc < 16) ? (640 + g * 128 + pcc * 8) : ((pcc < 32) ? (384 + g * 128 + (pcc - 16) * 8) : (h * 64 + (pcc - 32) * 8));
  const bf16_t* pbase = p.PS + rowbase * 912 + pcol;
  const float2* dbase = p.DTC + (size_t)(d * 6 + h) * TOK + rowbase;
  const int drow_stride = (pcc < 32) ? 136 : 72;
  uint4 pf0, pf1, pf2, pf3, pf4, pf5;
  float2 dtc = make_float2(0.f, 0.f);
#define SD_GEOM(cix_, plo_)                                                \
  {                                                                        \
    const int st0_ = (cix_) * 32;                                          \
    if (st0_ < 256) plo_ = (d == 0) ? st0_ : 224 - st0_;                   \
    else plo_ = (d == 0) ? st0_ : 4576 - st0_;                             \
  }
#define SD_PF1(dst_, rr_, plo_)                                                                   \
  {                                                                                               \
    dst_ = make_uint4(0, 0, 0, 0);                                                                \
    if (pact && (rr_) < 32) dst_ = *(const uint4*)(pbase + (size_t)((plo_) + (rr_)) * 912);       \
  }
#define SD_PREFETCH(cix_)                                                          \
  {                                                                                \
    int plo_;                                                                      \
    SD_GEOM(cix_, plo_);                                                           \
    SD_PF1(pf0, prow, plo_); SD_PF1(pf1, prow + 6, plo_); SD_PF1(pf2, prow + 12, plo_); \
    SD_PF1(pf3, prow + 18, plo_); SD_PF1(pf4, prow + 24, plo_); SD_PF1(pf5, prow + 30, plo_); \
    if (tid < 32) dtc = dbase[plo_ + tid];                                         \
  }
#define SD_ST1(src_, rr_, cbuf_)                                                                  \
  {                                                                                               \
    if (pact && (rr_) < 32) {                                                                     \
      const int i_ = (d == 0) ? (rr_) : 31 - (rr_);                                               \
      bf16_t* dst_ = (pcc < 16) ? ((cbuf_) + i_ * 136 + pcc * 8) : ((pcc < 32) ? (Bs + i_ * 136 + (pcc - 16) * 8) : (Xs + i_ * 72 + (pcc - 32) * 8)); \
      *(uint4*)dst_ = src_;                                                                       \
    }                                                                                             \
  }
#define SD_STASH(buf_)                                                              \
  {                                                                                 \
    bf16_t* cbuf_ = Cs0 + (buf_) * 32 * 136;                                        \
    SD_ST1(pf0, prow, cbuf_); SD_ST1(pf1, prow + 6, cbuf_); SD_ST1(pf2, prow + 12, cbuf_); \
    SD_ST1(pf3, prow + 18, cbuf_); SD_ST1(pf4, prow + 24, cbuf_); SD_ST1(pf5, prow + 30, cbuf_); \
    if (tid < 32) {                                                                 \
      const int i_ = (d == 0) ? tid : 31 - tid;                                     \
      dc[(buf_) * 64 + i_] = dtc.x;                                                 \
      dc[(buf_) * 64 + 32 + i_] = dtc.y;                                            \
    }                                                                               \
  }
  (void)drow_stride;
  SD_PREFETCH(0);
  SD_STASH(0);
  __syncthreads();
  for (int cix = 0; cix < 136; ++cix) {
    int plo;
    SD_GEOM(cix, plo);
    const int buf = cix & 1;
    const bf16_t* Cs = Cs0 + buf * 32 * 136;
    const float* dts = dc + buf * 64;
    const float* cums = dts + 32;
    {
      const int j = tid & 31, ng = tid >> 5;
      const float tail = __expf(cums[31] - cums[j]);
      const float dtj = dts[j];
      const uint4 b0 = *(const uint4*)(Bs + j * 136 + ng * 16), b1 = *(const uint4*)(Bs + j * 136 + ng * 16 + 8);
      const uint4 x0 = *(const uint4*)(Xs + j * 72 + ng * 8);
      const unsigned bw[8] = {b0.x, b0.y, b0.z, b0.w, b1.x, b1.y, b1.z, b1.w};
      const unsigned xw[4] = {x0.x, x0.y, x0.z, x0.w};
#pragma unroll
      for (int e = 0; e < 8; ++e) {
        const unsigned pk = pack2(__uint_as_float(bw[e] << 16) * tail, __uint_as_float(bw[e] & 0xffff0000u) * tail);
        BtT[(ng * 16 + 2 * e) * 40 + j] = (bf16_t)(pk & 0xffffu);
        BtT[(ng * 16 + 2 * e + 1) * 40 + j] = (bf16_t)(pk >> 16);
      }
#pragma unroll
      for (int e = 0; e < 4; ++e) {
        const unsigned pk = pack2(__uint_as_float(xw[e] << 16) * dtj, __uint_as_float(xw[e] & 0xffff0000u) * dtj);
        XdT[(ng * 8 + 2 * e) * 40 + j] = (bf16_t)(pk & 0xffffu);
        XdT[(ng * 8 + 2 * e + 1) * 40 + j] = (bf16_t)(pk >> 16);
      }
#pragma unroll
      for (int mt = 0; mt < 4; ++mt)
#pragma unroll
        for (int t = 0; t < 2; ++t)
#pragma unroll
          for (int jj = 0; jj < 4; ++jj) Sb[(mt * 16 + fq * 4 + jj) * 136 + (2 * w + t) * 16 + fr] = f2bf(S[mt][t][jj]);
      const int mi = w >> 1, nj = w & 1;
      f32x4 acc = (f32x4){0.f, 0.f, 0.f, 0.f};
#pragma unroll
      for (int ks = 0; ks < 4; ++ks) {
        bf16x8 a = *(const bf16x8*)(Cs + (mi * 16 + fr) * 136 + ks * 32 + fq * 8);
        bf16x8 bb = *(const bf16x8*)(Bs + (nj * 16 + fr) * 136 + ks * 32 + fq * 8);
        acc = MFMA(a, bb, acc);
      }
      const int jc = nj * 16 + fr;
      const float cj = cums[jc];
#pragma unroll
      for (int jj = 0; jj < 4; ++jj) {
        const int i = mi * 16 + fq * 4 + jj;
        const float v = (jc <= i) ? acc[jj] * __expf(cums[i] - cj) : 0.f;
        Ms[i * 40 + jc] = f2bf(v);
      }
    }
    __syncthreads();
    if (cix + 1 < 136) SD_PREFETCH(cix + 1);
    {
      const int mi = w >> 1;
      bf16x8 am = *(const bf16x8*)(Ms + (mi * 16 + fr) * 40 + fq * 8);
      bf16x8 ac[4];
#pragma unroll
      for (int ks = 0; ks < 4; ++ks) ac[ks] = *(const bf16x8*)(Cs + (mi * 16 + fr) * 136 + ks * 32 + fq * 8);
#pragma unroll
      for (int t = 0; t < 2; ++t) {
        const int pt = 2 * (w & 1) + t;
        f32x4 y1 = (f32x4){0.f, 0.f, 0.f, 0.f}, y2 = (f32x4){0.f, 0.f, 0.f, 0.f};
        bf16x8 bx = *(const bf16x8*)(XdT + (pt * 16 + fr) * 40 + fq * 8);
        y1 = MFMA(am, bx, y1);
#pragma unroll
        for (int ks = 0; ks < 4; ++ks) {
          bf16x8 bs = *(const bf16x8*)(Sb + (pt * 16 + fr) * 136 + ks * 32 + fq * 8);
          y2 = MFMA(ac[ks], bs, y2);
        }
#pragma unroll
        for (int jj = 0; jj < 4; ++jj) {
          const int i = mi * 16 + fq * 4 + jj;
          const int pi = plo + ((d == 0) ? i : 31 - i);
          const float y = y1[jj] + __expf(cums[i]) * y2[jj];
          p.yS[((size_t)d * TOK + rowbase + pi) * 384 + h * 64 + pt * 16 + fr] = f2bf(y);
        }
      }
      const float dec = __expf(cums[31]);
      bf16x8 bt[2];
#pragma unroll
      for (int t = 0; t < 2; ++t) bt[t] = *(const bf16x8*)(BtT + ((2 * w + t) * 16 + fr) * 40 + fq * 8);
#pragma unroll
      for (int mt = 0; mt < 4; ++mt) {
        bf16x8 ax = *(const bf16x8*)(XdT + (mt * 16 + fr) * 40 + fq * 8);
#pragma unroll
        for (int t = 0; t < 2; ++t) {
          S[mt][t] *= dec;
          S[mt][t] = MFMA(ax, bt[t], S[mt][t]);
        }
      }
    }
    if (cix + 1 < 136) SD_STASH(buf ^ 1);
    __syncthreads();
  }
}

__device__ __forceinline__ void attn_tile(const Params& p, int l, int tile, unsigned char* smem) {
  const bool isctx = tile >= 768;
  int qt, head, b;
  if (!isctx) { qt = tile & 31; head = (tile >> 5) % 6; b = tile / 192; }
  else { int tt = tile - 768; qt = tt & 1; head = (tt >> 1) % 6; b = tt / 12; }
  const int hkv = head / 3;
  const int tid = launder(threadIdx.x), lane = tid & 63, w = tid >> 6, fr = lane & 15, fq = lane >> 4;
  bf16_t* Ks = (bf16_t*)smem;
  bf16_t* Vt = Ks + 64 * 72;
  bf16_t* Ps = Vt + 64 * 72 + w * 32 * 72;
  const int q0 = qt * 128;
  const size_t rowb = (size_t)b * TPB;
  const size_t rowq0 = rowb + (isctx ? q0 : 256 + q0);
  bf16x8 qf[2][2];
  float m[2][4], ls[2][4];
  f32x4 o[2][4];
  const float sk = p.attn_sink[l * 6 + head];
#pragma unroll
  for (int mt = 0; mt < 2; ++mt) {
    const int qi0 = (2 * w + mt) * 16;
#pragma unroll
    for (int ks = 0; ks < 2; ++ks) qf[mt][ks] = *(const bf16x8*)(p.PA + (rowq0 + qi0 + fr) * 1024 + head * 64 + ks * 32 + fq * 8);
#pragma unroll
    for (int j = 0; j < 4; ++j) { m[mt][j] = sk; ls[mt][j] = 1.f; }
#pragma unroll
    for (int nt = 0; nt < 4; ++nt) o[mt][nt] = (f32x4){0.f, 0.f, 0.f, 0.f};
  }
  int klo = 0, nb = 0;
  if (!isctx) {
    klo = max(0, q0 - 128);
    const int khi = min(4096, q0 + 256);
    nb = (khi - klo) >> 6;
  }
  const int ntile = nb + 4;
  const int lr = tid >> 3, lc = tid & 7;
  uint4 kr0, kr1, vr0, vr1;
#define KVLOAD(kt_)                                                                              \
  {                                                                                              \
    const size_t kr0_ = ((kt_) < nb) ? rowb + 256 + klo + (kt_) * 64 : rowb + ((kt_) - nb) * 64; \
    const bf16_t* src0 = p.PA + (kr0_ + lr) * 1024 + 384 + hkv * 64 + lc * 8;                    \
    const bf16_t* src1 = src0 + 32 * 1024;                                                       \
    kr0 = *(const uint4*)src0;                                                                   \
    vr0 = *(const uint4*)(src0 + 128);                                                           \
    kr1 = *(const uint4*)src1;                                                                   \
    vr1 = *(const uint4*)(src1 + 128);                                                           \
  }
#define VTSTORE(vr_, rr_)                                                 \
  {                                                                       \
    Vt[(lc * 8 + 0) * 72 + (rr_)] = (bf16_t)((vr_).x & 0xffffu);          \
    Vt[(lc * 8 + 1) * 72 + (rr_)] = (bf16_t)((vr_).x >> 16);              \
    Vt[(lc * 8 + 2) * 72 + (rr_)] = (bf16_t)((vr_).y & 0xffffu);          \
    Vt[(lc * 8 + 3) * 72 + (rr_)] = (bf16_t)((vr_).y >> 16);              \
    Vt[(lc * 8 + 4) * 72 + (rr_)] = (bf16_t)((vr_).z & 0xffffu);          \
    Vt[(lc * 8 + 5) * 72 + (rr_)] = (bf16_t)((vr_).z >> 16);              \
    Vt[(lc * 8 + 6) * 72 + (rr_)] = (bf16_t)((vr_).w & 0xffffu);          \
    Vt[(lc * 8 + 7) * 72 + (rr_)] = (bf16_t)((vr_).w >> 16);              \
  }
  KVLOAD(0);
  for (int kt = 0; kt < ntile; ++kt) {
    __syncthreads();
    *(uint4*)(Ks + lr * 72 + lc * 8) = kr0;
    *(uint4*)(Ks + (lr + 32) * 72 + lc * 8) = kr1;
    VTSTORE(vr0, lr);
    VTSTORE(vr1, lr + 32);
    __syncthreads();
    if (kt + 1 < ntile) KVLOAD(kt + 1);
    f32x4 s[2][4];
#pragma unroll
    for (int mt = 0; mt < 2; ++mt)
#pragma unroll
      for (int nt = 0; nt < 4; ++nt) s[mt][nt] = (f32x4){0.f, 0.f, 0.f, 0.f};
#pragma unroll
    for (int ks = 0; ks < 2; ++ks) {
#pragma unroll
      for (int nt = 0; nt < 4; ++nt) {
        bf16x8 kb = *(const bf16x8*)(Ks + (nt * 16 + fr) * 72 + ks * 32 + fq * 8);
#pragma unroll
        for (int mt = 0; mt < 2; ++mt) s[mt][nt] = MFMA(qf[mt][ks], kb, s[mt][nt]);
      }
    }
    const bool band = kt < nb;
    const int kp0 = klo + kt * 64 + fr;
#pragma unroll
    for (int mt = 0; mt < 2; ++mt) {
      const int qi0 = (2 * w + mt) * 16;
#pragma unroll
      for (int j = 0; j < 4; ++j) {
        const int qp = q0 + qi0 + fq * 4 + j;
        float sv0 = s[mt][0][j], sv1 = s[mt][1][j], sv2 = s[mt][2][j], sv3 = s[mt][3][j];
        if (band) {
          const int dlt = qp - kp0;
          if (dlt > 128 || dlt < -128) sv0 = -INFINITY;
          if (dlt - 16 > 128 || dlt - 16 < -128) sv1 = -INFINITY;
          if (dlt - 32 > 128 || dlt - 32 < -128) sv2 = -INFINITY;
          if (dlt - 48 > 128 || dlt - 48 < -128) sv3 = -INFINITY;
        }
        float mx = fmaxf(fmaxf(sv0, sv1), fmaxf(sv2, sv3));
        mx = max16(mx);
        const float mn = fmaxf(m[mt][j], mx);
        const float alpha = __expf(m[mt][j] - mn);
        const float p0 = __expf(sv0 - mn), p1 = __expf(sv1 - mn), p2 = __expf(sv2 - mn), p3 = __expf(sv3 - mn);
        bf16_t* pr = Ps + (mt * 16 + fq * 4 + j) * 72 + fr;
        pr[0] = f2bf(p0); pr[16] = f2bf(p1); pr[32] = f2bf(p2); pr[48] = f2bf(p3);
        const float rsum = sum16(p0 + p1 + p2 + p3);
        ls[mt][j] = ls[mt][j] * alpha + rsum;
        m[mt][j] = mn;
#pragma unroll
        for (int nt = 0; nt < 4; ++nt) o[mt][nt][j] *= alpha;
      }
    }
    __builtin_amdgcn_wave_barrier();
#pragma unroll
    for (int ks = 0; ks < 2; ++ks) {
      bf16x8 pa[2];
#pragma unroll
      for (int mt = 0; mt < 2; ++mt) pa[mt] = *(const bf16x8*)(Ps + (mt * 16 + fr) * 72 + ks * 32 + fq * 8);
#pragma unroll
      for (int nt = 0; nt < 4; ++nt) {
        bf16x8 vb = *(const bf16x8*)(Vt + (nt * 16 + fr) * 72 + ks * 32 + fq * 8);
#pragma unroll
        for (int mt = 0; mt < 2; ++mt) o[mt][nt] = MFMA(pa[mt], vb, o[mt][nt]);
      }
    }
    __builtin_amdgcn_wave_barrier();
  }
#pragma unroll
  for (int mt = 0; mt < 2; ++mt) {
    const int qi0 = (2 * w + mt) * 16;
#pragma unroll
    for (int j = 0; j < 4; ++j) {
      const size_t r = rowq0 + qi0 + fq * 4 + j;
      const float inv = frcp(ls[mt][j]);
#pragma unroll
      for (int nt = 0; nt < 4; ++nt) {
        const int dc = nt * 16 + fr;
        const float gt = bf2f(p.PA[r * 1024 + 640 + head * 64 + dc]);
        p.PA[r * 1024 + head * 64 + dc] = f2bf(o[mt][nt][j] * inv * siluf_(gt));
      }
    }
  }
  __syncthreads();
}

#ifndef PROBE_DUP
#define PROBE_DUP 0
#endif
__device__ __forceinline__ void phase_probe(const Params& p, int l, unsigned char* smem) {
  if (PROBE_DUP == 1) { for (int t = blockIdx.x; t < 256; t += gridDim.x) { if (t < 128) rwkv_tile<false>(p, l, t, smem); else rwkv_tile<true>(p, l, t, smem); } }
  if (PROBE_DUP == 2) { for (int t = blockIdx.x; t < 48; t += gridDim.x) ssd_tile(p, l, t, smem); }
}
__device__ __forceinline__ void phase_mixers(const Params& p, int l, unsigned char* smem) {
  const int natt = (l == 0) ? 816 : 768;
  const int bid = blockIdx.x, G = gridDim.x;
  if (G == 512) {
    if (bid < 128) {
      __builtin_amdgcn_s_setprio(3);
      rwkv_tile<false>(p, l, bid, smem);
      __builtin_amdgcn_s_setprio(0);
    } else if (bid < 256) {
      __builtin_amdgcn_s_setprio(3);
      rwkv_tile<true>(p, l, bid, smem);
      __builtin_amdgcn_s_setprio(0);
    } else if (bid < 304) {
      __builtin_amdgcn_s_setprio(2);
      ssd_tile(p, l, bid - 256, smem);
      __builtin_amdgcn_s_setprio(0);
    }
    int* tsl = (int*)(smem + 73728);
    const int tid = launder(threadIdx.x);
    if (l == 0) {
      for (;;) {
        __syncthreads();
        if (tid == 0) *tsl = (int)atomicAdd(&p.ctrs[2], 1u);
        __syncthreads();
        const int t = *tsl;
        if (t >= 1440) break;
        deferred_transpose(p, t, smem);
      }
    }
    for (;;) {
      __syncthreads();
      if (tid == 0) *tsl = (int)atomicAdd(&p.ctrs[l], 1u);
      __syncthreads();
      const int t = *tsl;
      if (t >= natt) break;
      attn_tile(p, l, t, smem);
    }
    for (;;) {
      __syncthreads();
      if (tid == 0) *tsl = (int)atomicAdd(&p.ctrs[4 + l], 1u);
      __syncthreads();
      const int j = *tsl;
      if (j >= 136 * 5) break;
      gemm_late_tile(p, l, j / 5, 16 + j % 5, smem);
    }
  } else {
    if (l == 0) for (int t = bid; t < 1440; t += G) deferred_transpose(p, t, smem);
    for (int t = bid; t < 136 * 5; t += G) gemm_late_tile(p, l, t / 5, 16 + t % 5, smem);
    const int total = 304 + natt;
    for (int t = bid; t < total; t += G) {
      if (t < 128) rwkv_tile<false>(p, l, t, smem);
      else if (t < 256) rwkv_tile<true>(p, l, t, smem);
      else if (t < 304) ssd_tile(p, l, t - 256, smem);
      else attn_tile(p, l, t - 304, smem);
    }
  }
}

__device__ __forceinline__ float blo(unsigned u) { return __uint_as_float(u << 16); }
__device__ __forceinline__ float bhi(unsigned u) { return __uint_as_float(u & 0xffff0000u); }
__device__ __forceinline__ void phase_finish(const Params& p, int l) {
  const int tid = launder(threadIdx.x), lane = tid & 63, w = tid >> 6;
  bf16_t* mix = p.hbuf;
  const int cg_ = lane * 4, hh4 = lane >> 4;
  const float* mu0 = p.rwkv_mu + (size_t)(l * 2) * 1024 + cg_;
  const float* mu1 = mu0 + 1024;
  const float4 m0r = *(const float4*)mu0, m1r = *(const float4*)mu1;
  const float4 m0k = *(const float4*)(mu0 + 256), m1k = *(const float4*)(mu1 + 256);
  const float4 m0v = *(const float4*)(mu0 + 512), m1v = *(const float4*)(mu1 + 512);
  const float4 rk4 = *(const float4*)(p.rwkv_r_k + l * 256 + hh4 * 64 + (cg_ & 63));
  const float4 lw4 = *(const float4*)(p.rwkv_ln_w + l * 256 + cg_), lb4 = *(const float4*)(p.rwkv_ln_b + l * 256 + cg_);
  const int cs_ = lane * 6;
  const float2 nw0 = *(const float2*)(p.ssm_norm_w + l * 384 + cs_), nw1 = *(const float2*)(p.ssm_norm_w + l * 384 + cs_ + 2), nw2 = *(const float2*)(p.ssm_norm_w + l * 384 + cs_ + 4);
  const float dsk0 = p.ssm_d[l * 6 + (cs_ >> 6)], dsk1 = p.ssm_d[l * 6 + ((cs_ + 2) >> 6)], dsk2 = p.ssm_d[l * 6 + ((cs_ + 4) >> 6)];
  for (int t = blockIdx.x; t < TOK / 4; t += gridDim.x) {
    const int r = t * 4 + w, pp = r % TPB;
    if (l == 1 && pp < 256) continue;
    const bool isc = pp < 256;
    const int slo = isc ? 0 : 256, shi = isc ? 255 : 4351;
    const bool hp = pp > slo, hn = pp < shi;
    const unsigned* a32 = (const unsigned*)(p.PA + (size_t)r * 1024 + lane * 6);
    const unsigned at0 = a32[0], at1 = a32[1], at2 = a32[2];
    const uint2 ya = *(const uint2*)(p.yR + (size_t)r * 256 + cg_);
    const uint2 yb = *(const uint2*)(p.yR + ((size_t)TOK + r) * 256 + cg_);
    const bf16_t* pr = p.PR + (size_t)r * 1024 + cg_;
    const uint2 z2 = make_uint2(0u, 0u);
    const uint2 rc = *(const uint2*)pr, kc = *(const uint2*)(pr + 256), vc = *(const uint2*)(pr + 512);
    const uint2 rp = hp ? *(const uint2*)(pr - 1024) : z2, kp = hp ? *(const uint2*)(pr + 256 - 1024) : z2, vp = hp ? *(const uint2*)(pr + 512 - 1024) : z2;
    const uint2 rn = hn ? *(const uint2*)(pr + 1024) : z2, kn = hn ? *(const uint2*)(pr + 256 + 1024) : z2, vn = hn ? *(const uint2*)(pr + 512 + 1024) : z2;
    const uint2 g2 = *(const uint2*)(p.PG + (size_t)r * 640 + cg_);
    const unsigned* s0 = (const unsigned*)(p.yS + (size_t)r * 384 + cs_);
    const unsigned* s1 = (const unsigned*)(p.yS + ((size_t)TOK + r) * 384 + cs_);
    const unsigned* xs32 = (const unsigned*)(p.PS + (size_t)r * 912 + cs_);
    const unsigned* z32 = (const unsigned*)(p.PG + (size_t)r * 640 + 256 + cs_);
    const unsigned sa0 = s0[0], sa1 = s0[1], sa2 = s0[2], sb0 = s1[0], sb1 = s1[1], sb2 = s1[2];
    const unsigned xa0 = xs32[0], xa1 = xs32[1], xa2 = xs32[2], za0 = z32[0], za1 = z32[1], za2 = z32[2];
    {
      unsigned* d32 = (unsigned*)(mix + (size_t)r * 1024 + lane * 6);
      d32[0] = at0; d32[1] = at1; d32[2] = at2;
    }
    {
      float y[4] = {blo(ya.x) + blo(yb.x), bhi(ya.x) + bhi(yb.x), blo(ya.y) + blo(yb.y), bhi(ya.y) + bhi(yb.y)};
      const float sm = sum16(y[0] + y[1] + y[2] + y[3]);
      const float mean = sm * (1.f / 64.f);
      float vq = 0.f;
#pragma unroll
      for (int e = 0; e < 4; ++e) { y[e] -= mean; vq += y[e] * y[e]; }
      vq = sum16(vq);
      const float rstd = rsqrtf(vq * (1.f / 64.f) + 64e-5f);
      const float rs0 = blo(rc.x) + m0r.x * (blo(rp.x) - blo(rc.x)) + m1r.x * (blo(rn.x) - blo(rc.x));
      const float rs1 = bhi(rc.x) + m0r.y * (bhi(rp.x) - bhi(rc.x)) + m1r.y * (bhi(rn.x) - bhi(rc.x));
      const float rs2 = blo(rc.y) + m0r.z * (blo(rp.y) - blo(rc.y)) + m1r.z * (blo(rn.y) - blo(rc.y));
      const float rs3 = bhi(rc.y) + m0r.w * (bhi(rp.y) - bhi(rc.y)) + m1r.w * (bhi(rn.y) - bhi(rc.y));
      const float ks0 = blo(kc.x) + m0k.x * (blo(kp.x) - blo(kc.x)) + m1k.x * (blo(kn.x) - blo(kc.x));
      const float ks1 = bhi(kc.x) + m0k.y * (bhi(kp.x) - bhi(kc.x)) + m1k.y * (bhi(kn.x) - bhi(kc.x));
      const float ks2 = blo(kc.y) + m0k.z * (blo(kp.y) - blo(kc.y)) + m1k.z * (blo(kn.y) - blo(kc.y));
      const float ks3 = bhi(kc.y) + m0k.w * (bhi(kp.y) - bhi(kc.y)) + m1k.w * (bhi(kn.y) - bhi(kc.y));
      const float vs0 = blo(vc.x) + m0v.x * (blo(vp.x) - blo(vc.x)) + m1v.x * (blo(vn.x) - blo(vc.x));
      const float vs1 = bhi(vc.x) + m0v.y * (bhi(vp.x) - bhi(vc.x)) + m1v.y * (bhi(vn.x) - bhi(vc.x));
      const float vs2 = blo(vc.y) + m0v.z * (blo(vp.y) - blo(vc.y)) + m1v.z * (blo(vn.y) - blo(vc.y));
      const float vs3 = bhi(vc.y) + m0v.w * (bhi(vp.y) - bhi(vc.y)) + m1v.w * (bhi(vn.y) - bhi(vc.y));
      const float dot = sum16(rs0 * ks0 * rk4.x + rs1 * ks1 * rk4.y + rs2 * ks2 * rk4.z + rs3 * ks3 * rk4.w);
      const float o0 = (y[0] * rstd * lw4.x + lb4.x + dot * vs0) * siluf_(blo(g2.x));
      const float o1 = (y[1] * rstd * lw4.y + lb4.y + dot * vs1) * siluf_(bhi(g2.x));
      const float o2 = (y[2] * rstd * lw4.z + lb4.z + dot * vs2) * siluf_(blo(g2.y));
      const float o3 = (y[3] * rstd * lw4.w + lb4.w + dot * vs3) * siluf_(bhi(g2.y));
      uint2 ov;
      ov.x = pack2(o0, o1);
      ov.y = pack2(o2, o3);
      *(uint2*)(mix + (size_t)r * 1024 + 384 + cg_) = ov;
    }
    {
      const float y0 = (blo(sa0) + blo(sb0) + dsk0 * blo(xa0)) * siluf_(blo(za0));
      const float y1 = (bhi(sa0) + bhi(sb0) + dsk0 * bhi(xa0)) * siluf_(bhi(za0));
      const float y2 = (blo(sa1) + blo(sb1) + dsk1 * blo(xa1)) * siluf_(blo(za1));
      const float y3 = (bhi(sa1) + bhi(sb1) + dsk1 * bhi(xa1)) * siluf_(bhi(za1));
      const float y4 = (blo(sa2) + blo(sb2) + dsk2 * blo(xa2)) * siluf_(blo(za2));
      const float y5 = (bhi(sa2) + bhi(sb2) + dsk2 * bhi(xa2)) * siluf_(bhi(za2));
      float sq = sum16(y0 * y0 + y1 * y1 + y2 * y2 + y3 * y3 + y4 * y4 + y5 * y5);
      sq += __shfl_xor(sq, 16);
      const float rstd = rsqrtf(sq * (1.f / 192.f) + 1e-5f);
      unsigned* dd = (unsigned*)(mix + (size_t)r * 1024 + 640 + cs_);
      dd[0] = pack2(y0 * rstd * nw0.x, y1 * rstd * nw0.y);
      dd[1] = pack2(y2 * rstd * nw1.x, y3 * rstd * nw1.y);
      dd[2] = pack2(y4 * rstd * nw2.x, y5 * rstd * nw2.y);
    }
  }
}

#define XB_TMO      128
#define XB_XCNT(j)  (256  + 64 * (j))
#define XB_XSUB(j)  (1280 + 64 * (j))
#define XB_XGEN(j)  (2304 + 64 * (j))
#define XB_TOP      3328
#define XB_TOPGEN   3392
#define XCD_BAR_WORDS 3456
#define XB_SPIN_CAP (1u << 18)
#define LAS __attribute__((address_space(3)))

__device__ __forceinline__ unsigned xb_ld(unsigned* p)              { return __hip_atomic_load(p, __ATOMIC_RELAXED, __HIP_MEMORY_SCOPE_AGENT); }
__device__ __forceinline__ unsigned xb_add(unsigned* p, unsigned v) { return __hip_atomic_fetch_add(p, v, __ATOMIC_RELAXED, __HIP_MEMORY_SCOPE_AGENT); }
__device__ __forceinline__ unsigned xb_xcc_id() { return (unsigned)__builtin_amdgcn_s_getreg((3 << 11) | 20) & 0xFu; }
#define XB_SPIN(cond, bar) do { unsigned _sp = 0; while (cond) { __builtin_amdgcn_s_sleep(1); \
    if ((++_sp & 255u) == 0u) { if (xb_ld(&(bar)[XB_TMO])) break; if (_sp > XB_SPIN_CAP) { atomicAdd(&(bar)[XB_TMO], 1u); break; } } } } while (0)

struct XcdBarrier {
    unsigned* bar; unsigned x;
    volatile LAS unsigned* st;
};

__device__ __forceinline__ XcdBarrier xcd_barrier_post(unsigned* bar, volatile LAS unsigned* st) {
    XcdBarrier b; b.bar = bar; b.x = xb_xcc_id(); b.st = st;
    if (threadIdx.x == 0) (void)xb_add(&bar[XB_XCNT(b.x)], 1u);
    return b;
}
__device__ __forceinline__ void xcd_barrier_complete(unsigned* bar, unsigned x, unsigned& nloc, unsigned& nx) {
    const unsigned G = gridDim.x * gridDim.y * gridDim.z;
    unsigned sum, cnt, mine, sp = 0u;
    for (;;) {
        sum = 0u; cnt = 0u; mine = 0u;
#pragma unroll
        for (unsigned j = 0; j < 16; ++j) { const unsigned c = xb_ld(&bar[XB_XCNT(j)]); sum += c; cnt += (c > 0u) ? 1u : 0u; mine = (j == x) ? c : mine; }
        if (sum == G) break;
        __builtin_amdgcn_s_sleep(1);
        if ((++sp & 255u) == 0u) { if (xb_ld(&bar[XB_TMO])) break; if (sp > XB_SPIN_CAP) { atomicAdd(&bar[XB_TMO], 1u); break; } }
    }
    nloc = mine > 0u ? mine : 1u; nx = cnt > 0u ? cnt : 1u;
}

__device__ __forceinline__ void xcd_barrier(const XcdBarrier& b) {
    asm volatile("s_waitcnt vmcnt(0)" ::: "memory");
    __syncthreads();
    if (threadIdx.x == 0) {
        unsigned* bar = b.bar;
        __builtin_amdgcn_s_waitcnt(0);
        unsigned nloc = b.st[0], nx = b.st[1];
        if (nloc == 0u) { xcd_barrier_complete(bar, b.x, nloc, nx); b.st[0] = nloc; b.st[1] = nx; }
        const unsigned old = xb_add(&bar[XB_XSUB(b.x)], 1u);
        const unsigned gen = old / nloc;
        if (old + 1u == (gen + 1u) * nloc) {
            __builtin_amdgcn_fence(__ATOMIC_RELEASE, "agent");
            asm volatile("s_waitcnt vmcnt(0)" ::: "memory");
            const unsigned og = xb_add(&bar[XB_TOP], 1u);
            const unsigned tg = og / nx;
            if (og + 1u == (tg + 1u) * nx) xb_add(&bar[XB_TOPGEN], 1u);
            else XB_SPIN(xb_ld(&bar[XB_TOPGEN]) == tg, bar);
            __builtin_amdgcn_fence(__ATOMIC_ACQUIRE, "agent");
            xb_add(&bar[XB_XGEN(b.x)], 1u);
            asm volatile("s_waitcnt vmcnt(0)" ::: "memory");
        } else {
            XB_SPIN(xb_ld(&bar[XB_XGEN(b.x)]) == gen, bar);
            __builtin_amdgcn_fence(__ATOMIC_ACQUIRE, "agent");
            asm volatile("s_waitcnt vmcnt(0)" ::: "memory");
        }
    }
    __syncthreads();
}


__global__ void __launch_bounds__(NTHREADS, LBW) mega(Params p, int ph_lo, int ph_hi) {
  extern __shared__ __attribute__((aligned(16))) unsigned char smem[];
  volatile LAS unsigned* xst = (volatile LAS unsigned*)(smem + LDS_BYTES - 16);
  XcdBarrier xb;
  xb.bar = p.bar; xb.x = 0; xb.st = xst;
  if (ph_hi - ph_lo > 1) {
    if (threadIdx.x == 0) { xst[0] = 0u; xst[1] = 0u; }
    __syncthreads();
    xb = xcd_barrier_post(p.bar, xst);
  }
  for (int ph = ph_lo; ph < ph_hi; ++ph) {
    if (ph > ph_lo) {
      if (ph_hi > 1000) cg::this_grid().sync();
      xcd_barrier(xb);
    }
#ifndef TEST_PH
#define TEST_PH -1
#endif
    if (ph == 0) {
      if (PROBE_DUP == 4) { phase_setup(p, smem); cg::this_grid().sync(); }
      if (TEST_PH < 0 || TEST_PH == 0) phase_setup(p, smem);
    }
    else if (ph == NPHASES - 1) { if (TEST_PH < 0 || TEST_PH == 6) phase_final(p); }
    else {
      const int l = (ph - 1) / 7, s = (ph - 1) % 7;
      if (s == 0) { if (TEST_PH < 0 || TEST_PH == 1) phase_norm(p, l); }
      else if (s == 1) {
        if (PROBE_DUP == 3) { phase_inproj(p, l, smem); cg::this_grid().sync(); }
        if (TEST_PH < 0 || TEST_PH == 2) phase_inproj(p, l, smem);
      }
      else if (s == 2) {
        if (PROBE_DUP == 5) { phase_rwkvprep(p, l, smem); cg::this_grid().sync(); }
        if (TEST_PH < 0 || TEST_PH == 10) phase_rwkvprep(p, l, smem);
      }
      else if (s == 3) {
        if (PROBE_DUP == 1 || PROBE_DUP == 2) { phase_probe(p, l, smem); cg::this_grid().sync(); }
        if (TEST_PH < 0 || TEST_PH == 3 || (TEST_PH >= 7 && TEST_PH <= 9)) phase_mixers(p, l, smem);
      }
      else if (s == 4) { phase_rwkvfix(p); }
      else if (s == 5) { if (TEST_PH < 0 || TEST_PH == 4) phase_finish(p, l); }
      else { if (TEST_PH < 0 || TEST_PH == 5) phase_outproj(p, l, smem); }
    }
  }
}

extern "C" void kernel_launch(void* const* d_in, const int* in_sizes, int n_in, void* d_out, int out_size, void* d_ws,
                              size_t ws_size, hipStream_t stream) {
  static int grid_blocks = 0;
  if (!grid_blocks) {
    int dev = 0, cus = 0, per_cu = 0;
    hipGetDevice(&dev);
    hipDeviceGetAttribute(&cus, hipDeviceAttributeMultiprocessorCount, dev);
    hipFuncSetAttribute((const void*)mega, hipFuncAttributeMaxDynamicSharedMemorySize, LDS_BYTES);
    hipOccupancyMaxActiveBlocksPerMultiprocessor(&per_cu, (const void*)mega, NTHREADS, LDS_BYTES);
    if (per_cu < 1) per_cu = 1;
    if (per_cu > 2) per_cu = 2;
    grid_blocks = cus * per_cu;
  }
  Params p{};
  const float** fp = (const float**)&p;
  for (int i = 0; i < 27; ++i) fp[i] = (const float*)d_in[i];
  p.out = (float*)d_out;
  unsigned char* ws = (unsigned char*)d_ws;
  size_t off = 0;
  auto take = [&](size_t bytes) { unsigned char* r = ws + off; off += (bytes + 255) & ~(size_t)255; return r; };
  p.WtIn = (bf16_t*)take((size_t)2 * 3712 * 1024 * 2);
  p.WtOut = (bf16_t*)take((size_t)2 * 1024 * 1024 * 2);
  p.WupT = (bf16_t*)take((size_t)65536 * 2);
  p.AupT = (bf16_t*)take((size_t)65536 * 2);
  p.rope = (float*)take(1024 * 2 * 4);
  p.mod = (float*)take((size_t)2 * 5 * 3072 * 4);
  p.ctxcur = (float*)take((size_t)4 * 256 * 1024 * 4);
  p.PRE = (bf16_t*)take((size_t)3 * TOK * 512 * 2);
  p.hbuf = p.PRE;
  p.PA = (bf16_t*)take((size_t)TOK * 1024 * 2);
  p.PR = (bf16_t*)take((size_t)TOK * 1024 * 2);
  p.PG = (bf16_t*)take((size_t)TOK * 640 * 2);
  p.PS = (bf16_t*)take((size_t)TOK * 912 * 2);
  p.yR = (bf16_t*)take((size_t)2 * TOK * 256 * 2);
  p.HALO = (bf16_t*)take((size_t)512 * 2 * 896 * 2);
  p.DTC = (float2*)take((size_t)12 * TOK * 8);
  p.GID = (bf16_t*)take((size_t)8 * NSEG1 * 256 * 2);
  p.SMID = (float*)take((size_t)32 * 64 * 64 * 4);
  p.ctrs = (unsigned*)take(256);
  p.bar = (unsigned*)take((size_t)XCD_BAR_WORDS * 4);
  p.rstd = (float*)take((size_t)TOK * 4);
  p.yS = (bf16_t*)take((size_t)2 * TOK * 384 * 2);
  if (off > ws_size) { fprintf(stderr, "workspace too small: need %zu have %zu\n", off, ws_size); return; }
#if ONE_LAUNCH
  hipMemsetAsync(p.bar, 0, (size_t)XCD_BAR_WORDS * 4, stream);
  int lo = 0, hi = NPHASES;
  void* args[] = {&p, &lo, &hi};
  hipError_t e = hipLaunchCooperativeKernel((const void*)mega, dim3(grid_blocks), dim3(NTHREADS), args, LDS_BYTES, stream);
  if (e != hipSuccess) fprintf(stderr, "cooperative launch failed: %s (grid %d)\n", hipGetErrorString(e), grid_blocks);
#else
  for (int ph = 0; ph < NPHASES; ++ph)
    hipLaunchKernelGGL(mega, dim3(grid_blocks), dim3(NTHREADS), LDS_BYTES, stream, p, ph, ph + 1);
#endif
}
```

```cpp
#include <hip/hip_runtime.h>
#include <hip/hip_bf16.h>
#include <hip/hip_cooperative_groups.h>
#include <cstdio>
namespace cg = cooperative_groups;

#ifndef TEST_PH
#define TEST_PH -1
#endif
#ifndef ONE_LAUNCH
#define ONE_LAUNCH 1
#endif

typedef unsigned short bf16_t;
#define GLAS __attribute__((address_space(3)))
using bf16x8 = __attribute__((ext_vector_type(8))) short;
using f32x4 = __attribute__((ext_vector_type(4))) float;

#define TOK 17408
#define TPB 4352
#define NTHREADS 256
#define LDS_BYTES 76800
#define NPHASES 16
#define CSPLIT 78
#define NSEG1 ((136 - CSPLIT) * 32)
#ifndef LBW
#define LBW 2
#endif

struct Params {
  const float *x, *c, *ctx, *c_ctx, *ada_w, *ada_b, *norm_w, *w_in, *w_out, *attn_sink, *rwkv_mu, *rwkv_w0,
      *rwkv_w_up, *rwkv_a0, *rwkv_a_up, *rwkv_k_k, *rwkv_k_a, *rwkv_r_k, *rwkv_ln_w, *rwkv_ln_b, *ssm_conv_w,
      *ssm_conv_b, *ssm_a_log, *ssm_dt_bias, *ssm_d, *ssm_norm_w, *final_norm_w;
  float* out;
  bf16_t *WtIn, *WtOut, *WupT, *AupT;
  float *rope, *mod, *ctxcur;
  bf16_t *hbuf, *PA, *PR, *PG, *PS;
  bf16_t* yR;
  bf16_t* yS;
  bf16_t* PRE;
  bf16_t* HALO;
  float2* DTC;
  bf16_t* GID;
  float* SMID;
  unsigned* ctrs;
  unsigned* bar;
  float* rstd;
};

__device__ __forceinline__ float bf2f(bf16_t v) { return __uint_as_float(((unsigned)v) << 16); }
typedef __bf16 hbf2 __attribute__((ext_vector_type(2)));
typedef float hf2 __attribute__((ext_vector_type(2)));
__device__ __forceinline__ unsigned pack2(float a, float b) {
  hf2 v = {a, b};
  hbf2 r = __builtin_convertvector(v, hbf2);
  return *(unsigned*)&r;
}
__device__ __forceinline__ bf16_t f2bf(float f) { return (bf16_t)(pack2(f, 0.f) & 0xffffu); }
__device__ __forceinline__ float frcp(float x) { return __builtin_amdgcn_rcpf(x); }
__device__ __forceinline__ float sigmoidf_(float x) { return frcp(1.f + __expf(-x)); }
__device__ __forceinline__ float siluf_(float x) { return x * frcp(1.f + __expf(-x)); }
__device__ __forceinline__ float softplusf_(float x) {
  if (x > 15.f) return x;
  float e = __expf(x);
  return (e < 0.01f) ? e * (1.f - e * (0.5f - e * 0.33333333f)) : __logf(1.f + e);
}
__device__ __forceinline__ float tanhf_(float x) {
  float e = __expf(2.f * x);
  return 1.f - 2.f * frcp(e + 1.f);
}

template <int CTRL>
__device__ __forceinline__ float dppf(float x) {
  return __int_as_float(__builtin_amdgcn_update_dpp(0, __float_as_int(x), CTRL, 0xF, 0xF, true));
}
__device__ __forceinline__ float sum16(float x) {
  x += dppf<0xB1>(x);
  x += dppf<0x4E>(x);
  x += dppf<0x141>(x);
  x += dppf<0x140>(x);
  return x;
}
__device__ __forceinline__ float max16(float x) {
  x = fmaxf(x, dppf<0xB1>(x));
  x = fmaxf(x, dppf<0x4E>(x));
  x = fmaxf(x, dppf<0x141>(x));
  x = fmaxf(x, dppf<0x140>(x));
  return x;
}
__device__ __forceinline__ float sum64(float x) {
#pragma unroll
  for (int o = 32; o >= 1; o >>= 1) x += __shfl_xor(x, o);
  return x;
}
__device__ __forceinline__ float sum32(float x) {
#pragma unroll
  for (int o = 16; o >= 1; o >>= 1) x += __shfl_xor(x, o);
  return x;
}
__device__ __forceinline__ int launder(int x) { asm volatile("" : "+v"(x)); return x; }
#define MFMA(a, b, c) __builtin_amdgcn_mfma_f32_16x16x32_bf16(a, b, c, 0, 0, 0)

__device__ __forceinline__ void transpose_tile(const float* __restrict__ W, int N, int Kdim, bf16_t* __restrict__ Wt, int k0, int n0,
                               unsigned char* smem) {
  float* T = (float*)smem;
  const int tid = launder(threadIdx.x);
#pragma unroll 4
  for (int it = 0; it < 16; ++it) {
    int kk = (tid >> 6) + 4 * it, nn = tid & 63, n = n0 + nn;
    T[kk * 65 + nn] = (n < N) ? W[(size_t)(k0 + kk) * N + n] : 0.f;
  }
  __syncthreads();
#pragma unroll
  for (int it = 0; it < 2; ++it) {
    int nn = (tid >> 3) + 32 * it, kc = tid & 7;
    uint4 o;
    o.x = pack2(T[(kc * 8 + 0) * 65 + nn], T[(kc * 8 + 1) * 65 + nn]);
    o.y = pack2(T[(kc * 8 + 2) * 65 + nn], T[(kc * 8 + 3) * 65 + nn]);
    o.z = pack2(T[(kc * 8 + 4) * 65 + nn], T[(kc * 8 + 5) * 65 + nn]);
    o.w = pack2(T[(kc * 8 + 6) * 65 + nn], T[(kc * 8 + 7) * 65 + nn]);
    *(uint4*)(Wt + (size_t)(n0 + nn) * Kdim + k0 + kc * 8) = o;
  }
  __syncthreads();
}

__device__ void sincos_d(double x, float& c, float& s) {
  double n = rint(x * 0.63661977236758134308);
  double r = x - n * 1.57079632679489661923;
  double r2 = r * r;
  double sn = r * (1.0 + r2 * (-1.0 / 6 + r2 * (1.0 / 120 + r2 * (-1.0 / 5040 + r2 * (1.0 / 362880 + r2 * (-1.0 / 39916800 + r2 * (1.0 / 6227020800.0)))))));
  double cs = 1.0 + r2 * (-0.5 + r2 * (1.0 / 24 + r2 * (-1.0 / 720 + r2 * (1.0 / 40320 + r2 * (-1.0 / 3628800 + r2 * (1.0 / 479001600.0 + r2 * (-1.0 / 87178291200.0)))))));
  int q = ((int)n) & 3;
  double co, so;
  if (q == 0) { co = cs; so = sn; }
  else if (q == 1) { co = -sn; so = cs; }
  else if (q == 2) { co = -cs; so = -sn; }
  else { co = sn; so = -cs; }
  c = (float)co;
  s = (float)so;
}

__device__ __forceinline__ void deferred_transpose(const Params& p, int t, unsigned char* smem) {
  if (t < 928) {
    const int kt = t / 58, nt = t % 58;
    transpose_tile(p.w_in + (size_t)1024 * 3596, 3596, 1024, p.WtIn + (size_t)3712 * 1024, kt * 64, nt * 64, smem);
  } else {
    const int tt = t - 928, l = tt >> 8, r = tt & 255, kt = r >> 4, nt = r & 15;
    transpose_tile(p.w_out + (size_t)l * 1024 * 1024, 1024, 1024, p.WtOut + (size_t)l * 1024 * 1024, kt * 64, nt * 64, smem);
  }
}
__device__ __forceinline__ void phase_setup(const Params& p, unsigned char* smem) {
  const int T_WIN = 16 * 58, T_WOUT = 0, T_ADA = 2 * 96, T_MISC = 17;
  const int total = T_WIN + T_WOUT + T_ADA + T_MISC;
  const int tid = launder(threadIdx.x);
  if (blockIdx.x == 0 && tid < 8) p.ctrs[tid] = 0u;
  for (int t = blockIdx.x; t < total; t += gridDim.x) {
    if (t < T_WIN) {
      int kt = t / 58, nt = t % 58;
      transpose_tile(p.w_in, 3596, 1024, p.WtIn, kt * 64, nt * 64, smem);
    } else if (t < T_WIN + T_WOUT + T_ADA) {
      int tt = t - T_WIN - T_WOUT, l = tt / 96, n0 = (tt % 96) * 32;
      float* cact = (float*)smem;
      for (int i = tid; i < 5120; i += 256) {
        int j = i >> 10, k = i & 1023;
        float v = (j < 4) ? p.c[j * 1024 + k] : p.c_ctx[k];
        cact[i] = siluf_(v);
      }
      __syncthreads();
      int col = tid & 31, kg = tid >> 5;
      float a0 = 0, a1 = 0, a2 = 0, a3 = 0, a4 = 0;
      const float* wp = p.ada_w + ((size_t)l * 1024 + kg * 128) * 3072 + n0 + col;
#pragma unroll 8
      for (int k = 0; k < 128; ++k) {
        float w = wp[(size_t)k * 3072];
        int kk = kg * 128 + k;
        a0 += cact[kk] * w; a1 += cact[1024 + kk] * w; a2 += cact[2048 + kk] * w; a3 += cact[3072 + kk] * w; a4 += cact[4096 + kk] * w;
      }
      float* red = cact + 5120;
      red[(kg * 5 + 0) * 32 + col] = a0; red[(kg * 5 + 1) * 32 + col] = a1; red[(kg * 5 + 2) * 32 + col] = a2;
      red[(kg * 5 + 3) * 32 + col] = a3; red[(kg * 5 + 4) * 32 + col] = a4;
      __syncthreads();
      if (tid < 160) {
        int j = tid >> 5, cc = tid & 31;
        float s = 0;
#pragma unroll
        for (int g = 0; g < 8; ++g) s += red[(g * 5 + j) * 32 + cc];
        p.mod[(size_t)(l * 5 + j) * 3072 + n0 + cc] = s + p.ada_b[l * 3072 + n0 + cc];
      }
      __syncthreads();
    } else {
      int tt = t - T_WIN - T_WOUT - T_ADA;
      if (tt < 16) {
        for (int i = tid; i < 8192; i += 256) {
          int idx = tt * 8192 + i;
          int arr = idx >> 16, e = idx & 65535;
          int ld = e >> 14, rem = e & 16383, n = rem >> 6, k = rem & 63;
          const float* src = arr ? p.rwkv_a_up : p.rwkv_w_up;
          bf16_t* dst = arr ? p.AupT : p.WupT;
          dst[e] = f2bf(src[((size_t)ld * 64 + k) * 256 + n]);
        }
      } else {
        for (int i = tid; i < 1024; i += 256) {
          int pos = i >> 4, f = i & 15;
          float inv32 = exp2f(-(float)f * 0.83048202372184058f);
          float c, s;
          sincos_d((double)((float)pos * inv32), c, s);
          p.rope[i * 2] = c;
          p.rope[i * 2 + 1] = s;
        }
      }
    }
  }
}

__device__ __forceinline__ void phase_norm(const Params& p, int l) {
  const int tid = launder(threadIdx.x), lane = tid & 63, w = tid >> 6;
  for (int t = blockIdx.x; t < TOK / 4; t += gridDim.x) {
    int r = t * 4 + w, b = r / TPB, pp = r % TPB;
    const float* src;
    if (l == 0) src = (pp < 256) ? p.ctx + ((size_t)b * 256 + pp) * 1024 : p.x + ((size_t)b * 4096 + pp - 256) * 1024;
    else src = (pp < 256) ? p.ctxcur + ((size_t)b * 256 + pp) * 1024 : p.out + ((size_t)b * 4096 + pp - 256) * 1024;
    const float* md = p.mod + (size_t)(l * 5 + ((pp < 256) ? 4 : b)) * 3072;
    const float* nw = p.norm_w + l * 1024;
    float4 v[4];
    float ss = 0;
#pragma unroll
    for (int i = 0; i < 4; ++i) {
      v[i] = *(const float4*)(src + lane * 4 + 256 * i);
      ss += v[i].x * v[i].x + v[i].y * v[i].y + v[i].z * v[i].z + v[i].w * v[i].w;
    }
    ss = sum64(ss);
    float rstd = rsqrtf(ss * (1.f / 1024.f) + 1e-6f);
    if (lane == 0) p.rstd[r] = rstd;
#pragma unroll
    for (int i = 0; i < 4; ++i) {
      int k = lane * 4 + 256 * i;
      float4 n4 = *(const float4*)(nw + k), sc = *(const float4*)(md + 1024 + k), sh = *(const float4*)(md + k);
      float h0 = v[i].x * rstd * n4.x * (1.f + sc.x) + sh.x;
      float h1 = v[i].y * rstd * n4.y * (1.f + sc.y) + sh.y;
      float h2 = v[i].z * rstd * n4.z * (1.f + sc.z) + sh.z;
      float h3 = v[i].w * rstd * n4.w * (1.f + sc.w) + sh.w;
      uint2 o;
      o.x = pack2(h0, h1);
      o.y = pack2(h2, h3);
      *(uint2*)(p.hbuf + (size_t)r * 1024 + k) = o;
    }
  }
}

__device__ __forceinline__ void phase_final(const Params& p) {
  const int tid = launder(threadIdx.x), lane = tid & 63, w = tid >> 6;
  for (int t = blockIdx.x; t < 16384 / 4; t += gridDim.x) {
    int r = t * 4 + w;
    float* src = p.out + (size_t)r * 1024;
    float4 v[4];
    float ss = 0;
#pragma unroll
    for (int i = 0; i < 4; ++i) {
      v[i] = *(const float4*)(src + lane * 4 + 256 * i);
      ss += v[i].x * v[i].x + v[i].y * v[i].y + v[i].z * v[i].z + v[i].w * v[i].w;
    }
    ss = sum64(ss);
    float rstd = rsqrtf(ss * (1.f / 1024.f) + 1e-6f);
#pragma unroll
    for (int i = 0; i < 4; ++i) {
      int k = lane * 4 + 256 * i;
      float4 n4 = *(const float4*)(p.final_norm_w + k);
      float4 o;
      o.x = v[i].x * rstd * n4.x; o.y = v[i].y * rstd * n4.y; o.z = v[i].z * rstd * n4.z; o.w = v[i].w * rstd * n4.w;
      *(float4*)(src + k) = o;
    }
  }
}

template <int MODE>
__device__ __forceinline__ void gemm_tile(const Params& p, int l, int mt_, int nt_, unsigned char* smem) {
  const bf16_t* A = p.hbuf;
  const bf16_t* Bt = (MODE == 0) ? p.WtIn + (size_t)l * 3712 * 1024 : p.WtOut + (size_t)l * 1024 * 1024;
  const int m0 = mt_ * 128, n0 = nt_ * 128;
  bf16_t* As = (bf16_t*)smem;
  bf16_t* Bs = As + 2 * 128 * 72;
  const int tid = launder(threadIdx.x), lane = tid & 63, w = tid >> 6, wr = w >> 1, wc = w & 1, fr = lane & 15, fq = lane >> 4;
  f32x4 acc[4][4];
#pragma unroll
  for (int i = 0; i < 4; ++i)
#pragma unroll
    for (int j = 0; j < 4; ++j) acc[i][j] = (f32x4){0.f, 0.f, 0.f, 0.f};
  unsigned char* lds = smem;
  int sR[4], sC[4];
#pragma unroll
  for (int i = 0; i < 4; ++i) {
    const int bo = tid * 16 + i * 4096;
    const int st = bo >> 10, sb = bo & 1023, swz = sb ^ (((sb >> 9) & 1) << 5);
    sR[i] = (st >> 1) * 16 + (swz >> 6);
    sC[i] = (st & 1) * 32 + ((swz & 63) >> 1);
  }
  const bf16_t* Ag0 = A + (size_t)(m0 + sR[0]) * 1024 + sC[0];
  const bf16_t* Ag1 = A + (size_t)(m0 + sR[1]) * 1024 + sC[1];
  const bf16_t* Ag2 = A + (size_t)(m0 + sR[2]) * 1024 + sC[2];
  const bf16_t* Ag3 = A + (size_t)(m0 + sR[3]) * 1024 + sC[3];
  const bf16_t* Bg0 = Bt + (size_t)(n0 + sR[0]) * 1024 + sC[0];
  const bf16_t* Bg1 = Bt + (size_t)(n0 + sR[1]) * 1024 + sC[1];
  const bf16_t* Bg2 = Bt + (size_t)(n0 + sR[2]) * 1024 + sC[2];
  const bf16_t* Bg3 = Bt + (size_t)(n0 + sR[3]) * 1024 + sC[3];
#define GL_STAGE(q_, kt_)                                                                                                              \
  {                                                                                                                                    \
    unsigned char* base_ = lds + (q_) * 32768 + tid * 16;                                                                              \
    __builtin_amdgcn_global_load_lds((const unsigned*)(Ag0 + (kt_) * 64), (GLAS unsigned*)(base_), 16, 0, 0);                          \
    __builtin_amdgcn_global_load_lds((const unsigned*)(Ag1 + (kt_) * 64), (GLAS unsigned*)(base_ + 4096), 16, 0, 0);                   \
    __builtin_amdgcn_global_load_lds((const unsigned*)(Ag2 + (kt_) * 64), (GLAS unsigned*)(base_ + 8192), 16, 0, 0);                   \
    __builtin_amdgcn_global_load_lds((const unsigned*)(Ag3 + (kt_) * 64), (GLAS unsigned*)(base_ + 12288), 16, 0, 0);                  \
    __builtin_amdgcn_global_load_lds((const unsigned*)(Bg0 + (kt_) * 64), (GLAS unsigned*)(base_ + 16384), 16, 0, 0);                  \
    __builtin_amdgcn_global_load_lds((const unsigned*)(Bg1 + (kt_) * 64), (GLAS unsigned*)(base_ + 16384 + 4096), 16, 0, 0);           \
    __builtin_amdgcn_global_load_lds((const unsigned*)(Bg2 + (kt_) * 64), (GLAS unsigned*)(base_ + 16384 + 8192), 16, 0, 0);           \
    __builtin_amdgcn_global_load_lds((const unsigned*)(Bg3 + (kt_) * 64), (GLAS unsigned*)(base_ + 16384 + 12288), 16, 0, 0);          \
  }
  const int lo = (fr * 64 + fq * 16) ^ ((fr >> 3) << 5);
#define GL_COMPUTE(q_)                                                                                 \
  {                                                                                                    \
    const unsigned char* Ab = lds + (q_) * 32768 + (wr * 4) * 2048 + lo;                               \
    const unsigned char* Bb = lds + (q_) * 32768 + 16384 + (wc * 4) * 2048 + lo;                       \
    _Pragma("unroll") for (int ks = 0; ks < 2; ++ks) {                                                 \
      bf16x8 a[4], b[4];                                                                               \
      _Pragma("unroll") for (int i = 0; i < 4; ++i) {                                                  \
        a[i] = *(const bf16x8*)(Ab + i * 2048 + ks * 1024);                                            \
        b[i] = *(const bf16x8*)(Bb + i * 2048 + ks * 1024);                                            \
      }                                                                                                \
      _Pragma("unroll") for (int i = 0; i < 4; ++i)                                                    \
        _Pragma("unroll") for (int j = 0; j < 4; ++j) acc[i][j] = MFMA(a[i], b[j], acc[i][j]);         \
    }                                                                                                  \
  }
  GL_STAGE(0, 0);
  asm volatile("s_waitcnt vmcnt(0)" ::: "memory");
  __builtin_amdgcn_s_barrier();
  for (int kt = 0; kt < 16; ++kt) {
    const int q = kt & 1;
    if (kt + 1 < 16) GL_STAGE(q ^ 1, kt + 1);
    GL_COMPUTE(q);
    asm volatile("s_waitcnt vmcnt(0) lgkmcnt(0)" ::: "memory");
    __builtin_amdgcn_s_barrier();
  }
  const int cbase = n0 + wc * 64;
  if (MODE == 0) {
    bf16_t* dst;
    int ld, coff;
    if (cbase < 1024) { dst = p.PA; ld = 1024; coff = cbase; }
    else if (cbase < 2048) { dst = p.PR; ld = 1024; coff = cbase - 1024; }
    else if (cbase < 2688) { dst = p.PG; ld = 640; coff = cbase - 2048; }
    else { dst = p.PS; ld = 912; coff = cbase - 2688; }
    bf16_t* wbuf = (bf16_t*)smem + w * (64 * 72);
#pragma unroll
    for (int i = 0; i < 4; ++i) {
#pragma unroll
      for (int j = 0; j < 4; ++j) {
        const int r = m0 + wr * 64 + i * 16 + fq * 4 + j;
        const int pp = r % TPB;
        float v0 = acc[i][0][j], v1 = acc[i][1][j], v2 = acc[i][2][j], v3 = acc[i][3][j];
        if (cbase < 512 && pp >= 256) {
          const int tt = pp - 256, rp = tt >> 6, cp = tt & 63;
          const float2 cs0 = *(const float2*)(p.rope + (rp * 16 + fr) * 2);
          const float2 cs1 = *(const float2*)(p.rope + (cp * 16 + fr) * 2);
          float n0_ = v0 * cs0.x - v1 * cs0.y, n1_ = v0 * cs0.y + v1 * cs0.x;
          float n2_ = v2 * cs1.x - v3 * cs1.y, n3_ = v2 * cs1.y + v3 * cs1.x;
          v0 = n0_; v1 = n1_; v2 = n2_; v3 = n3_;
        }
        if (cbase < 384) { v0 *= 0.125f; v1 *= 0.125f; v2 *= 0.125f; v3 *= 0.125f; }
        bf16_t* o = wbuf + (i * 16 + fq * 4 + j) * 72 + fr;
        o[0] = f2bf(v0); o[16] = f2bf(v1); o[32] = f2bf(v2); o[48] = f2bf(v3);
      }
    }
    __builtin_amdgcn_wave_barrier();
    {
      const int ch = lane & 7;
      const bool chv = (cbase + ch * 8) < 3600;
      const bool halo = (cbase >= 2688) && (cbase + 64 <= 3584);
#pragma unroll
      for (int t = 0; t < 8; ++t) {
        const int rl = (lane >> 3) + 8 * t;
        const uint4 v = *(const uint4*)(wbuf + rl * 72 + ch * 8);
        const int r = m0 + wr * 64 + rl;
        if (chv) *(uint4*)(dst + (size_t)r * ld + coff + ch * 8) = v;
        if (halo) {
          const int pp = r % TPB, q34 = pp % 34, t34 = pp / 34, bb = r / TPB;
          if (q34 == 33 && t34 + 1 < 128) *(uint4*)(p.HALO + ((size_t)(bb * 128 + t34 + 1) * 2 + 0) * 896 + coff + ch * 8) = v;
          if (q34 == 0 && t34 >= 1) *(uint4*)(p.HALO + ((size_t)(bb * 128 + t34 - 1) * 2 + 1) * 896 + coff + ch * 8) = v;
        }
      }
    }
  } else {
#pragma unroll
    for (int i = 0; i < 4; ++i) {
#pragma unroll
      for (int j = 0; j < 4; ++j) {
        const int r = m0 + wr * 64 + i * 16 + fq * 4 + j;
        const int b = r / TPB, pp = r % TPB;
        const bool isc = pp < 256;
        const float* gate = p.mod + (size_t)(l * 5 + (isc ? 4 : b)) * 3072 + 2048;
        const float* res;
        float* dstp;
        if (l == 0) {
          res = isc ? p.ctx + ((size_t)b * 256 + pp) * 1024 : p.x + ((size_t)b * 4096 + pp - 256) * 1024;
          dstp = isc ? p.ctxcur + ((size_t)b * 256 + pp) * 1024 : p.out + ((size_t)b * 4096 + pp - 256) * 1024;
        } else {
          res = p.out + ((size_t)b * 4096 + pp - 256) * 1024;
          dstp = p.out + ((size_t)b * 4096 + pp - 256) * 1024;
        }
#pragma unroll
        for (int nn = 0; nn < 4; ++nn) {
          const int n = cbase + nn * 16 + fr;
          dstp[n] = res[n] + gate[n] * acc[i][nn][j];
        }
      }
    }
  }
  __syncthreads();
}

#define G_COMPUTE(buf_)                                                                 \
  {                                                                                     \
    const bf16_t* Ac = As + (buf_) * 128 * 72 + (wr * 64 + fr) * 72 + fq * 8;           \
    const bf16_t* Bc = Bs + (buf_) * 128 * 72 + (wc * 64 + fr) * 72 + fq * 8;           \
    _Pragma("unroll") for (int ks = 0; ks < 2; ++ks) {                                  \
      bf16x8 a[4], b[4];                                                                \
      _Pragma("unroll") for (int i = 0; i < 4; ++i) {                                   \
        a[i] = *(const bf16x8*)(Ac + i * 16 * 72 + ks * 32);                            \
        b[i] = *(const bf16x8*)(Bc + i * 16 * 72 + ks * 32);                            \
      }                                                                                 \
      _Pragma("unroll") for (int i = 0; i < 4; ++i)                                     \
        _Pragma("unroll") for (int j = 0; j < 4; ++j) acc[i][j] = MFMA(a[i], b[j], acc[i][j]); \
    }                                                                                   \
  }
__device__ __forceinline__ void gemm_late_tile(const Params& p, int l, int mt_, int nt_, unsigned char* smem) {
  const bf16_t* Bt = p.WtIn + (size_t)l * 3712 * 1024;
  const int m0 = mt_ * 128, n0 = nt_ * 128;
  bf16_t* As = (bf16_t*)smem;
  bf16_t* Bs = As + 2 * 128 * 72;
  const int tid = launder(threadIdx.x), lane = tid & 63, w = tid >> 6, wr = w >> 1, wc = w & 1, fr = lane & 15, fq = lane >> 4;
  f32x4 acc[4][4];
#pragma unroll
  for (int i = 0; i < 4; ++i)
#pragma unroll
    for (int j = 0; j < 4; ++j) acc[i][j] = (f32x4){0.f, 0.f, 0.f, 0.f};
  const int lrow = tid >> 3, lkc = tid & 7;
  const int bb = m0 / TPB, pp0 = m0 % TPB;
  const bool isc0 = pp0 < 256;
  const float* xbase;
  if (l == 0) xbase = isc0 ? p.ctx + ((size_t)bb * 256 + pp0) * 1024 : p.x + ((size_t)bb * 4096 + pp0 - 256) * 1024;
  else xbase = isc0 ? p.ctxcur + ((size_t)bb * 256 + pp0) * 1024 : p.out + ((size_t)bb * 4096 + pp0 - 256) * 1024;
  const float* xr = xbase + (size_t)lrow * 1024 + lkc * 8;
  const float* md = p.mod + (size_t)(l * 5 + (isc0 ? 4 : bb)) * 3072 + lkc * 8;
  const float* nwp = p.norm_w + l * 1024 + lkc * 8;
  const float rs0 = p.rstd[m0 + lrow], rs1 = p.rstd[m0 + lrow + 32], rs2 = p.rstd[m0 + lrow + 64], rs3 = p.rstd[m0 + lrow + 96];
  const bf16_t* Bg = Bt + (size_t)(n0 + lrow) * 1024 + lkc * 8;
  float4 xa0, xb0, xa1, xb1, xa2, xb2, xa3, xb3, nwa, nwb, sca, scb, sha, shb;
  uint4 lb0, lb1, lb2, lb3;
#define L_LOAD(kt_)                                                                                   \
  {                                                                                                   \
    const int ko_ = (kt_) * 64;                                                                       \
    xa0 = *(const float4*)(xr + ko_); xb0 = *(const float4*)(xr + ko_ + 4);                            \
    xa1 = *(const float4*)(xr + 32 * 1024 + ko_); xb1 = *(const float4*)(xr + 32 * 1024 + ko_ + 4);    \
    xa2 = *(const float4*)(xr + 64 * 1024 + ko_); xb2 = *(const float4*)(xr + 64 * 1024 + ko_ + 4);    \
    xa3 = *(const float4*)(xr + 96 * 1024 + ko_); xb3 = *(const float4*)(xr + 96 * 1024 + ko_ + 4);    \
    lb0 = *(const uint4*)(Bg + ko_); lb1 = *(const uint4*)(Bg + (size_t)32 * 1024 + ko_);              \
    lb2 = *(const uint4*)(Bg + (size_t)64 * 1024 + ko_); lb3 = *(const uint4*)(Bg + (size_t)96 * 1024 + ko_); \
    nwa = *(const float4*)(nwp + ko_); nwb = *(const float4*)(nwp + ko_ + 4);                          \
    sca = *(const float4*)(md + 1024 + ko_); scb = *(const float4*)(md + 1024 + ko_ + 4);              \
    sha = *(const float4*)(md + ko_); shb = *(const float4*)(md + ko_ + 4);                            \
  }
#define L_ROW(xa_, xb_, rs_, i_, buf_)                                                                \
  {                                                                                                   \
    uint4 o_;                                                                                         \
    o_.x = pack2(xa_.x * rs_ * nwa.x * (1.f + sca.x) + sha.x, xa_.y * rs_ * nwa.y * (1.f + sca.y) + sha.y); \
    o_.y = pack2(xa_.z * rs_ * nwa.z * (1.f + sca.z) + sha.z, xa_.w * rs_ * nwa.w * (1.f + sca.w) + sha.w); \
    o_.z = pack2(xb_.x * rs_ * nwb.x * (1.f + scb.x) + shb.x, xb_.y * rs_ * nwb.y * (1.f + scb.y) + shb.y); \
    o_.w = pack2(xb_.z * rs_ * nwb.z * (1.f + scb.z) + shb.z, xb_.w * rs_ * nwb.w * (1.f + scb.w) + shb.w); \
    *(uint4*)(As + (buf_) * 128 * 72 + (lrow + 32 * (i_)) * 72 + lkc * 8) = o_;                       \
  }
#define L_STORE(buf_)                                                                                 \
  {                                                                                                   \
    L_ROW(xa0, xb0, rs0, 0, buf_) L_ROW(xa1, xb1, rs1, 1, buf_) L_ROW(xa2, xb2, rs2, 2, buf_) L_ROW(xa3, xb3, rs3, 3, buf_) \
    *(uint4*)(Bs + (buf_) * 128 * 72 + lrow * 72 + lkc * 8) = lb0;                                    \
    *(uint4*)(Bs + (buf_) * 128 * 72 + (lrow + 32) * 72 + lkc * 8) = lb1;                             \
    *(uint4*)(Bs + (buf_) * 128 * 72 + (lrow + 64) * 72 + lkc * 8) = lb2;                             \
    *(uint4*)(Bs + (buf_) * 128 * 72 + (lrow + 96) * 72 + lkc * 8) = lb3;                             \
  }
  L_LOAD(0);
  L_STORE(0);
  __syncthreads();
  for (int kt = 0; kt < 16; ++kt) {
    L_LOAD((kt + 1 < 16) ? kt + 1 : 15);
    G_COMPUTE(kt & 1);
    L_STORE((kt + 1) & 1);
    __syncthreads();
  }
  const int cbase = n0 + wc * 64;
    bf16_t* dst;
    int ld, coff;
    if (cbase < 1024) { dst = p.PA; ld = 1024; coff = cbase; }
    else if (cbase < 2048) { dst = p.PR; ld = 1024; coff = cbase - 1024; }
    else if (cbase < 2688) { dst = p.PG; ld = 640; coff = cbase - 2048; }
    else { dst = p.PS; ld = 912; coff = cbase - 2688; }
    bf16_t* wbuf = (bf16_t*)smem + w * (64 * 72);
#pragma unroll
    for (int i = 0; i < 4; ++i) {
#pragma unroll
      for (int j = 0; j < 4; ++j) {
        const int r = m0 + wr * 64 + i * 16 + fq * 4 + j;
        const int pp = r % TPB;
        float v0 = acc[i][0][j], v1 = acc[i][1][j], v2 = acc[i][2][j], v3 = acc[i][3][j];
        if (cbase < 512 && pp >= 256) {
          const int tt = pp - 256, rp = tt >> 6, cp = tt & 63;
          const float2 cs0 = *(const float2*)(p.rope + (rp * 16 + fr) * 2);
          const float2 cs1 = *(const float2*)(p.rope + (cp * 16 + fr) * 2);
          float n0_ = v0 * cs0.x - v1 * cs0.y, n1_ = v0 * cs0.y + v1 * cs0.x;
          float n2_ = v2 * cs1.x - v3 * cs1.y, n3_ = v2 * cs1.y + v3 * cs1.x;
          v0 = n0_; v1 = n1_; v2 = n2_; v3 = n3_;
        }
        if (cbase < 384) { v0 *= 0.125f; v1 *= 0.125f; v2 *= 0.125f; v3 *= 0.125f; }
        bf16_t* o = wbuf + (i * 16 + fq * 4 + j) * 72 + fr;
        o[0] = f2bf(v0); o[16] = f2bf(v1); o[32] = f2bf(v2); o[48] = f2bf(v3);
      }
    }
    __builtin_amdgcn_wave_barrier();
    {
      const int ch = lane & 7;
      const bool chv = (cbase + ch * 8) < 3600;
      const bool halo = (cbase >= 2688) && (cbase + 64 <= 3584);
#pragma unroll
      for (int t = 0; t < 8; ++t) {
        const int rl = (lane >> 3) + 8 * t;
        const uint4 v = *(const uint4*)(wbuf + rl * 72 + ch * 8);
        const int r = m0 + wr * 64 + rl;
        if (chv) *(uint4*)(dst + (size_t)r * ld + coff + ch * 8) = v;
        if (halo) {
          const int pp = r % TPB, q34 = pp % 34, t34 = pp / 34, bb = r / TPB;
          if (q34 == 33 && t34 + 1 < 128) *(uint4*)(p.HALO + ((size_t)(bb * 128 + t34 + 1) * 2 + 0) * 896 + coff + ch * 8) = v;
          if (q34 == 0 && t34 >= 1) *(uint4*)(p.HALO + ((size_t)(bb * 128 + t34 - 1) * 2 + 1) * 896 + coff + ch * 8) = v;
        }
      }
    }
  __syncthreads();
}

__device__ __forceinline__ void phase_inproj(const Params& p, int l, unsigned char* smem) {
  if ((gridDim.x & 7) == 0) {
    const int x = blockIdx.x & 7, slot = blockIdx.x >> 3, nslot = gridDim.x >> 3;
    for (int j = slot; j < 17 * 24; j += nslot) { const int ne = j % 24; gemm_tile<0>(p, l, (j / 24) * 8 + x, (ne < 16) ? ne : ne + 5, smem); }
  } else {
    for (int t = blockIdx.x; t < 136 * 24; t += gridDim.x) { const int ne = t % 24; gemm_tile<0>(p, l, t / 24, (ne < 16) ? ne : ne + 5, smem); }
  }
}
__device__ __forceinline__ void phase_outproj(const Params& p, int l, unsigned char* smem) {
  if ((gridDim.x & 7) == 0) {
    const int x = blockIdx.x & 7, slot = blockIdx.x >> 3, nslot = gridDim.x >> 3;
    for (int j = slot; j < 17 * 8; j += nslot) {
      const int mt = (j >> 3) * 8 + x, nt = j & 7;
      if (l == 1 && (mt % 34) < 2) continue;
      gemm_tile<1>(p, l, mt, nt, smem);
    }
  } else {
    for (int t = blockIdx.x; t < 136 * 8; t += gridDim.x) {
      int mt = t >> 3, nt = t & 7;
      if (l == 1 && (mt % 34) < 2) continue;
      gemm_tile<1>(p, l, mt, nt, smem);
    }
  }
}

#define PRE_ARR ((size_t)TOK * 512)
__device__ __forceinline__ void rwkv_prep_tile(const Params& p, int l, int tile, unsigned char* smem) {
  const int d = tile & 1, tb = (tile >> 1) % 136, b = tile / 272;
  bf16_t* raw = (bf16_t*)smem;
  bf16_t* Aw = raw + 34 * 384;
  bf16_t* Aa = Aw + 32 * 72;
  const int tid = launder(threadIdx.x), lane = tid & 63, w = tid >> 6, fr = lane & 15, fq = lane >> 4;
  const int p0 = tb * 32;
  const int slo = (p0 < 256) ? 0 : 256, shi = (p0 < 256) ? 255 : 4351;
  const size_t rowbase = (size_t)b * TPB;
  const int ld2 = l * 2 + d;
  for (int q = tid; q < 34 * 48; q += 256) {
    const int rr = q / 48, cc = q % 48;
    const int tr = p0 - 1 + rr;
    const int col = (cc < 32) ? (256 + cc * 8) : ((cc < 40) ? (768 + d * 64 + (cc - 32) * 8) : (896 + d * 64 + (cc - 40) * 8));
    uint4 v = make_uint4(0, 0, 0, 0);
    if (tr >= slo && tr <= shi) v = *(const uint4*)(p.PR + (rowbase + tr) * 1024 + col);
    *(uint4*)(raw + rr * 384 + cc * 8) = v;
  }
  __syncthreads();
  const float* mu0 = p.rwkv_mu + (size_t)(l * 2 + 0) * 1024;
  const float* mu1 = p.rwkv_mu + (size_t)(l * 2 + 1) * 1024;
  {
    const int ca = tid & 63;
    const float m0wd = mu0[768 + d * 64 + ca], m1wd = mu1[768 + d * 64 + ca];
    const float m0ad = mu0[896 + d * 64 + ca], m1ad = mu1[896 + d * 64 + ca];
#pragma unroll 2
    for (int it = 0; it < 8; ++it) {
      const int i = w + 4 * it;
      const bf16_t* r0 = raw + (i + 1) * 384 + ca;
      float u = bf2f(r0[256]), up = bf2f(r0[256 - 384]), un = bf2f(r0[256 + 384]);
      Aw[i * 72 + ca] = f2bf(tanhf_(u + m0wd * (up - u) + m1wd * (un - u)));
      u = bf2f(r0[320]); up = bf2f(r0[320 - 384]); un = bf2f(r0[320 + 384]);
      Aa[i * 72 + ca] = f2bf(u + m0ad * (up - u) + m1ad * (un - u));
    }
  }
  __syncthreads();
  bf16x8 aw[2][2], aa[2][2];
#pragma unroll
  for (int mt = 0; mt < 2; ++mt)
#pragma unroll
    for (int ks = 0; ks < 2; ++ks) {
      aw[mt][ks] = *(const bf16x8*)(Aw + (mt * 16 + fr) * 72 + ks * 32 + fq * 8);
      aa[mt][ks] = *(const bf16x8*)(Aa + (mt * 16 + fr) * 72 + ks * 32 + fq * 8);
    }
  float kkr[2][4][4];
  float ssq[2][4];
#pragma unroll
  for (int mt = 0; mt < 2; ++mt)
#pragma unroll
    for (int j = 0; j < 4; ++j) ssq[mt][j] = 0.f;
#pragma unroll
  for (int nt = 0; nt < 4; ++nt) {
    const int c = w * 64 + nt * 16 + fr;
    const float m0k = mu0[256 + c], m1k = mu1[256 + c], kkc = p.rwkv_k_k[ld2 * 256 + c];
#pragma unroll
    for (int mt = 0; mt < 2; ++mt)
#pragma unroll
      for (int j = 0; j < 4; ++j) {
        const int i = mt * 16 + fq * 4 + j;
        const bf16_t* r0 = raw + (i + 1) * 384 + c;
        const float u = bf2f(r0[0]), up = bf2f(r0[-384]), un = bf2f(r0[384]);
        const float kq = (u + m0k * (up - u) + m1k * (un - u)) * kkc;
        kkr[mt][nt][j] = kq;
        ssq[mt][j] += kq * kq;
      }
  }
  float inv[2][4];
#pragma unroll
  for (int mt = 0; mt < 2; ++mt)
#pragma unroll
    for (int j = 0; j < 4; ++j) {
      const float tot = sum16(ssq[mt][j]);
      inv[mt][j] = frcp(fmaxf(__builtin_amdgcn_sqrtf(tot), 1e-12f));
    }
#pragma unroll
  for (int nt = 0; nt < 4; ++nt) {
    const int c = w * 64 + nt * 16 + fr;
    const bf16_t* wup = p.WupT + ((size_t)(ld2 * 256 + c)) * 64 + fq * 8;
    const bf16_t* aup = p.AupT + ((size_t)(ld2 * 256 + c)) * 64 + fq * 8;
    const bf16x8 bw0 = *(const bf16x8*)wup, bw1 = *(const bf16x8*)(wup + 32);
    const bf16x8 ba0 = *(const bf16x8*)aup, ba1 = *(const bf16x8*)(aup + 32);
    const float w0c = p.rwkv_w0[ld2 * 256 + c], a0c = p.rwkv_a0[ld2 * 256 + c];
#pragma unroll
    for (int mt = 0; mt < 2; ++mt) {
      f32x4 accw = (f32x4){0.f, 0.f, 0.f, 0.f}, acca = (f32x4){0.f, 0.f, 0.f, 0.f};
      accw = MFMA(aw[mt][0], bw0, accw);
      accw = MFMA(aw[mt][1], bw1, accw);
      acca = MFMA(aa[mt][0], ba0, acca);
      acca = MFMA(aa[mt][1], ba1, acca);
#pragma unroll
      for (int j = 0; j < 4; ++j) {
        const int i = mt * 16 + fq * 4 + j;
        const float ew = 0.6065306597f * sigmoidf_(w0c + accw[j]);
        const float a = sigmoidf_(a0c + acca[j]);
        const float kk = kkr[mt][nt][j] * inv[mt][j];
        const size_t o = ((rowbase + p0 + i) * 2 + d) * 256 + c;
        p.PRE[o] = f2bf(ew);
        p.PRE[PRE_ARR + o] = f2bf(a);
        p.PRE[2 * PRE_ARR + o] = f2bf(kk);
      }
    }
  }
  __syncthreads();
}
__device__ __forceinline__ void ssd_conv_tile(const Params& p, int l, int tile, unsigned char* smem);
__device__ __forceinline__ void ssd_dtcum_tile(const Params& p, int l, int tile, unsigned char* smem);
__device__ __forceinline__ void phase_rwkvprep(const Params& p, int l, unsigned char* smem) {
  for (int t = blockIdx.x; t < 1088 + 512 + 544; t += gridDim.x) {
    if (t < 1088) rwkv_prep_tile(p, l, t, smem);
    else if (t < 1600) ssd_conv_tile(p, l, t - 1088, smem);
    else ssd_dtcum_tile(p, l, t - 1600, smem);
  }
}

typedef float v2f __attribute__((ext_vector_type(2)));
template <bool DUAL>
__device__ __forceinline__ void rwkv_tile(const Params& p, int l, int tile, unsigned char* smem) {
  const int part = tile >> 7;
  const int rg = tile & 3, h = (tile >> 2) & 3, b = (tile >> 4) & 3, d = (tile >> 6) & 1;
  const int cbeg = (part == 0) ? 0 : CSPLIT, cend = (part == 0) ? CSPLIT : 136;
  bf16_t* raw = (bf16_t*)smem;
  bf16_t* pre = raw + 34 * 192;
  float* rec = (float*)(smem + 13056 + 12288);
  const int tid = launder(threadIdx.x), lane = tid & 63, w = tid >> 6, fr = lane & 15, fq = lane >> 4;
  const int row = rg * 16 + w * 4 + fq;
  const int c0 = fr * 4;
  const int ld2 = l * 2 + d;
  const size_t rowbase = (size_t)b * TPB;
  const int lc = (tid & 15) * 4;
  const float* mu0 = p.rwkv_mu + (size_t)(l * 2 + 0) * 1024 + h * 64 + lc;
  const float* mu1 = p.rwkv_mu + (size_t)(l * 2 + 1) * 1024 + h * 64 + lc;
  const float4 m0r = *(const float4*)mu0, m1r = *(const float4*)mu1;
  const float4 m0k = *(const float4*)(mu0 + 256), m1k = *(const float4*)(mu1 + 256);
  const float4 m0v = *(const float4*)(mu0 + 512), m1v = *(const float4*)(mu1 + 512);
  const float4 ka4 = *(const float4*)(p.rwkv_k_a + ld2 * 256 + h * 64 + lc);
  v2f sA = {0.f, 0.f}, sB = {0.f, 0.f};
  v2f iA = {(row == c0) ? 1.f : 0.f, (row == c0 + 1) ? 1.f : 0.f}, iB = {(row == c0 + 2) ? 1.f : 0.f, (row == c0 + 3) ? 1.f : 0.f};
  const int pcc = tid % 24, prow = tid / 24;
  const bool pact = tid < 240;
  const bf16_t* rbase_g = p.PR + rowbase * 1024 + (pcc >> 3) * 256 + h * 64 + (pcc & 7) * 8;
  const bf16_t* pbase_g = p.PRE + (size_t)(pcc >> 3) * PRE_ARR + (rowbase * 2 + d) * 256 + h * 64 + (pcc & 7) * 8;
  uint4 pf0, pf1, pf2, pf3, pg0, pg1, pg2, pg3;
#define RW_GEOM(cix_, plo_, slo_, shi_)                                                   \
  {                                                                                       \
    const int st0_ = (cix_) * 32;                                                         \
    if (st0_ < 256) { slo_ = 0; shi_ = 255; plo_ = (d == 0) ? st0_ : 224 - st0_; }         \
    else { slo_ = 256; shi_ = 4351; plo_ = (d == 0) ? st0_ : 4576 - st0_; }                \
  }
#define RW_PF1(dst_, rr_, plo_, slo_, shi_)                                                         \
  {                                                                                                 \
    const int tr_ = (plo_) - 1 + (rr_);                                                             \
    dst_ = make_uint4(0, 0, 0, 0);                                                                  \
    if (pact && (rr_) < 34 && tr_ >= (slo_) && tr_ <= (shi_)) dst_ = *(const uint4*)(rbase_g + (size_t)tr_ * 1024); \
  }
#define RW_PG1(dst_, rr_, plo_)                                                                     \
  {                                                                                                 \
    dst_ = make_uint4(0, 0, 0, 0);                                                                  \
    if (pact && (rr_) < 32) dst_ = *(const uint4*)(pbase_g + (size_t)((plo_) + (rr_)) * 512);       \
  }
#define RW_PREFETCH(cix_)                                                                 \
  {                                                                                       \
    int plo_, slo_, shi_;                                                                 \
    RW_GEOM(cix_, plo_, slo_, shi_);                                                      \
    RW_PF1(pf0, prow, plo_, slo_, shi_); RW_PF1(pf1, prow + 10, plo_, slo_, shi_);        \
    RW_PF1(pf2, prow + 20, plo_, slo_, shi_); RW_PF1(pf3, prow + 30, plo_, slo_, shi_);   \
    RW_PG1(pg0, prow, plo_); RW_PG1(pg1, prow + 10, plo_);                                \
    RW_PG1(pg2, prow + 20, plo_); RW_PG1(pg3, prow + 30, plo_);                           \
  }
#define RW_STASH()                                                                        \
  {                                                                                       \
    if (pact) {                                                                           \
      *(uint4*)(raw + prow * 192 + pcc * 8) = pf0;                                        \
      *(uint4*)(raw + (prow + 10) * 192 + pcc * 8) = pf1;                                 \
      *(uint4*)(raw + (prow + 20) * 192 + pcc * 8) = pf2;                                 \
      if (prow + 30 < 34) *(uint4*)(raw + (prow + 30) * 192 + pcc * 8) = pf3;             \
      *(uint4*)(pre + prow * 192 + pcc * 8) = pg0;                                        \
      *(uint4*)(pre + (prow + 10) * 192 + pcc * 8) = pg1;                                 \
      *(uint4*)(pre + (prow + 20) * 192 + pcc * 8) = pg2;                                 \
      if (prow + 30 < 32) *(uint4*)(pre + (prow + 30) * 192 + pcc * 8) = pg3;             \
    }                                                                                     \
  }
  RW_PREFETCH(cbeg);
  RW_STASH();
  __syncthreads();
  for (int cix = cbeg; cix < cend; ++cix) {
    int plo, slo, shi;
    RW_GEOM(cix, plo, slo, shi);
#pragma unroll
    for (int k = 0; k < 2; ++k) {
      const int i = (tid >> 4) + 16 * k;
      const int ri = (d == 0) ? i + 1 : 32 - i;
      const bf16_t* r0 = raw + ri * 192 + lc;
      const bf16_t* q0 = pre + (ri - 1) * 192 + lc;
      float rs[4], ksv[4], vs[4];
#pragma unroll
      for (int sl = 0; sl < 3; ++sl) {
        const uint2 uc = *(const uint2*)(r0 + sl * 64), up = *(const uint2*)(r0 + sl * 64 - 192), un = *(const uint2*)(r0 + sl * 64 + 192);
        const float4 m0 = (sl == 0) ? m0r : ((sl == 1) ? m0k : m0v);
        const float4 m1 = (sl == 0) ? m1r : ((sl == 1) ? m1k : m1v);
        float* dst = (sl == 0) ? rs : ((sl == 1) ? ksv : vs);
        float u, a, n;
        u = __uint_as_float(uc.x << 16); a = __uint_as_float(up.x << 16); n = __uint_as_float(un.x << 16);
        dst[0] = u + m0.x * (a - u) + m1.x * (n - u);
        u = __uint_as_float(uc.x & 0xffff0000u); a = __uint_as_float(up.x & 0xffff0000u); n = __uint_as_float(un.x & 0xffff0000u);
        dst[1] = u + m0.y * (a - u) + m1.y * (n - u);
        u = __uint_as_float(uc.y << 16); a = __uint_as_float(up.y << 16); n = __uint_as_float(un.y << 16);
        dst[2] = u + m0.z * (a - u) + m1.z * (n - u);
        u = __uint_as_float(uc.y & 0xffff0000u); a = __uint_as_float(up.y & 0xffff0000u); n = __uint_as_float(un.y & 0xffff0000u);
        dst[3] = u + m0.w * (a - u) + m1.w * (n - u);
      }
      const uint2 ue = *(const uint2*)(q0), ua = *(const uint2*)(q0 + 64), uk = *(const uint2*)(q0 + 128);
      const float ew[4] = {__uint_as_float(ue.x << 16), __uint_as_float(ue.x & 0xffff0000u), __uint_as_float(ue.y << 16), __uint_as_float(ue.y & 0xffff0000u)};
      const float av[4] = {__uint_as_float(ua.x << 16), __uint_as_float(ua.x & 0xffff0000u), __uint_as_float(ua.y << 16), __uint_as_float(ua.y & 0xffff0000u)};
      const float kk[4] = {__uint_as_float(uk.x << 16), __uint_as_float(uk.x & 0xffff0000u), __uint_as_float(uk.y << 16), __uint_as_float(uk.y & 0xffff0000u)};
      const float kav[4] = {ka4.x, ka4.y, ka4.z, ka4.w};
      float4 o0, o1, o2, o3, o4, o5;
      float* f0 = (float*)&o0; float* f1 = (float*)&o1; float* f2 = (float*)&o2; float* f3 = (float*)&o3; float* f4 = (float*)&o4; float* f5 = (float*)&o5;
#pragma unroll
      for (int e = 0; e < 4; ++e) {
        f0[e] = __expf(-ew[e]);
        f1[e] = kk[e];
        f2[e] = kk[e] * av[e];
        f3[e] = ksv[e] * (1.f + (av[e] - 1.f) * kav[e]);
        f4[e] = rs[e];
        f5[e] = vs[e];
      }
      float* rp = rec + i * 384 + lc;
      *(float4*)(rp) = o0; *(float4*)(rp + 64) = o1; *(float4*)(rp + 128) = o2;
      *(float4*)(rp + 192) = o3; *(float4*)(rp + 256) = o4; *(float4*)(rp + 320) = o5;
    }
    __syncthreads();
    if (cix + 1 < cend) RW_PREFETCH(cix + 1);
    {
      const float* rp = rec + c0;
      const float* vp = rec + 320 + row;
      float4 w4 = *(const float4*)(rp), kk4 = *(const float4*)(rp + 64), kb4 = *(const float4*)(rp + 128);
      float4 kd4 = *(const float4*)(rp + 192), r4 = *(const float4*)(rp + 256);
      float v = vp[0];
      float ykeep = 0.f, gkeep = 0.f;
#pragma unroll 2
      for (int i = 0; i < 32; ++i) {
        const int inx = (i + 1) & 31;
        const float4 nw4 = *(const float4*)(rp + inx * 384), nkk4 = *(const float4*)(rp + inx * 384 + 64), nkb4 = *(const float4*)(rp + inx * 384 + 128);
        const float4 nkd4 = *(const float4*)(rp + inx * 384 + 192), nr4 = *(const float4*)(rp + inx * 384 + 256);
        const float nv = vp[inx * 384];
        v2f t = sA * (v2f){kk4.x, kk4.y};
        t = sB * (v2f){kk4.z, kk4.w} + t;
        float sa = t.x + t.y, ia = 0.f;
        if (DUAL) {
          v2f ti = iA * (v2f){kk4.x, kk4.y};
          ti = iB * (v2f){kk4.z, kk4.w} + ti;
          ia = ti.x + ti.y;
          sa += dppf<0xB1>(sa); ia += dppf<0xB1>(ia);
          sa += dppf<0x4E>(sa); ia += dppf<0x4E>(ia);
          sa += dppf<0x141>(sa); ia += dppf<0x141>(ia);
          sa += dppf<0x140>(sa); ia += dppf<0x140>(ia);
        } else {
          sa = sum16(sa);
        }
        v2f cA = sA * (v2f){w4.x, w4.y} + (v2f){kd4.x, kd4.y} * v;
        v2f cB = sB * (v2f){w4.z, w4.w} + (v2f){kd4.z, kd4.w} * v;
        sA = cA - (v2f){kb4.x, kb4.y} * sa;
        sB = cB - (v2f){kb4.z, kb4.w} * sa;
        v2f u = sA * (v2f){r4.x, r4.y};
        u = sB * (v2f){r4.z, r4.w} + u;
        float y = u.x + u.y, g = 0.f;
        if (DUAL) {
          iA = iA * (v2f){w4.x, w4.y} - (v2f){kb4.x, kb4.y} * ia;
          iB = iB * (v2f){w4.z, w4.w} - (v2f){kb4.z, kb4.w} * ia;
          v2f ui = iA * (v2f){r4.x, r4.y};
          ui = iB * (v2f){r4.z, r4.w} + ui;
          g = ui.x + ui.y;
          y += dppf<0xB1>(y); g += dppf<0xB1>(g);
          y += dppf<0x4E>(y); g += dppf<0x4E>(g);
          y += dppf<0x141>(y); g += dppf<0x141>(g);
          y += dppf<0x140>(y); g += dppf<0x140>(g);
          if (fr == (i & 15)) gkeep = g;
        } else {
          y = sum16(y);
        }
        if (fr == (i & 15)) ykeep = y;
        if ((i & 15) == 15) {
          const int ii = (i & 16) + fr;
          const int ri = (d == 0) ? ii + 1 : 32 - ii;
          const int pi = plo - 1 + ri;
          p.yR[((size_t)d * TOK + rowbase + pi) * 256 + h * 64 + row] = f2bf(ykeep);
          if (DUAL) p.GID[((size_t)(d * 4 + b) * NSEG1 + (cix - CSPLIT) * 32 + ii) * 256 + h * 64 + row] = f2bf(gkeep);
        }
        w4 = nw4; kk4 = nkk4; kb4 = nkb4; kd4 = nkd4; r4 = nr4; v = nv;
      }
    }
    if (cix + 1 < cend) RW_STASH();
    __syncthreads();
  }
  if (part == 0) *(float4*)(p.SMID + ((size_t)(((d * 4 + b) * 4 + h) * 64 + row)) * 64 + c0) = make_float4(sA.x, sA.y, sB.x, sB.y);
}

__device__ __forceinline__ void rwkv_fix_tile(const Params& p, int tile) {
  const int mb = tile % (NSEG1 / 64), dbh = tile / (NSEG1 / 64), h = dbh & 3, b = (dbh >> 2) & 3, d = dbh >> 4;
  const int tid = launder(threadIdx.x), lane = tid & 63, w = tid >> 6, fr = lane & 15, fq = lane >> 4;
  const size_t rowbase = (size_t)b * TPB;
  const int s0 = mb * 64 + 16 * w;
  const bf16_t* gp = p.GID + ((size_t)(d * 4 + b) * NSEG1 + s0 + fr) * 256 + h * 64 + fq * 8;
  const bf16x8 a0 = *(const bf16x8*)gp, a1 = *(const bf16x8*)(gp + 32);
#pragma unroll
  for (int nt = 0; nt < 4; ++nt) {
    const float* sp = p.SMID + ((size_t)(dbh * 64 + nt * 16 + fr)) * 64 + fq * 8;
    const float4 f0 = *(const float4*)sp, f1 = *(const float4*)(sp + 4), f2 = *(const float4*)(sp + 32), f3 = *(const float4*)(sp + 36);
    union { unsigned u[4]; bf16x8 v; } b0, b1;
    b0.u[0] = pack2(f0.x, f0.y); b0.u[1] = pack2(f0.z, f0.w); b0.u[2] = pack2(f1.x, f1.y); b0.u[3] = pack2(f1.z, f1.w);
    b1.u[0] = pack2(f2.x, f2.y); b1.u[1] = pack2(f2.z, f2.w); b1.u[2] = pack2(f3.x, f3.y); b1.u[3] = pack2(f3.z, f3.w);
    f32x4 acc = (f32x4){0.f, 0.f, 0.f, 0.f};
    acc = MFMA(a0, b0.v, acc);
    acc = MFMA(a1, b1.v, acc);
#pragma unroll
    for (int j = 0; j < 4; ++j) {
      const int st = CSPLIT * 32 + s0 + fq * 4 + j;
      const int pp = (d == 0) ? st : ((st < 256) ? 255 - st : 4607 - st);
      bf16_t* yp = p.yR + ((size_t)d * TOK + rowbase + pp) * 256 + h * 64 + nt * 16 + fr;
      *yp = f2bf(bf2f(*yp) + acc[j]);
    }
  }
}
__device__ __forceinline__ void phase_rwkvfix(const Params& p) {
  for (int t = blockIdx.x; t < 32 * (NSEG1 / 64); t += gridDim.x) rwkv_fix_tile(p, t);
}

__device__ __forceinline__ void ssd_conv_tile(const Params& p, int l, int tile, unsigned char* smem) {
  const int b = tile >> 7, t34 = tile & 127, pp0 = t34 * 34;
  const size_t r0 = (size_t)b * TPB + pp0;
  bf16_t* T = (bf16_t*)smem;
  const int tid = launder(threadIdx.x);
  for (int q = tid; q < 34 * 112; q += 256) {
    const int rr = q / 112, cc = q % 112;
    *(uint4*)(T + (rr + 1) * 896 + cc * 8) = *(const uint4*)(p.PS + (r0 + rr) * 912 + cc * 8);
  }
  if (tid < 224) {
    const int which = tid / 112, cc = tid % 112;
    const bool ex = (which == 0) ? (t34 >= 1) : (t34 + 1 < 128);
    uint4 v = make_uint4(0, 0, 0, 0);
    if (ex) v = *(const uint4*)(p.HALO + ((size_t)(b * 128 + t34) * 2 + which) * 896 + cc * 8);
    *(uint4*)(T + (which ? 35 : 0) * 896 + cc * 8) = v;
  }
  __syncthreads();
  const float* cw = p.ssm_conv_w + (size_t)l * 3 * 896;
  const float* cb = p.ssm_conv_b + (size_t)l * 896;
  for (int c = tid; c < 896; c += 256) {
    const float w0 = cw[c], w1 = cw[896 + c], w2 = cw[1792 + c], bs = cb[c];
    float um = bf2f(T[c]), u0 = bf2f(T[896 + c]);
#pragma unroll 2
    for (int rr = 0; rr < 34; ++rr) {
      const float up = bf2f(T[(rr + 2) * 896 + c]);
      const int pp = pp0 + rr;
      const bool pv = (pp != 0) && (pp != 256), nv = (pp != 255) && (pp != 4351);
      const float v = w0 * (pv ? um : 0.f) + w1 * u0 + w2 * (nv ? up : 0.f) + bs;
      p.PS[(r0 + rr) * 912 + c] = f2bf(siluf_(v));
      um = u0; u0 = up;
    }
  }
  __syncthreads();
}
__device__ __forceinline__ void ssd_dtcum_tile(const Params& p, int l, int tile, unsigned char* smem) {
  const int b = tile / 136, c32 = tile % 136, p0 = c32 * 32;
  float* draw = (float*)smem;
  const int tid = launder(threadIdx.x);
  for (int q = tid; q < 384; q += 256) {
    const int i = q / 12, dh = q % 12;
    draw[q] = bf2f(p.PS[((size_t)b * TPB + p0 + i) * 912 + 896 + dh]);
  }
  __syncthreads();
  if (tid < 12) {
    const int dh = tid, d = dh / 6, h = dh % 6;
    const float a_neg = -__expf(p.ssm_a_log[(l * 2 + d) * 6 + h]);
    const float bias = p.ssm_dt_bias[(l * 2 + d) * 6 + h];
    float cum = 0.f;
    for (int k = 0; k < 32; ++k) {
      const int it = (d == 0) ? k : 31 - k;
      const float dt = softplusf_(draw[it * 12 + dh] + bias);
      cum += dt * a_neg;
      p.DTC[(size_t)dh * TOK + (size_t)b * TPB + p0 + it] = make_float2(dt, cum);
    }
  }
  __syncthreads();
}

__device__ __forceinline__ void ssd_tile(const Params& p, int l, int tile, unsigned char* smem) {
  const int h = tile % 6, b = (tile / 6) & 3, d = tile / 24, g = h / 3;
  bf16_t* Cs0 = (bf16_t*)smem;
  bf16_t* Bs = Cs0 + 2 * 32 * 136;
  bf16_t* Xs = Bs + 32 * 136;
  bf16_t* BtT = Xs + 32 * 72;
  bf16_t* XdT = BtT + 128 * 40;
  bf16_t* Ms = XdT + 64 * 40;
  bf16_t* Sb = Ms + 32 * 40;
  float* dc = (float*)(Sb + 64 * 136);
  const int tid = launder(threadIdx.x), lane = tid & 63, w = tid >> 6, fr = lane & 15, fq = lane >> 4;
  const size_t rowbase = (size_t)b * TPB;
  f32x4 S[4][2];
#pragma unroll
  for (int i = 0; i < 4; ++i)
#pragma unroll
    for (int j = 0; j < 2; ++j) S[i][j] = (f32x4){0.f, 0.f, 0.f, 0.f};
  const int pcc = tid % 40, prow = tid / 40;
  const bool pact = tid < 240;
  const int pcol = (pcc < 16) ? (640 + g * 128 + pcc * 8) : ((pcc < 32) ? (384 + g * 128 + (pcc - 16) * 8) : (h * 64 + (pcc - 32) * 8));
  const bf16_t* pbase = p.PS + rowbase * 912 + pcol;
  const float2* dbase = p.DTC + (size_t)(d * 6 + h) * TOK + rowbase;
  const int drow_stride = (pcc < 32) ? 136 : 72;
  uint4 pf0, pf1, pf2, pf3, pf4, pf5;
  float2 dtc = make_float2(0.f, 0.f);
#define SD_GEOM(cix_, plo_)                                                \
  {                                                                        \
    const int st0_ = (cix_) * 32;                                          \
    if (st0_ < 256) plo_ = (d == 0) ? st0_ : 224 - st0_;                   \
    else plo_ = (d == 0) ? st0_ : 4576 - st0_;                             \
  }
#define SD_PF1(dst_, rr_, plo_)                                                                   \
  {                                                                                               \
    dst_ = make_uint4(0, 0, 0, 0);                                                                \
    if (pact && (rr_) < 32) dst_ = *(const uint4*)(pbase + (size_t)((plo_) + (rr_)) * 912);       \
  }
#define SD_PREFETCH(cix_)                                                          \
  {                                                                                \
    int plo_;                                                                      \
    SD_GEOM(cix_, plo_);                                                           \
    SD_PF1(pf0, prow, plo_); SD_PF1(pf1, prow + 6, plo_); SD_PF1(pf2, prow + 12, plo_); \
    SD_PF1(pf3, prow + 18, plo_); SD_PF1(pf4, prow + 24, plo_); SD_PF1(pf5, prow + 30, plo_); \
    if (tid < 32) dtc = dbase[plo_ + tid];                                         \
  }
#define SD_ST1(src_, rr_, cbuf_)                                                                  \
  {                                                                                               \
    if (pact && (rr_) < 32) {                                                                     \
      const int i_ = (d == 0) ? (rr_) : 31 - (rr_);                                               \
      bf16_t* dst_ = (pcc < 16) ? ((cbuf_) + i_ * 136 + pcc * 8) : ((pcc < 32) ? (Bs + i_ * 136 + (pcc - 16) * 8) : (Xs + i_ * 72 + (pcc - 32) * 8)); \
      *(uint4*)dst_ = src_;                                                                       \
    }                                                                                             \
  }
#define SD_STASH(buf_)                                                              \
  {                                                                                 \
    bf16_t* cbuf_ = Cs0 + (buf_) * 32 * 136;                                        \
    SD_ST1(pf0, prow, cbuf_); SD_ST1(pf1, prow + 6, cbuf_); SD_ST1(pf2, prow + 12, cbuf_); \
    SD_ST1(pf3, prow + 18, cbuf_); SD_ST1(pf4, prow + 24, cbuf_); SD_ST1(pf5, prow + 30, cbuf_); \
    if (tid < 32) {                                                                 \
      const int i_ = (d == 0) ? tid : 31 - tid;                                     \
      dc[(buf_) * 64 + i_] = dtc.x;                                                 \
      dc[(buf_) * 64 + 32 + i_] = dtc.y;                                            \
    }                                                                               \
  }
  (void)drow_stride;
  SD_PREFETCH(0);
  SD_STASH(0);
  __syncthreads();
  for (int cix = 0; cix < 136; ++cix) {
    int plo;
    SD_GEOM(cix, plo);
    const int buf = cix & 1;
    const bf16_t* Cs = Cs0 + buf * 32 * 136;
    const float* dts = dc + buf * 64;
    const float* cums = dts + 32;
    {
      const int j = tid & 31, ng = tid >> 5;
      const float tail = __expf(cums[31] - cums[j]);
      const float dtj = dts[j];
      const uint4 b0 = *(const uint4*)(Bs + j * 136 + ng * 16), b1 = *(const uint4*)(Bs + j * 136 + ng * 16 + 8);
      const uint4 x0 = *(const uint4*)(Xs + j * 72 + ng * 8);
      const unsigned bw[8] = {b0.x, b0.y, b0.z, b0.w, b1.x, b1.y, b1.z, b1.w};
      const unsigned xw[4] = {x0.x, x0.y, x0.z, x0.w};
#pragma unroll
      for (int e = 0; e < 8; ++e) {
        const unsigned pk = pack2(__uint_as_float(bw[e] << 16) * tail, __uint_as_float(bw[e] & 0xffff0000u) * tail);
        BtT[(ng * 16 + 2 * e) * 40 + j] = (bf16_t)(pk & 0xffffu);
        BtT[(ng * 16 + 2 * e + 1) * 40 + j] = (bf16_t)(pk >> 16);
      }
#pragma unroll
      for (int e = 0; e < 4; ++e) {
        const unsigned pk = pack2(__uint_as_float(xw[e] << 16) * dtj, __uint_as_float(xw[e] & 0xffff0000u) * dtj);
        XdT[(ng * 8 + 2 * e) * 40 + j] = (bf16_t)(pk & 0xffffu);
        XdT[(ng * 8 + 2 * e + 1) * 40 + j] = (bf16_t)(pk >> 16);
      }
#pragma unroll
      for (int mt = 0; mt < 4; ++mt)
#pragma unroll
        for (int t = 0; t < 2; ++t)
#pragma unroll
          for (int jj = 0; jj < 4; ++jj) Sb[(mt * 16 + fq * 4 + jj) * 136 + (2 * w + t) * 16 + fr] = f2bf(S[mt][t][jj]);
      const int mi = w >> 1, nj = w & 1;
      f32x4 acc = (f32x4){0.f, 0.f, 0.f, 0.f};
#pragma unroll
      for (int ks = 0; ks < 4; ++ks) {
        bf16x8 a = *(const bf16x8*)(Cs + (mi * 16 + fr) * 136 + ks * 32 + fq * 8);
        bf16x8 bb = *(const bf16x8*)(Bs + (nj * 16 + fr) * 136 + ks * 32 + fq * 8);
        acc = MFMA(a, bb, acc);
      }
      const int jc = nj * 16 + fr;
      const float cj = cums[jc];
#pragma unroll
      for (int jj = 0; jj < 4; ++jj) {
        const int i = mi * 16 + fq * 4 + jj;
        const float v = (jc <= i) ? acc[jj] * __expf(cums[i] - cj) : 0.f;
        Ms[i * 40 + jc] = f2bf(v);
      }
    }
    __syncthreads();
    if (cix + 1 < 136) SD_PREFETCH(cix + 1);
    {
      const int mi = w >> 1;
      bf16x8 am = *(const bf16x8*)(Ms + (mi * 16 + fr) * 40 + fq * 8);
      bf16x8 ac[4];
#pragma unroll
      for (int ks = 0; ks < 4; ++ks) ac[ks] = *(const bf16x8*)(Cs + (mi * 16 + fr) * 136 + ks * 32 + fq * 8);
#pragma unroll
      for (int t = 0; t < 2; ++t) {
        const int pt = 2 * (w & 1) + t;
        f32x4 y1 = (f32x4){0.f, 0.f, 0.f, 0.f}, y2 = (f32x4){0.f, 0.f, 0.f, 0.f};
        bf16x8 bx = *(const bf16x8*)(XdT + (pt * 16 + fr) * 40 + fq * 8);
        y1 = MFMA(am, bx, y1);
#pragma unroll
        for (int ks = 0; ks < 4; ++ks) {
          bf16x8 bs = *(const bf16x8*)(Sb + (pt * 16 + fr) * 136 + ks * 32 + fq * 8);
          y2 = MFMA(ac[ks], bs, y2);
        }
#pragma unroll
        for (int jj = 0; jj < 4; ++jj) {
          const int i = mi * 16 + fq * 4 + jj;
          const int pi = plo + ((d == 0) ? i : 31 - i);
          const float y = y1[jj] + __expf(cums[i]) * y2[jj];
          p.yS[((size_t)d * TOK + rowbase + pi) * 384 + h * 64 + pt * 16 + fr] = f2bf(y);
        }
      }
      const float dec = __expf(cums[31]);
      bf16x8 bt[2];
#pragma unroll
      for (int t = 0; t < 2; ++t) bt[t] = *(const bf16x8*)(BtT + ((2 * w + t) * 16 + fr) * 40 + fq * 8);
#pragma unroll
      for (int mt = 0; mt < 4; ++mt) {
        bf16x8 ax = *(const bf16x8*)(XdT + (mt * 16 + fr) * 40 + fq * 8);
#pragma unroll
        for (int t = 0; t < 2; ++t) {
          S[mt][t] *= dec;
          S[mt][t] = MFMA(ax, bt[t], S[mt][t]);
        }
      }
    }
    if (cix + 1 < 136) SD_STASH(buf ^ 1);
    __syncthreads();
  }
}

__device__ __forceinline__ void attn_tile(const Params& p, int l, int tile, unsigned char* smem) {
  const bool isctx = tile >= 768;
  int qt, head, b;
  if (!isctx) { qt = tile & 31; head = (tile >> 5) % 6; b = tile / 192; }
  else { int tt = tile - 768; qt = tt & 1; head = (tt >> 1) % 6; b = tt / 12; }
  const int hkv = head / 3;
  const int tid = launder(threadIdx.x), lane = tid & 63, w = tid >> 6, fr = lane & 15, fq = lane >> 4;
  bf16_t* Ks = (bf16_t*)smem;
  bf16_t* Vt = Ks + 64 * 72;
  bf16_t* Ps = Vt + 64 * 72 + w * 32 * 72;
  const int q0 = qt * 128;
  const size_t rowb = (size_t)b * TPB;
  const size_t rowq0 = rowb + (isctx ? q0 : 256 + q0);
  bf16x8 qf[2][2];
  float m[2][4], ls[2][4];
  f32x4 o[2][4];
  const float sk = p.attn_sink[l * 6 + head];
#pragma unroll
  for (int mt = 0; mt < 2; ++mt) {
    const int qi0 = (2 * w + mt) * 16;
#pragma unroll
    for (int ks = 0; ks < 2; ++ks) qf[mt][ks] = *(const bf16x8*)(p.PA + (rowq0 + qi0 + fr) * 1024 + head * 64 + ks * 32 + fq * 8);
#pragma unroll
    for (int j = 0; j < 4; ++j) { m[mt][j] = sk; ls[mt][j] = 1.f; }
#pragma unroll
    for (int nt = 0; nt < 4; ++nt) o[mt][nt] = (f32x4){0.f, 0.f, 0.f, 0.f};
  }
  int klo = 0, nb = 0;
  if (!isctx) {
    klo = max(0, q0 - 128);
    const int khi = min(4096, q0 + 256);
    nb = (khi - klo) >> 6;
  }
  const int ntile = nb + 4;
  const int lr = tid >> 3, lc = tid & 7;
  uint4 kr0, kr1, vr0, vr1;
#define KVLOAD(kt_)                                                                              \
  {                                                                                              \
    const size_t kr0_ = ((kt_) < nb) ? rowb + 256 + klo + (kt_) * 64 : rowb + ((kt_) - nb) * 64; \
    const bf16_t* src0 = p.PA + (kr0_ + lr) * 1024 + 384 + hkv * 64 + lc * 8;                    \
    const bf16_t* src1 = src0 + 32 * 1024;                                                       \
    kr0 = *(const uint4*)src0;                                                                   \
    vr0 = *(const uint4*)(src0 + 128);                                                           \
    kr1 = *(const uint4*)src1;                                                                   \
    vr1 = *(const uint4*)(src1 + 128);                                                           \
  }
#define VTSTORE(vr_, rr_)                                                 \
  {                                                                       \
    Vt[(lc * 8 + 0) * 72 + (rr_)] = (bf16_t)((vr_).x & 0xffffu);          \
    Vt[(lc * 8 + 1) * 72 + (rr_)] = (bf16_t)((vr_).x >> 16);              \
    Vt[(lc * 8 + 2) * 72 + (rr_)] = (bf16_t)((vr_).y & 0xffffu);          \
    Vt[(lc * 8 + 3) * 72 + (rr_)] = (bf16_t)((vr_).y >> 16);              \
    Vt[(lc * 8 + 4) * 72 + (rr_)] = (bf16_t)((vr_).z & 0xffffu);          \
    Vt[(lc * 8 + 5) * 72 + (rr_)] = (bf16_t)((vr_).z >> 16);              \
    Vt[(lc * 8 + 6) * 72 + (rr_)] = (bf16_t)((vr_).w & 0xffffu);          \
    Vt[(lc * 8 + 7) * 72 + (rr_)] = (bf16_t)((vr_).w >> 16);              \
  }
  KVLOAD(0);
  for (int kt = 0; kt < ntile; ++kt) {
    __syncthreads();
    *(uint4*)(Ks + lr * 72 + lc * 8) = kr0;
    *(uint4*)(Ks + (lr + 32) * 72 + lc * 8) = kr1;
    VTSTORE(vr0, lr);
    VTSTORE(vr1, lr + 32);
    __syncthreads();
    if (kt + 1 < ntile) KVLOAD(kt + 1);
    f32x4 s[2][4];
#pragma unroll
    for (int mt = 0; mt < 2; ++mt)
#pragma unroll
      for (int nt = 0; nt < 4; ++nt) s[mt][nt] = (f32x4){0.f, 0.f, 0.f, 0.f};
#pragma unroll
    for (int ks = 0; ks < 2; ++ks) {
#pragma unroll
      for (int nt = 0; nt < 4; ++nt) {
        bf16x8 kb = *(const bf16x8*)(Ks + (nt * 16 + fr) * 72 + ks * 32 + fq * 8);
#pragma unroll
        for (int mt = 0; mt < 2; ++mt) s[mt][nt] = MFMA(qf[mt][ks], kb, s[mt][nt]);
      }
    }
    const bool band = kt < nb;
    const int kp0 = klo + kt * 64 + fr;
#pragma unroll
    for (int mt = 0; mt < 2; ++mt) {
      const int qi0 = (2 * w + mt) * 16;
#pragma unroll
      for (int j = 0; j < 4; ++j) {
        const int qp = q0 + qi0 + fq * 4 + j;
        float sv0 = s[mt][0][j], sv1 = s[mt][1][j], sv2 = s[mt][2][j], sv3 = s[mt][3][j];
        if (band) {
          const int dlt = qp - kp0;
          if (dlt > 128 || dlt < -128) sv0 = -INFINITY;
          if (dlt - 16 > 128 || dlt - 16 < -128) sv1 = -INFINITY;
          if (dlt - 32 > 128 || dlt - 32 < -128) sv2 = -INFINITY;
          if (dlt - 48 > 128 || dlt - 48 < -128) sv3 = -INFINITY;
        }
        float mx = fmaxf(fmaxf(sv0, sv1), fmaxf(sv2, sv3));
        mx = max16(mx);
        const float mn = fmaxf(m[mt][j], mx);
        const float alpha = __expf(m[mt][j] - mn);
        const float p0 = __expf(sv0 - mn), p1 = __expf(sv1 - mn), p2 = __expf(sv2 - mn), p3 = __expf(sv3 - mn);
        bf16_t* pr = Ps + (mt * 16 + fq * 4 + j) * 72 + fr;
        pr[0] = f2bf(p0); pr[16] = f2bf(p1); pr[32] = f2bf(p2); pr[48] = f2bf(p3);
        const float rsum = sum16(p0 + p1 + p2 + p3);
        ls[mt][j] = ls[mt][j] * alpha + rsum;
        m[mt][j] = mn;
#pragma unroll
        for (int nt = 0; nt < 4; ++nt) o[mt][nt][j] *= alpha;
      }
    }
    __builtin_amdgcn_wave_barrier();
#pragma unroll
    for (int ks = 0; ks < 2; ++ks) {
      bf16x8 pa[2];
#pragma unroll
      for (int mt = 0; mt < 2; ++mt) pa[mt] = *(const bf16x8*)(Ps + (mt * 16 + fr) * 72 + ks * 32 + fq * 8);
#pragma unroll
      for (int nt = 0; nt < 4; ++nt) {
        bf16x8 vb = *(const bf16x8*)(Vt + (nt * 16 + fr) * 72 + ks * 32 + fq * 8);
#pragma unroll
        for (int mt = 0; mt < 2; ++mt) o[mt][nt] = MFMA(pa[mt], vb, o[mt][nt]);
      }
    }
    __builtin_amdgcn_wave_barrier();
  }
#pragma unroll
  for (int mt = 0; mt < 2; ++mt) {
    const int qi0 = (2 * w + mt) * 16;
#pragma unroll
    for (int j = 0; j < 4; ++j) {
      const size_t r = rowq0 + qi0 + fq * 4 + j;
      const float inv = frcp(ls[mt][j]);
#pragma unroll
      for (int nt = 0; nt < 4; ++nt) {
        const int dc = nt * 16 + fr;
        const float gt = bf2f(p.PA[r * 1024 + 640 + head * 64 + dc]);
        p.PA[r * 1024 + head * 64 + dc] = f2bf(o[mt][nt][j] * inv * siluf_(gt));
      }
    }
  }
  __syncthreads();
}

#ifndef PROBE_DUP
#define PROBE_DUP 0
#endif
__device__ __forceinline__ void phase_probe(const Params& p, int l, unsigned char* smem) {
  if (PROBE_DUP == 1) { for (int t = blockIdx.x; t < 256; t += gridDim.x) { if (t < 128) rwkv_tile<false>(p, l, t, smem); else rwkv_tile<true>(p, l, t, smem); } }
  if (PROBE_DUP == 2) { for (int t = blockIdx.x; t < 48; t += gridDim.x) ssd_tile(p, l, t, smem); }
}
__device__ __forceinline__ void phase_mixers(const Params& p, int l, unsigned char* smem) {
  const int natt = (l == 0) ? 816 : 768;
  const int bid = blockIdx.x, G = gridDim.x;
  if (G == 512) {
    if (bid < 128) {
      __builtin_amdgcn_s_setprio(3);
      rwkv_tile<false>(p, l, bid, smem);
      __builtin_amdgcn_s_setprio(0);
    } else if (bid < 256) {
      __builtin_amdgcn_s_setprio(3);
      rwkv_tile<true>(p, l, bid, smem);
      __builtin_amdgcn_s_setprio(0);
    } else if (bid < 304) {
      __builtin_amdgcn_s_setprio(2);
      ssd_tile(p, l, bid - 256, smem);
      __builtin_amdgcn_s_setprio(0);
    }
    int* tsl = (int*)(smem + 73728);
    const int tid = launder(threadIdx.x);
    if (l == 0) {
      for (;;) {
        __syncthreads();
        if (tid == 0) *tsl = (int)atomicAdd(&p.ctrs[2], 1u);
        __syncthreads();
        const int t = *tsl;
        if (t >= 1440) break;
        deferred_transpose(p, t, smem);
      }
    }
    for (;;) {
      __syncthreads();
      if (tid == 0) *tsl = (int)atomicAdd(&p.ctrs[l], 1u);
      __syncthreads();
      const int t = *tsl;
      if (t >= natt) break;
      attn_tile(p, l, t, smem);
    }
    for (;;) {
      __syncthreads();
      if (tid == 0) *tsl = (int)atomicAdd(&p.ctrs[4 + l], 1u);
      __syncthreads();
      const int j = *tsl;
      if (j >= 136 * 5) break;
      gemm_late_tile(p, l, j / 5, 16 + j % 5, smem);
    }
  } else {
    if (l == 0) for (int t = bid; t < 1440; t += G) deferred_transpose(p, t, smem);
    for (int t = bid; t < 136 * 5; t += G) gemm_late_tile(p, l, t / 5, 16 + t % 5, smem);
    const int total = 304 + natt;
    for (int t = bid; t < total; t += G) {
      if (t < 128) rwkv_tile<false>(p, l, t, smem);
      else if (t < 256) rwkv_tile<true>(p, l, t, smem);
      else if (t < 304) ssd_tile(p, l, t - 256, smem);
      else attn_tile(p, l, t - 304, smem);
    }
  }
}

__device__ __forceinline__ float blo(unsigned u) { return __uint_as_float(u << 16); }
__device__ __forceinline__ float bhi(unsigned u) { return __uint_as_float(u & 0xffff0000u); }
__device__ __forceinline__ void phase_finish(const Params& p, int l) {
  const int tid = launder(threadIdx.x), lane = tid & 63, w = tid >> 6;
  bf16_t* mix = p.hbuf;
  const int cg_ = lane * 4, hh4 = lane >> 4;
  const float* mu0 = p.rwkv_mu + (size_t)(l * 2) * 1024 + cg_;
  const float* mu1 = mu0 + 1024;
  const float4 m0r = *(const float4*)mu0, m1r = *(const float4*)mu1;
  const float4 m0k = *(const float4*)(mu0 + 256), m1k = *(const float4*)(mu1 + 256);
  const float4 m0v = *(const float4*)(mu0 + 512), m1v = *(const float4*)(mu1 + 512);
  const float4 rk4 = *(const float4*)(p.rwkv_r_k + l * 256 + hh4 * 64 + (cg_ & 63));
  const float4 lw4 = *(const float4*)(p.rwkv_ln_w + l * 256 + cg_), lb4 = *(const float4*)(p.rwkv_ln_b + l * 256 + cg_);
  const int cs_ = lane * 6;
  const float2 nw0 = *(const float2*)(p.ssm_norm_w + l * 384 + cs_), nw1 = *(const float2*)(p.ssm_norm_w + l * 384 + cs_ + 2), nw2 = *(const float2*)(p.ssm_norm_w + l * 384 + cs_ + 4);
  const float dsk0 = p.ssm_d[l * 6 + (cs_ >> 6)], dsk1 = p.ssm_d[l * 6 + ((cs_ + 2) >> 6)], dsk2 = p.ssm_d[l * 6 + ((cs_ + 4) >> 6)];
  for (int t = blockIdx.x; t < TOK / 4; t += gridDim.x) {
    const int r = t * 4 + w, pp = r % TPB;
    if (l == 1 && pp < 256) continue;
    const bool isc = pp < 256;
    const int slo = isc ? 0 : 256, shi = isc ? 255 : 4351;
    const bool hp = pp > slo, hn = pp < shi;
    const unsigned* a32 = (const unsigned*)(p.PA + (size_t)r * 1024 + lane * 6);
    const unsigned at0 = a32[0], at1 = a32[1], at2 = a32[2];
    const uint2 ya = *(const uint2*)(p.yR + (size_t)r * 256 + cg_);
    const uint2 yb = *(const uint2*)(p.yR + ((size_t)TOK + r) * 256 + cg_);
    const bf16_t* pr = p.PR + (size_t)r * 1024 + cg_;
    const uint2 z2 = make_uint2(0u, 0u);
    const uint2 rc = *(const uint2*)pr, kc = *(const uint2*)(pr + 256), vc = *(const uint2*)(pr + 512);
    const uint2 rp = hp ? *(const uint2*)(pr - 1024) : z2, kp = hp ? *(const uint2*)(pr + 256 - 1024) : z2, vp = hp ? *(const uint2*)(pr + 512 - 1024) : z2;
    const uint2 rn = hn ? *(const uint2*)(pr + 1024) : z2, kn = hn ? *(const uint2*)(pr + 256 + 1024) : z2, vn = hn ? *(const uint2*)(pr + 512 + 1024) : z2;
    const uint2 g2 = *(const uint2*)(p.PG + (size_t)r * 640 + cg_);
    const unsigned* s0 = (const unsigned*)(p.yS + (size_t)r * 384 + cs_);
    const unsigned* s1 = (const unsigned*)(p.yS + ((size_t)TOK + r) * 384 + cs_);
    const unsigned* xs32 = (const unsigned*)(p.PS + (size_t)r * 912 + cs_);
    const unsigned* z32 = (const unsigned*)(p.PG + (size_t)r * 640 + 256 + cs_);
    const unsigned sa0 = s0[0], sa1 = s0[1], sa2 = s0[2], sb0 = s1[0], sb1 = s1[1], sb2 = s1[2];
    const unsigned xa0 = xs32[0], xa1 = xs32[1], xa2 = xs32[2], za0 = z32[0], za1 = z32[1], za2 = z32[2];
    {
      unsigned* d32 = (unsigned*)(mix + (size_t)r * 1024 + lane * 6);
      d32[0] = at0; d32[1] = at1; d32[2] = at2;
    }
    {
      float y[4] = {blo(ya.x) + blo(yb.x), bhi(ya.x) + bhi(yb.x), blo(ya.y) + blo(yb.y), bhi(ya.y) + bhi(yb.y)};
      const float sm = sum16(y[0] + y[1] + y[2] + y[3]);
      const float mean = sm * (1.f / 64.f);
      float vq = 0.f;
#pragma unroll
      for (int e = 0; e < 4; ++e) { y[e] -= mean; vq += y[e] * y[e]; }
      vq = sum16(vq);
      const float rstd = rsqrtf(vq * (1.f / 64.f) + 64e-5f);
      const float rs0 = blo(rc.x) + m0r.x * (blo(rp.x) - blo(rc.x)) + m1r.x * (blo(rn.x) - blo(rc.x));
      const float rs1 = bhi(rc.x) + m0r.y * (bhi(rp.x) - bhi(rc.x)) + m1r.y * (bhi(rn.x) - bhi(rc.x));
      const float rs2 = blo(rc.y) + m0r.z * (blo(rp.y) - blo(rc.y)) + m1r.z * (blo(rn.y) - blo(rc.y));
      const float rs3 = bhi(rc.y) + m0r.w * (bhi(rp.y) - bhi(rc.y)) + m1r.w * (bhi(rn.y) - bhi(rc.y));
      const float ks0 = blo(kc.x) + m0k.x * (blo(kp.x) - blo(kc.x)) + m1k.x * (blo(kn.x) - blo(kc.x));
      const float ks1 = bhi(kc.x) + m0k.y * (bhi(kp.x) - bhi(kc.x)) + m1k.y * (bhi(kn.x) - bhi(kc.x));
      const float ks2 = blo(kc.y) + m0k.z * (blo(kp.y) - blo(kc.y)) + m1k.z * (blo(kn.y) - blo(kc.y));
      const float ks3 = bhi(kc.y) + m0k.w * (bhi(kp.y) - bhi(kc.y)) + m1k.w * (bhi(kn.y) - bhi(kc.y));
      const float vs0 = blo(vc.x) + m0v.x * (blo(vp.x) - blo(vc.x)) + m1v.x * (blo(vn.x) - blo(vc.x));
      const float vs1 = bhi(vc.x) + m0v.y * (bhi(vp.x) - bhi(vc.x)) + m1v.y * (bhi(vn.x) - bhi(vc.x));
      const float vs2 = blo(vc.y) + m0v.z * (blo(vp.y) - blo(vc.y)) + m1v.z * (blo(vn.y) - blo(vc.y));
      const float vs3 = bhi(vc.y) + m0v.w * (bhi(vp.y) - bhi(vc.y)) + m1v.w * (bhi(vn.y) - bhi(vc.y));
      const float dot = sum16(rs0 * ks0 * rk4.x + rs1 * ks1 * rk4.y + rs2 * ks2 * rk4.z + rs3 * ks3 * rk4.w);
      const float o0 = (y[0] * rstd * lw4.x + lb4.x + dot * vs0) * siluf_(blo(g2.x));
      const float o1 = (y[1] * rstd * lw4.y + lb4.y + dot * vs1) * siluf_(bhi(g2.x));
      const float o2 = (y[2] * rstd * lw4.z + lb4.z + dot * vs2) * siluf_(blo(g2.y));
      const float o3 = (y[3] * rstd * lw4.w + lb4.w + dot * vs3) * siluf_(bhi(g2.y));
      uint2 ov;
      ov.x = pack2(o0, o1);
      ov.y = pack2(o2, o3);
      *(uint2*)(mix + (size_t)r * 1024 + 384 + cg_) = ov;
    }
    {
      const float y0 = (blo(sa0) + blo(sb0) + dsk0 * blo(xa0)) * siluf_(blo(za0));
      const float y1 = (bhi(sa0) + bhi(sb0) + dsk0 * bhi(xa0)) * siluf_(bhi(za0));
      const float y2 = (blo(sa1) + blo(sb1) + dsk1 * blo(xa1)) * siluf_(blo(za1));
      const float y3 = (bhi(sa1) + bhi(sb1) + dsk1 * bhi(xa1)) * siluf_(bhi(za1));
      const float y4 = (blo(sa2) + blo(sb2) + dsk2 * blo(xa2)) * siluf_(blo(za2));
      const float y5 = (bhi(sa2) + bhi(sb2) + dsk2 * bhi(xa2)) * siluf_(bhi(za2));
      float sq = sum16(y0 * y0 + y1 * y1 + y2 * y2 + y3 * y3 + y4 * y4 + y5 * y5);
      sq += __shfl_xor(sq, 16);
      const float rstd = rsqrtf(sq * (1.f / 192.f) + 1e-5f);
      unsigned* dd = (unsigned*)(mix + (size_t)r * 1024 + 640 + cs_);
      dd[0] = pack2(y0 * rstd * nw0.x, y1 * rstd * nw0.y);
      dd[1] = pack2(y2 * rstd * nw1.x, y3 * rstd * nw1.y);
      dd[2] = pack2(y4 * rstd * nw2.x, y5 * rstd * nw2.y);
    }
  }
}

#define XB_TMO      128
#define XB_XCNT(j)  (256  + 64 * (j))
#define XB_XSUB(j)  (1280 + 64 * (j))
#define XB_XGEN(j)  (2304 + 64 * (j))
#define XB_TOP      3328
#define XB_TOPGEN   3392
#define XCD_BAR_WORDS 3456
#define XB_SPIN_CAP (1u << 18)
#define LAS __attribute__((address_space(3)))

__device__ __forceinline__ unsigned xb_ld(unsigned* p)              { return __hip_atomic_load(p, __ATOMIC_RELAXED, __HIP_MEMORY_SCOPE_AGENT); }
__device__ __forceinline__ unsigned xb_add(unsigned* p, unsigned v) { return __hip_atomic_fetch_add(p, v, __ATOMIC_RELAXED, __HIP_MEMORY_SCOPE_AGENT); }
__device__ __forceinline__ unsigned xb_xcc_id() { return (unsigned)__builtin_amdgcn_s_getreg((3 << 11) | 20) & 0xFu; }
#define XB_SPIN(cond, bar) do { unsigned _sp = 0; while (cond) { __builtin_amdgcn_s_sleep(1); \
    if ((++_sp & 255u) == 0u) { if (xb_ld(&(bar)[XB_TMO])) break; if (_sp > XB_SPIN_CAP) { atomicAdd(&(bar)[XB_TMO], 1u); break; } } } } while (0)

struct XcdBarrier {
    unsigned* bar; unsigned x;
    volatile LAS unsigned* st;
};

__device__ __forceinline__ XcdBarrier xcd_barrier_post(unsigned* bar, volatile LAS unsigned* st) {
    XcdBarrier b; b.bar = bar; b.x = xb_xcc_id(); b.st = st;
    if (threadIdx.x == 0) (void)xb_add(&bar[XB_XCNT(b.x)], 1u);
    return b;
}
__device__ __forceinline__ void xcd_barrier_complete(unsigned* bar, unsigned x, unsigned& nloc, unsigned& nx) {
    const unsigned G = gridDim.x * gridDim.y * gridDim.z;
    unsigned sum, cnt, mine, sp = 0u;
    for (;;) {
        sum = 0u; cnt = 0u; mine = 0u;
#pragma unroll
        for (unsigned j = 0; j < 16; ++j) { const unsigned c = xb_ld(&bar[XB_XCNT(j)]); sum += c; cnt += (c > 0u) ? 1u : 0u; mine = (j == x) ? c : mine; }
        if (sum == G) break;
        __builtin_amdgcn_s_sleep(1);
        if ((++sp & 255u) == 0u) { if (xb_ld(&bar[XB_TMO])) break; if (sp > XB_SPIN_CAP) { atomicAdd(&bar[XB_TMO], 1u); break; } }
    }
    nloc = mine > 0u ? mine : 1u; nx = cnt > 0u ? cnt : 1u;
}

__device__ __forceinline__ void xcd_barrier(const XcdBarrier& b) {
    asm volatile("s_waitcnt vmcnt(0)" ::: "memory");
    __syncthreads();
    if (threadIdx.x == 0) {
        unsigned* bar = b.bar;
        __builtin_amdgcn_s_waitcnt(0);
        unsigned nloc = b.st[0], nx = b.st[1];
        if (nloc == 0u) { xcd_barrier_complete(bar, b.x, nloc, nx); b.st[0] = nloc; b.st[1] = nx; }
        const unsigned old = xb_add(&bar[XB_XSUB(b.x)], 1u);
        const unsigned gen = old / nloc;
        if (old + 1u == (gen + 1u) * nloc) {
            __builtin_amdgcn_fence(__ATOMIC_RELEASE, "agent");
            asm volatile("s_waitcnt vmcnt(0)" ::: "memory");
            const unsigned og = xb_add(&bar[XB_TOP], 1u);
            const unsigned tg = og / nx;
            if (og + 1u == (tg + 1u) * nx) xb_add(&bar[XB_TOPGEN], 1u);
            else XB_SPIN(xb_ld(&bar[XB_TOPGEN]) == tg, bar);
            __builtin_amdgcn_fence(__ATOMIC_ACQUIRE, "agent");
            xb_add(&bar[XB_XGEN(b.x)], 1u);
            asm volatile("s_waitcnt vmcnt(0)" ::: "memory");
        } else {
            XB_SPIN(xb_ld(&bar[XB_XGEN(b.x)]) == gen, bar);
            __builtin_amdgcn_fence(__ATOMIC_ACQUIRE, "agent");
            asm volatile("s_waitcnt vmcnt(0)" ::: "memory");
        }
    }
    __syncthreads();
}


__global__ void __launch_bounds__(NTHREADS, LBW) mega(Params p, int ph_lo, int ph_hi) {
  extern __shared__ __attribute__((aligned(16))) unsigned char smem[];
  volatile LAS unsigned* xst = (volatile LAS unsigned*)(smem + LDS_BYTES - 16);
  XcdBarrier xb;
  xb.bar = p.bar; xb.x = 0; xb.st = xst;
  if (ph_hi - ph_lo > 1) {
    if (threadIdx.x == 0) { xst[0] = 0u; xst[1] = 0u; }
    __syncthreads();
    xb = xcd_barrier_post(p.bar, xst);
  }
  for (int ph = ph_lo; ph < ph_hi; ++ph) {
    if (ph > ph_lo) {
      if (ph_hi > 1000) cg::this_grid().sync();
      xcd_barrier(xb);
    }
#ifndef TEST_PH
#define TEST_PH -1
#endif
    if (ph == 0) {
      if (PROBE_DUP == 4) { phase_setup(p, smem); cg::this_grid().sync(); }
      if (TEST_PH < 0 || TEST_PH == 0) phase_setup(p, smem);
    }
    else if (ph == NPHASES - 1) { if (TEST_PH < 0 || TEST_PH == 6) phase_final(p); }
    else {
      const int l = (ph - 1) / 7, s = (ph - 1) % 7;
      if (s == 0) { if (TEST_PH < 0 || TEST_PH == 1) phase_norm(p, l); }
      else if (s == 1) {
        if (PROBE_DUP == 3) { phase_inproj(p, l, smem); cg::this_grid().sync(); }
        if (TEST_PH < 0 || TEST_PH == 2) phase_inproj(p, l, smem);
      }
      else if (s == 2) {
        if (PROBE_DUP == 5) { phase_rwkvprep(p, l, smem); cg::this_grid().sync(); }
        if (TEST_PH < 0 || TEST_PH == 10) phase_rwkvprep(p, l, smem);
      }
      else if (s == 3) {
        if (PROBE_DUP == 1 || PROBE_DUP == 2) { phase_probe(p, l, smem); cg::this_grid().sync(); }
        if (TEST_PH < 0 || TEST_PH == 3 || (TEST_PH >= 7 && TEST_PH <= 9)) phase_mixers(p, l, smem);
      }
      else if (s == 4) { phase_rwkvfix(p); }
      else if (s == 5) { if (TEST_PH < 0 || TEST_PH == 4) phase_finish(p, l); }
      else { if (TEST_PH < 0 || TEST_PH == 5) phase_outproj(p, l, smem); }
    }
  }
}

extern "C" void kernel_launch(void* const* d_in, const int* in_sizes, int n_in, void* d_out, int out_size, void* d_ws,
                              size_t ws_size, hipStream_t stream) {
  static int grid_blocks = 0;
  if (!grid_blocks) {
    int dev = 0, cus = 0, per_cu = 0;
    hipGetDevice(&dev);
    hipDeviceGetAttribute(&cus, hipDeviceAttributeMultiprocessorCount, dev);
    hipFuncSetAttribute((const void*)mega, hipFuncAttributeMaxDynamicSharedMemorySize, LDS_BYTES);
    hipOccupancyMaxActiveBlocksPerMultiprocessor(&per_cu, (const void*)mega, NTHREADS, LDS_BYTES);
    if (per_cu < 1) per_cu = 1;
    if (per_cu > 2) per_cu = 2;
    grid_blocks = cus * per_cu;
  }
  Params p{};
  const float** fp = (const float**)&p;
  for (int i = 0; i < 27; ++i) fp[i] = (const float*)d_in[i];
  p.out = (float*)d_out;
  unsigned char* ws = (unsigned char*)d_ws;
  size_t off = 0;
  auto take = [&](size_t bytes) { unsigned char* r = ws + off; off += (bytes + 255) & ~(size_t)255; return r; };
  p.WtIn = (bf16_t*)take((size_t)2 * 3712 * 1024 * 2);
  p.WtOut = (bf16_t*)take((size_t)2 * 1024 * 1024 * 2);
  p.WupT = (bf16_t*)take((size_t)65536 * 2);
  p.AupT = (bf16_t*)take((size_t)65536 * 2);
  p.rope = (float*)take(1024 * 2 * 4);
  p.mod = (float*)take((size_t)2 * 5 * 3072 * 4);
  p.ctxcur = (float*)take((size_t)4 * 256 * 1024 * 4);
  p.PRE = (bf16_t*)take((size_t)3 * TOK * 512 * 2);
  p.hbuf = p.PRE;
  p.PA = (bf16_t*)take((size_t)TOK * 1024 * 2);
  p.PR = (bf16_t*)take((size_t)TOK * 1024 * 2);
  p.PG = (bf16_t*)take((size_t)TOK * 640 * 2);
  p.PS = (bf16_t*)take((size_t)TOK * 912 * 2);
  p.yR = (bf16_t*)take((size_t)2 * TOK * 256 * 2);
  p.HALO = (bf16_t*)take((size_t)512 * 2 * 896 * 2);
  p.DTC = (float2*)take((size_t)12 * TOK * 8);
  p.GID = (bf16_t*)take((size_t)8 * NSEG1 * 256 * 2);
  p.SMID = (float*)take((size_t)32 * 64 * 64 * 4);
  p.ctrs = (unsigned*)take(256);
  p.bar = (unsigned*)take((size_t)XCD_BAR_WORDS * 4);
  p.rstd = (float*)take((size_t)TOK * 4);
  p.yS = (bf16_t*)take((size_t)2 * TOK * 384 * 2);
  if (off > ws_size) { fprintf(stderr, "workspace too small: need %zu have %zu\n", off, ws_size); return; }
#if ONE_LAUNCH
  hipMemsetAsync(p.bar, 0, (size_t)XCD_BAR_WORDS * 4, stream);
  int lo = 0, hi = NPHASES;
  void* args[] = {&p, &lo, &hi};
  hipError_t e = hipLaunchCooperativeKernel((const void*)mega, dim3(grid_blocks), dim3(NTHREADS), args, LDS_BYTES, stream);
  if (e != hipSuccess) fprintf(stderr, "cooperative launch failed: %s (grid %d)\n", hipGetErrorString(e), grid_blocks);
#else
  for (int ph = 0; ph < NPHASES; ++ph)
    hipLaunchKernelGGL(mega, dim3(grid_blocks), dim3(NTHREADS), LDS_BYTES, stream, p, ph, ph + 1);
#endif
}
```

```cpp
#include <hip/hip_runtime.h>
#include <hip/hip_bf16.h>
#include <hip/hip_cooperative_groups.h>
#include <cstdio>
namespace cg = cooperative_groups;

#ifndef TEST_PH
#define TEST_PH -1
#endif
#ifndef ONE_LAUNCH
#define ONE_LAUNCH 1
#endif

typedef unsigned short bf16_t;
#define GLAS __attribute__((address_space(3)))
using bf16x8 = __attribute__((ext_vector_type(8))) short;
using f32x4 = __attribute__((ext_vector_type(4))) float;

#define TOK 17408
#define TPB 4352
#define NTHREADS 256
#define LDS_BYTES 76800
#define NPHASES 16
#define CSPLIT 78
#define NSEG1 ((136 - CSPLIT) * 32)
#ifndef LBW
#define LBW 2
#endif

struct Params {
  const float *x, *c, *ctx, *c_ctx, *ada_w, *ada_b, *norm_w, *w_in, *w_out, *attn_sink, *rwkv_mu, *rwkv_w0,
      *rwkv_w_up, *rwkv_a0, *rwkv_a_up, *rwkv_k_k, *rwkv_k_a, *rwkv_r_k, *rwkv_ln_w, *rwkv_ln_b, *ssm_conv_w,
      *ssm_conv_b, *ssm_a_log, *ssm_dt_bias, *ssm_d, *ssm_norm_w, *final_norm_w;
  float* out;
  bf16_t *WtIn, *WtOut, *WupT, *AupT;
  float *rope, *mod, *ctxcur;
  bf16_t *hbuf, *PA, *PR, *PG, *PS;
  bf16_t* yR;
  bf16_t* yS;
  bf16_t* PRE;
  bf16_t* HALO;
  float2* DTC;
  bf16_t* GID;
  float* SMID;
  unsigned* ctrs;
  unsigned* bar;
  float* rstd;
};

__device__ __forceinline__ float bf2f(bf16_t v) { return __uint_as_float(((unsigned)v) << 16); }
typedef __bf16 hbf2 __attribute__((ext_vector_type(2)));
typedef float hf2 __attribute__((ext_vector_type(2)));
__device__ __forceinline__ unsigned pack2(float a, float b) {
  hf2 v = {a, b};
  hbf2 r = __builtin_convertvector(v, hbf2);
  return *(unsigned*)&r;
}
__device__ __forceinline__ bf16_t f2bf(float f) { return (bf16_t)(pack2(f, 0.f) & 0xffffu); }
__device__ __forceinline__ float frcp(float x) { return __builtin_amdgcn_rcpf(x); }
__device__ __forceinline__ float sigmoidf_(float x) { return frcp(1.f + __expf(-x)); }
__device__ __forceinline__ float siluf_(float x) { return x * frcp(1.f + __expf(-x)); }
__device__ __forceinline__ float softplusf_(float x) {
  if (x > 15.f) return x;
  float e = __expf(x);
  return (e < 0.01f) ? e * (1.f - e * (0.5f - e * 0.33333333f)) : __logf(1.f + e);
}
__device__ __forceinline__ float tanhf_(float x) {
  float e = __expf(2.f * x);
  return 1.f - 2.f * frcp(e + 1.f);
}

template <int CTRL>
__device__ __forceinline__ float dppf(float x) {
  return __int_as_float(__builtin_amdgcn_update_dpp(0, __float_as_int(x), CTRL, 0xF, 0xF, true));
}
__device__ __forceinline__ float sum16(float x) {
  x += dppf<0xB1>(x);
  x += dppf<0x4E>(x);
  x += dppf<0x141>(x);
  x += dppf<0x140>(x);
  return x;
}
__device__ __forceinline__ float max16(float x) {
  x = fmaxf(x, dppf<0xB1>(x));
  x = fmaxf(x, dppf<0x4E>(x));
  x = fmaxf(x, dppf<0x141>(x));
  x = fmaxf(x, dppf<0x140>(x));
  return x;
}
__device__ __forceinline__ float sum64(float x) {
#pragma unroll
  for (int o = 32; o >= 1; o >>= 1) x += __shfl_xor(x, o);
  return x;
}
__device__ __forceinline__ float sum32(float x) {
#pragma unroll
  for (int o = 16; o >= 1; o >>= 1) x += __shfl_xor(x, o);
  return x;
}
__device__ __forceinline__ int launder(int x) { asm volatile("" : "+v"(x)); return x; }
#define MFMA(a, b, c) __builtin_amdgcn_mfma_f32_16x16x32_bf16(a, b, c, 0, 0, 0)

__device__ __forceinline__ void transpose_tile(const float* __restrict__ W, int N, int Kdim, bf16_t* __restrict__ Wt, int k0, int n0,
                               unsigned char* smem) {
  float* T = (float*)smem;
  const int tid = launder(threadIdx.x);
#pragma unroll 4
  for (int it = 0; it < 16; ++it) {
    int kk = (tid >> 6) + 4 * it, nn = tid & 63, n = n0 + nn;
    T[kk * 65 + nn] = (n < N) ? W[(size_t)(k0 + kk) * N + n] : 0.f;
  }
  __syncthreads();
#pragma unroll
  for (int it = 0; it < 2; ++it) {
    int nn = (tid >> 3) + 32 * it, kc = tid & 7;
    uint4 o;
    o.x = pack2(T[(kc * 8 + 0) * 65 + nn], T[(kc * 8 + 1) * 65 + nn]);
    o.y = pack2(T[(kc * 8 + 2) * 65 + nn], T[(kc * 8 + 3) * 65 + nn]);
    o.z = pack2(T[(kc * 8 + 4) * 65 + nn], T[(kc * 8 + 5) * 65 + nn]);
    o.w = pack2(T[(kc * 8 + 6) * 65 + nn], T[(kc * 8 + 7) * 65 + nn]);
    *(uint4*)(Wt + (size_t)(n0 + nn) * Kdim + k0 + kc * 8) = o;
  }
  __syncthreads();
}

__device__ void sincos_d(double x, float& c, float& s) {
  double n = rint(x * 0.63661977236758134308);
  double r = x - n * 1.57079632679489661923;
  double r2 = r * r;
  double sn = r * (1.0 + r2 * (-1.0 / 6 + r2 * (1.0 / 120 + r2 * (-1.0 / 5040 + r2 * (1.0 / 362880 + r2 * (-1.0 / 39916800 + r2 * (1.0 / 6227020800.0)))))));
  double cs = 1.0 + r2 * (-0.5 + r2 * (1.0 / 24 + r2 * (-1.0 / 720 + r2 * (1.0 / 40320 + r2 * (-1.0 / 3628800 + r2 * (1.0 / 479001600.0 + r2 * (-1.0 / 87178291200.0)))))));
  int q = ((int)n) & 3;
  double co, so;
  if (q == 0) { co = cs; so = sn; }
  else if (q == 1) { co = -sn; so = cs; }
  else if (q == 2) { co = -cs; so = -sn; }
  else { co = sn; so = -cs; }
  c = (float)co;
  s = (float)so;
}

__device__ __forceinline__ void deferred_transpose(const Params& p, int t, unsigned char* smem) {
  if (t < 928) {
    const int kt = t / 58, nt = t % 58;
    transpose_tile(p.w_in + (size_t)1024 * 3596, 3596, 1024, p.WtIn + (size_t)3712 * 1024, kt * 64, nt * 64, smem);
  } else {
    const int tt = t - 928, l = tt >> 8, r = tt & 255, kt = r >> 4, nt = r & 15;
    transpose_tile(p.w_out + (size_t)l * 1024 * 1024, 1024, 1024, p.WtOut + (size_t)l * 1024 * 1024, kt * 64, nt * 64, smem);
  }
}
__device__ __forceinline__ void phase_setup(const Params& p, unsigned char* smem) {
  const int T_WIN = 16 * 58, T_WOUT = 0, T_ADA = 2 * 96, T_MISC = 17;
  const int total = T_WIN + T_WOUT + T_ADA + T_MISC;
  const int tid = launder(threadIdx.x);
  if (blockIdx.x == 0 && tid < 8) p.ctrs[tid] = 0u;
  for (int t = blockIdx.x; t < total; t += gridDim.x) {
    if (t < T_WIN) {
      int kt = t / 58, nt = t % 58;
      transpose_tile(p.w_in, 3596, 1024, p.WtIn, kt * 64, nt * 64, smem);
    } else if (t < T_WIN + T_WOUT + T_ADA) {
      int tt = t - T_WIN - T_WOUT, l = tt / 96, n0 = (tt % 96) * 32;
      float* cact = (float*)smem;
      for (int i = tid; i < 5120; i += 256) {
        int j = i >> 10, k = i & 1023;
        float v = (j < 4) ? p.c[j * 1024 + k] : p.c_ctx[k];
        cact[i] = siluf_(v);
      }
      __syncthreads();
      int col = tid & 31, kg = tid >> 5;
      float a0 = 0, a1 = 0, a2 = 0, a3 = 0, a4 = 0;
      const float* wp = p.ada_w + ((size_t)l * 1024 + kg * 128) * 3072 + n0 + col;
#pragma unroll 8
      for (int k = 0; k < 128; ++k) {
        float w = wp[(size_t)k * 3072];
        int kk = kg * 128 + k;
        a0 += cact[kk] * w; a1 += cact[1024 + kk] * w; a2 += cact[2048 + kk] * w; a3 += cact[3072 + kk] * w; a4 += cact[4096 + kk] * w;
      }
      float* red = cact + 5120;
      red[(kg * 5 + 0) * 32 + col] = a0; red[(kg * 5 + 1) * 32 + col] = a1; red[(kg * 5 + 2) * 32 + col] = a2;
      red[(kg * 5 + 3) * 32 + col] = a3; red[(kg * 5 + 4) * 32 + col] = a4;
      __syncthreads();
      if (tid < 160) {
        int j = tid >> 5, cc = tid & 31;
        float s = 0;
#pragma unroll
        for (int g = 0; g < 8; ++g) s += red[(g * 5 + j) * 32 + cc];
        p.mod[(size_t)(l * 5 + j) * 3072 + n0 + cc] = s + p.ada_b[l * 3072 + n0 + cc];
      }
      __syncthreads();
    } else {
      int tt = t - T_WIN - T_WOUT - T_ADA;
      if (tt < 16) {
        for (int i = tid; i < 8192; i += 256) {
          int idx = tt * 8192 + i;
          int arr = idx >> 16, e = idx & 65535;
          int ld = e >> 14, rem = e & 16383, n = rem >> 6, k = rem & 63;
          const float* src = arr ? p.rwkv_a_up : p.rwkv_w_up;
          bf16_t* dst = arr ? p.AupT : p.WupT;
          dst[e] = f2bf(src[((size_t)ld * 64 + k) * 256 + n]);
        }
      } else {
        for (int i = tid; i < 1024; i += 256) {
          int pos = i >> 4, f = i & 15;
          float inv32 = exp2f(-(float)f * 0.83048202372184058f);
          float c, s;
          sincos_d((double)((float)pos * inv32), c, s);
          p.rope[i * 2] = c;
          p.rope[i * 2 + 1] = s;
        }
      }
    }
  }
}

__device__ __forceinline__ void phase_norm(const Params& p, int l) {
  const int tid = launder(threadIdx.x), lane = tid & 63, w = tid >> 6;
  for (int t = blockIdx.x; t < TOK / 4; t += gridDim.x) {
    int r = t * 4 + w, b = r / TPB, pp = r % TPB;
    const float* src;
    if (l == 0) src = (pp < 256) ? p.ctx + ((size_t)b * 256 + pp) * 1024 : p.x + ((size_t)b * 4096 + pp - 256) * 1024;
    else src = (pp < 256) ? p.ctxcur + ((size_t)b * 256 + pp) * 1024 : p.out + ((size_t)b * 4096 + pp - 256) * 1024;
    const float* md = p.mod + (size_t)(l * 5 + ((pp < 256) ? 4 : b)) * 3072;
    const float* nw = p.norm_w + l * 1024;
    float4 v[4];
    float ss = 0;
#pragma unroll
    for (int i = 0; i < 4; ++i) {
      v[i] = *(const float4*)(src + lane * 4 + 256 * i);
      ss += v[i].x * v[i].x + v[i].y * v[i].y + v[i].z * v[i].z + v[i].w * v[i].w;
    }
    ss = sum64(ss);
    float rstd = rsqrtf(ss * (1.f / 1024.f) + 1e-6f);
    if (lane == 0) p.rstd[r] = rstd;
#pragma unroll
    for (int i = 0; i < 4; ++i) {
      int k = lane * 4 + 256 * i;
      float4 n4 = *(const float4*)(nw + k), sc = *(const float4*)(md + 1024 + k), sh = *(const float4*)(md + k);
      float h0 = v[i].x * rstd * n4.x * (1.f + sc.x) + sh.x;
      float h1 = v[i].y * rstd * n4.y * (1.f + sc.y) + sh.y;
      float h2 = v[i].z * rstd * n4.z * (1.f + sc.z) + sh.z;
      float h3 = v[i].w * rstd * n4.w * (1.f + sc.w) + sh.w;
      uint2 o;
      o.x = pack2(h0, h1);
      o.y = pack2(h2, h3);
      *(uint2*)(p.hbuf + (size_t)r * 1024 + k) = o;
    }
  }
}

__device__ __forceinline__ void phase_final(const Params& p) {
  const int tid = launder(threadIdx.x), lane = tid & 63, w = tid >> 6;
  for (int t = blockIdx.x; t < 16384 / 4; t += gridDim.x) {
    int r = t * 4 + w;
    float* src = p.out + (size_t)r * 1024;
    float4 v[4];
    float ss = 0;
#pragma unroll
    for (int i = 0; i < 4; ++i) {
      v[i] = *(const float4*)(src + lane * 4 + 256 * i);
      ss += v[i].x * v[i].x + v[i].y * v[i].y + v[i].z * v[i].z + v[i].w * v[i].w;
    }
    ss = sum64(ss);
    float rstd = rsqrtf(ss * (1.f / 1024.f) + 1e-6f);
#pragma unroll
    for (int i = 0; i < 4; ++i) {
      int k = lane * 4 + 256 * i;
      float4 n4 = *(const float4*)(p.final_norm_w + k);
      float4 o;
      o.x = v[i].x * rstd * n4.x; o.y = v[i].y * rstd * n4.y; o.z = v[i].z * rstd * n4.z; o.w = v[i].w * rstd * n4.w;
      *(float4*)(src + k) = o;
    }
  }
}

template <int MODE>
__device__ __forceinline__ void gemm_tile(const Params& p, int l, int mt_, int nt_, unsigned char* smem) {
  const bf16_t* A = p.hbuf;
  const bf16_t* Bt = (MODE == 0) ? p.WtIn + (size_t)l * 3712 * 1024 : p.WtOut + (size_t)l * 1024 * 1024;
  const int m0 = mt_ * 128, n0 = nt_ * 128;
  bf16_t* As = (bf16_t*)smem;
  bf16_t* Bs = As + 2 * 128 * 72;
  const int tid = launder(threadIdx.x), lane = tid & 63, w = tid >> 6, wr = w >> 1, wc = w & 1, fr = lane & 15, fq = lane >> 4;
  f32x4 acc[4][4];
#pragma unroll
  for (int i = 0; i < 4; ++i)
#pragma unroll
    for (int j = 0; j < 4; ++j) acc[i][j] = (f32x4){0.f, 0.f, 0.f, 0.f};
  unsigned char* lds = smem;
  int sR[4], sC[4];
#pragma unroll
  for (int i = 0; i < 4; ++i) {
    const int bo = tid * 16 + i * 4096;
    const int st = bo >> 10, sb = bo & 1023, swz = sb ^ (((sb >> 9) & 1) << 5);
    sR[i] = (st >> 1) * 16 + (swz >> 6);
    sC[i] = (st & 1) * 32 + ((swz & 63) >> 1);
  }
  const bf16_t* Ag0 = A + (size_t)(m0 + sR[0]) * 1024 + sC[0];
  const bf16_t* Ag1 = A + (size_t)(m0 + sR[1]) * 1024 + sC[1];
  const bf16_t* Ag2 = A + (size_t)(m0 + sR[2]) * 1024 + sC[2];
  const bf16_t* Ag3 = A + (size_t)(m0 + sR[3]) * 1024 + sC[3];
  const bf16_t* Bg0 = Bt + (size_t)(n0 + sR[0]) * 1024 + sC[0];
  const bf16_t* Bg1 = Bt + (size_t)(n0 + sR[1]) * 1024 + sC[1];
  const bf16_t* Bg2 = Bt + (size_t)(n0 + sR[2]) * 1024 + sC[2];
  const bf16_t* Bg3 = Bt + (size_t)(n0 + sR[3]) * 1024 + sC[3];
#define GL_STAGE(q_, kt_)                                                                                                              \
  {                                                                                                                                    \
    unsigned char* base_ = lds + (q_) * 32768 + tid * 16;                                                                              \
    __builtin_amdgcn_global_load_lds((const unsigned*)(Ag0 + (kt_) * 64), (GLAS unsigned*)(base_), 16, 0, 0);                          \
    __builtin_amdgcn_global_load_lds((const unsigned*)(Ag1 + (kt_) * 64), (GLAS unsigned*)(base_ + 4096), 16, 0, 0);                   \
    __builtin_amdgcn_global_load_lds((const unsigned*)(Ag2 + (kt_) * 64), (GLAS unsigned*)(base_ + 8192), 16, 0, 0);                   \
    __builtin_amdgcn_global_load_lds((const unsigned*)(Ag3 + (kt_) * 64), (GLAS unsigned*)(base_ + 12288), 16, 0, 0);                  \
    __builtin_amdgcn_global_load_lds((const unsigned*)(Bg0 + (kt_) * 64), (GLAS unsigned*)(base_ + 16384), 16, 0, 0);                  \
    __builtin_amdgcn_global_load_lds((const unsigned*)(Bg1 + (kt_) * 64), (GLAS unsigned*)(base_ + 16384 + 4096), 16, 0, 0);           \
    __builtin_amdgcn_global_load_lds((const unsigned*)(Bg2 + (kt_) * 64), (GLAS unsigned*)(base_ + 16384 + 8192), 16, 0, 0);           \
    __builtin_amdgcn_global_load_lds((const unsigned*)(Bg3 + (kt_) * 64), (GLAS unsigned*)(base_ + 16384 + 12288), 16, 0, 0);          \
  }
  const int lo = (fr * 64 + fq * 16) ^ ((fr >> 3) << 5);
#define GL_COMPUTE(q_)                                                                                 \
  {                                                                                                    \
    const unsigned char* Ab = lds + (q_) * 32768 + (wr * 4) * 2048 + lo;                               \
    const unsigned char* Bb = lds + (q_) * 32768 + 16384 + (wc * 4) * 2048 + lo;                       \
    _Pragma("unroll") for (int ks = 0; ks < 2; ++ks) {                                                 \
      bf16x8 a[4], b[4];                                                                               \
      _Pragma("unroll") for (int i = 0; i < 4; ++i) {                                                  \
        a[i] = *(const bf16x8*)(Ab + i * 2048 + ks * 1024);                                            \
        b[i] = *(const bf16x8*)(Bb + i * 2048 + ks * 1024);                                            \
      }                                                                                                \
      _Pragma("unroll") for (int i = 0; i < 4; ++i)                                                    \
        _Pragma("unroll") for (int j = 0; j < 4; ++j) acc[i][j] = MFMA(a[i], b[j], acc[i][j]);         \
    }                                                                                                  \
  }
  GL_STAGE(0, 0);
  asm volatile("s_waitcnt vmcnt(0)" ::: "memory");
  __builtin_amdgcn_s_barrier();
  for (int kt = 0; kt < 16; ++kt) {
    const int q = kt & 1;
    if (kt + 1 < 16) GL_STAGE(q ^ 1, kt + 1);
    GL_COMPUTE(q);
    asm volatile("s_waitcnt vmcnt(0) lgkmcnt(0)" ::: "memory");
    __builtin_amdgcn_s_barrier();
  }
  const int cbase = n0 + wc * 64;
  if (MODE == 0) {
    bf16_t* dst;
    int ld, coff;
    if (cbase < 1024) { dst = p.PA; ld = 1024; coff = cbase; }
    else if (cbase < 2048) { dst = p.PR; ld = 1024; coff = cbase - 1024; }
    else if (cbase < 2688) { dst = p.PG; ld = 640; coff = cbase - 2048; }
    else { dst = p.PS; ld = 912; coff = cbase - 2688; }
    bf16_t* wbuf = (bf16_t*)smem + w * (64 * 72);
#pragma unroll
    for (int i = 0; i < 4; ++i) {
#pragma unroll
      for (int j = 0; j < 4; ++j) {
        const int r = m0 + wr * 64 + i * 16 + fq * 4 + j;
        const int pp = r % TPB;
        float v0 = acc[i][0][j], v1 = acc[i][1][j], v2 = acc[i][2][j], v3 = acc[i][3][j];
        if (cbase < 512 && pp >= 256) {
          const int tt = pp - 256, rp = tt >> 6, cp = tt & 63;
          const float2 cs0 = *(const float2*)(p.rope + (rp * 16 + fr) * 2);
          const float2 cs1 = *(const float2*)(p.rope + (cp * 16 + fr) * 2);
          float n0_ = v0 * cs0.x - v1 * cs0.y, n1_ = v0 * cs0.y + v1 * cs0.x;
          float n2_ = v2 * cs1.x - v3 * cs1.y, n3_ = v2 * cs1.y + v3 * cs1.x;
          v0 = n0_; v1 = n1_; v2 = n2_; v3 = n3_;
        }
        if (cbase < 384) { v0 *= 0.125f; v1 *= 0.125f; v2 *= 0.125f; v3 *= 0.125f; }
        bf16_t* o = wbuf + (i * 16 + fq * 4 + j) * 72 + fr;
        o[0] = f2bf(v0); o[16] = f2bf(v1); o[32] = f2bf(v2); o[48] = f2bf(v3);
      }
    }
    __builtin_amdgcn_wave_barrier();
    {
      const int ch = lane & 7;
      const bool chv = (cbase + ch * 8) < 3600;
      const bool halo = (cbase >= 2688) && (cbase + 64 <= 3584);
#pragma unroll
      for (int t = 0; t < 8; ++t) {
        const int rl = (lane >> 3) + 8 * t;
        const uint4 v = *(const uint4*)(wbuf + rl * 72 + ch * 8);
        const int r = m0 + wr * 64 + rl;
        if (chv) *(uint4*)(dst + (size_t)r * ld + coff + ch * 8) = v;
        if (halo) {
          const int pp = r % TPB, q34 = pp % 34, t34 = pp / 34, bb = r / TPB;
          if (q34 == 33 && t34 + 1 < 128) *(uint4*)(p.HALO + ((size_t)(bb * 128 + t34 + 1) * 2 + 0) * 896 + coff + ch * 8) = v;
          if (q34 == 0 && t34 >= 1) *(uint4*)(p.HALO + ((size_t)(bb * 128 + t34 - 1) * 2 + 1) * 896 + coff + ch * 8) = v;
        }
      }
    }
  } else {
    float* wbuf = (float*)smem + w * (64 * 68);
#pragma unroll
    for (int i = 0; i < 4; ++i)
#pragma unroll
      for (int j = 0; j < 4; ++j) {
        float* o = wbuf + (i * 16 + fq * 4 + j) * 68 + fr;
        o[0] = acc[i][0][j]; o[16] = acc[i][1][j]; o[32] = acc[i][2][j]; o[48] = acc[i][3][j];
      }
    __builtin_amdgcn_wave_barrier();
    {
      const int ch = lane & 15;
      const int b = m0 / TPB, pp0 = (m0 % TPB) + wr * 64;
      const bool isc = pp0 < 256;
      const float4 g4 = *(const float4*)(p.mod + (size_t)(l * 5 + (isc ? 4 : b)) * 3072 + 2048 + cbase + ch * 4);
      const float* resb;
      float* dstb;
      if (l == 0) {
        resb = isc ? p.ctx + ((size_t)b * 256 + pp0) * 1024 : p.x + ((size_t)b * 4096 + pp0 - 256) * 1024;
        dstb = isc ? p.ctxcur + ((size_t)b * 256 + pp0) * 1024 : p.out + ((size_t)b * 4096 + pp0 - 256) * 1024;
      } else {
        resb = p.out + ((size_t)b * 4096 + pp0 - 256) * 1024;
        dstb = p.out + ((size_t)b * 4096 + pp0 - 256) * 1024;
      }
#pragma unroll
      for (int t = 0; t < 16; ++t) {
        const int rl = (lane >> 4) + 4 * t;
        const float4 a4 = *(const float4*)(wbuf + rl * 68 + ch * 4);
        const float4 r4 = *(const float4*)(resb + (size_t)rl * 1024 + cbase + ch * 4);
        float4 o4;
        o4.x = r4.x + g4.x * a4.x; o4.y = r4.y + g4.y * a4.y; o4.z = r4.z + g4.z * a4.z; o4.w = r4.w + g4.w * a4.w;
        *(float4*)(dstb + (size_t)rl * 1024 + cbase + ch * 4) = o4;
      }
    }
  }
  __syncthreads();
}

#define G_COMPUTE(buf_)                                                                 \
  {                                                                                     \
    const bf16_t* Ac = As + (buf_) * 128 * 72 + (wr * 64 + fr) * 72 + fq * 8;           \
    const bf16_t* Bc = Bs + (buf_) * 128 * 72 + (wc * 64 + fr) * 72 + fq * 8;           \
    _Pragma("unroll") for (int ks = 0; ks < 2; ++ks) {                                  \
      bf16x8 a[4], b[4];                                                                \
      _Pragma("unroll") for (int i = 0; i < 4; ++i) {                                   \
        a[i] = *(const bf16x8*)(Ac + i * 16 * 72 + ks * 32);                            \
        b[i] = *(const bf16x8*)(Bc + i * 16 * 72 + ks * 32);                            \
      }                                                                                 \
      _Pragma("unroll") for (int i = 0; i < 4; ++i)                                     \
        _Pragma("unroll") for (int j = 0; j < 4; ++j) acc[i][j] = MFMA(a[i], b[j], acc[i][j]); \
    }                                                                                   \
  }
__device__ __forceinline__ void gemm_late_tile(const Params& p, int l, int mt_, int nt_, unsigned char* smem) {
  const bf16_t* Bt = p.WtIn + (size_t)l * 3712 * 1024;
  const int m0 = mt_ * 128, n0 = nt_ * 128;
  bf16_t* As = (bf16_t*)smem;
  bf16_t* Bs = As + 2 * 128 * 72;
  const int tid = launder(threadIdx.x), lane = tid & 63, w = tid >> 6, wr = w >> 1, wc = w & 1, fr = lane & 15, fq = lane >> 4;
  f32x4 acc[4][4];
#pragma unroll
  for (int i = 0; i < 4; ++i)
#pragma unroll
    for (int j = 0; j < 4; ++j) acc[i][j] = (f32x4){0.f, 0.f, 0.f, 0.f};
  const int lrow = tid >> 3, lkc = tid & 7;
  const int bb = m0 / TPB, pp0 = m0 % TPB;
  const bool isc0 = pp0 < 256;
  const float* xbase;
  if (l == 0) xbase = isc0 ? p.ctx + ((size_t)bb * 256 + pp0) * 1024 : p.x + ((size_t)bb * 4096 + pp0 - 256) * 1024;
  else xbase = isc0 ? p.ctxcur + ((size_t)bb * 256 + pp0) * 1024 : p.out + ((size_t)bb * 4096 + pp0 - 256) * 1024;
  const float* xr = xbase + (size_t)lrow * 1024 + lkc * 8;
  const float* md = p.mod + (size_t)(l * 5 + (isc0 ? 4 : bb)) * 3072 + lkc * 8;
  const float* nwp = p.norm_w + l * 1024 + lkc * 8;
  const float rs0 = p.rstd[m0 + lrow], rs1 = p.rstd[m0 + lrow + 32], rs2 = p.rstd[m0 + lrow + 64], rs3 = p.rstd[m0 + lrow + 96];
  const bf16_t* Bg = Bt + (size_t)(n0 + lrow) * 1024 + lkc * 8;
  float4 xa0, xb0, xa1, xb1, xa2, xb2, xa3, xb3, nwa, nwb, sca, scb, sha, shb;
  uint4 lb0, lb1, lb2, lb3;
#define L_LOAD(kt_)                                                                                   \
  {                                                                                                   \
    const int ko_ = (kt_) * 64;                                                                       \
    xa0 = *(const float4*)(xr + ko_); xb0 = *(const float4*)(xr + ko_ + 4);                            \
    xa1 = *(const float4*)(xr + 32 * 1024 + ko_); xb1 = *(const float4*)(xr + 32 * 1024 + ko_ + 4);    \
    xa2 = *(const float4*)(xr + 64 * 1024 + ko_); xb2 = *(const float4*)(xr + 64 * 1024 + ko_ + 4);    \
    xa3 = *(const float4*)(xr + 96 * 1024 + ko_); xb3 = *(const float4*)(xr + 96 * 1024 + ko_ + 4);    \
    lb0 = *(const uint4*)(Bg + ko_); lb1 = *(const uint4*)(Bg + (size_t)32 * 1024 + ko_);              \
    lb2 = *(const uint4*)(Bg + (size_t)64 * 1024 + ko_); lb3 = *(const uint4*)(Bg + (size_t)96 * 1024 + ko_); \
    nwa = *(const float4*)(nwp + ko_); nwb = *(const float4*)(nwp + ko_ + 4);                          \
    sca = *(const float4*)(md + 1024 + ko_); scb = *(const float4*)(md + 1024 + ko_ + 4);              \
    sha = *(const float4*)(md + ko_); shb = *(const float4*)(md + ko_ + 4);                            \
  }
#define L_ROW(xa_, xb_, rs_, i_, buf_)                                                                \
  {                                                                                                   \
    uint4 o_;                                                                                         \
    o_.x = pack2(xa_.x * rs_ * nwa.x * (1.f + sca.x) + sha.x, xa_.y * rs_ * nwa.y * (1.f + sca.y) + sha.y); \
    o_.y = pack2(xa_.z * rs_ * nwa.z * (1.f + sca.z) + sha.z, xa_.w * rs_ * nwa.w * (1.f + sca.w) + sha.w); \
    o_.z = pack2(xb_.x * rs_ * nwb.x * (1.f + scb.x) + shb.x, xb_.y * rs_ * nwb.y * (1.f + scb.y) + shb.y); \
    o_.w = pack2(xb_.z * rs_ * nwb.z * (1.f + scb.z) + shb.z, xb_.w * rs_ * nwb.w * (1.f + scb.w) + shb.w); \
    *(uint4*)(As + (buf_) * 128 * 72 + (lrow + 32 * (i_)) * 72 + lkc * 8) = o_;                       \
  }
#define L_STORE(buf_)                                                                                 \
  {                                                                                                   \
    L_ROW(xa0, xb0, rs0, 0, buf_) L_ROW(xa1, xb1, rs1, 1, buf_) L_ROW(xa2, xb2, rs2, 2, buf_) L_ROW(xa3, xb3, rs3, 3, buf_) \
    *(uint4*)(Bs + (buf_) * 128 * 72 + lrow * 72 + lkc * 8) = lb0;                                    \
    *(uint4*)(Bs + (buf_) * 128 * 72 + (lrow + 32) * 72 + lkc * 8) = lb1;                             \
    *(uint4*)(Bs + (buf_) * 128 * 72 + (lrow + 64) * 72 + lkc * 8) = lb2;                             \
    *(uint4*)(Bs + (buf_) * 128 * 72 + (lrow + 96) * 72 + lkc * 8) = lb3;                             \
  }
  L_LOAD(0);
  L_STORE(0);
  __syncthreads();
  for (int kt = 0; kt < 16; ++kt) {
    L_LOAD((kt + 1 < 16) ? kt + 1 : 15);
    G_COMPUTE(kt & 1);
    L_STORE((kt + 1) & 1);
    __syncthreads();
  }
  const int cbase = n0 + wc * 64;
    bf16_t* dst;
    int ld, coff;
    if (cbase < 1024) { dst = p.PA; ld = 1024; coff = cbase; }
    else if (cbase < 2048) { dst = p.PR; ld = 1024; coff = cbase - 1024; }
    else if (cbase < 2688) { dst = p.PG; ld = 640; coff = cbase - 2048; }
    else { dst = p.PS; ld = 912; coff = cbase - 2688; }
    bf16_t* wbuf = (bf16_t*)smem + w * (64 * 72);
#pragma unroll
    for (int i = 0; i < 4; ++i) {
#pragma unroll
      for (int j = 0; j < 4; ++j) {
        const int r = m0 + wr * 64 + i * 16 + fq * 4 + j;
        const int pp = r % TPB;
        float v0 = acc[i][0][j], v1 = acc[i][1][j], v2 = acc[i][2][j], v3 = acc[i][3][j];
        if (cbase < 512 && pp >= 256) {
          const int tt = pp - 256, rp = tt >> 6, cp = tt & 63;
          const float2 cs0 = *(const float2*)(p.rope + (rp * 16 + fr) * 2);
          const float2 cs1 = *(const float2*)(p.rope + (cp * 16 + fr) * 2);
          float n0_ = v0 * cs0.x - v1 * cs0.y, n1_ = v0 * cs0.y + v1 * cs0.x;
          float n2_ = v2 * cs1.x - v3 * cs1.y, n3_ = v2 * cs1.y + v3 * cs1.x;
          v0 = n0_; v1 = n1_; v2 = n2_; v3 = n3_;
        }
        if (cbase < 384) { v0 *= 0.125f; v1 *= 0.125f; v2 *= 0.125f; v3 *= 0.125f; }
        bf16_t* o = wbuf + (i * 16 + fq * 4 + j) * 72 + fr;
        o[0] = f2bf(v0); o[16] = f2bf(v1); o[32] = f2bf(v2); o[48] = f2bf(v3);
      }
    }
    __builtin_amdgcn_wave_barrier();
    {
      const int ch = lane & 7;
      const bool chv = (cbase + ch * 8) < 3600;
      const bool halo = (cbase >= 2688) && (cbase + 64 <= 3584);
#pragma unroll
      for (int t = 0; t < 8; ++t) {
        const int rl = (lane >> 3) + 8 * t;
        const uint4 v = *(const uint4*)(wbuf + rl * 72 + ch * 8);
        const int r = m0 + wr * 64 + rl;
        if (chv) *(uint4*)(dst + (size_t)r * ld + coff + ch * 8) = v;
        if (halo) {
          const int pp = r % TPB, q34 = pp % 34, t34 = pp / 34, bb = r / TPB;
          if (q34 == 33 && t34 + 1 < 128) *(uint4*)(p.HALO + ((size_t)(bb * 128 + t34 + 1) * 2 + 0) * 896 + coff + ch * 8) = v;
          if (q34 == 0 && t34 >= 1) *(uint4*)(p.HALO + ((size_t)(bb * 128 + t34 - 1) * 2 + 1) * 896 + coff + ch * 8) = v;
        }
      }
    }
  __syncthreads();
}

__device__ __forceinline__ void phase_inproj(const Params& p, int l, unsigned char* smem) {
  if ((gridDim.x & 7) == 0) {
    const int x = blockIdx.x & 7, slot = blockIdx.x >> 3, nslot = gridDim.x >> 3;
    for (int j = slot; j < 17 * 24; j += nslot) { const int ne = j % 24; gemm_tile<0>(p, l, (j / 24) * 8 + x, (ne < 16) ? ne : ne + 5, smem); }
  } else {
    for (int t = blockIdx.x; t < 136 * 24; t += gridDim.x) { const int ne = t % 24; gemm_tile<0>(p, l, t / 24, (ne < 16) ? ne : ne + 5, smem); }
  }
}
__device__ __forceinline__ void phase_outproj(const Params& p, int l, unsigned char* smem) {
  if ((gridDim.x & 7) == 0) {
    const int x = blockIdx.x & 7, slot = blockIdx.x >> 3, nslot = gridDim.x >> 3;
    for (int j = slot; j < 17 * 8; j += nslot) {
      const int mt = (j >> 3) * 8 + x, nt = j & 7;
      if (l == 1 && (mt % 34) < 2) continue;
      gemm_tile<1>(p, l, mt, nt, smem);
    }
  } else {
    for (int t = blockIdx.x; t < 136 * 8; t += gridDim.x) {
      int mt = t >> 3, nt = t & 7;
      if (l == 1 && (mt % 34) < 2) continue;
      gemm_tile<1>(p, l, mt, nt, smem);
    }
  }
}

#define PRE_ARR ((size_t)TOK * 512)
__device__ __forceinline__ void rwkv_prep_tile(const Params& p, int l, int tile, unsigned char* smem) {
  const int d = tile & 1, tb = (tile >> 1) % 136, b = tile / 272;
  bf16_t* raw = (bf16_t*)smem;
  bf16_t* Aw = raw + 34 * 384;
  bf16_t* Aa = Aw + 32 * 72;
  const int tid = launder(threadIdx.x), lane = tid & 63, w = tid >> 6, fr = lane & 15, fq = lane >> 4;
  const int p0 = tb * 32;
  const int slo = (p0 < 256) ? 0 : 256, shi = (p0 < 256) ? 255 : 4351;
  const size_t rowbase = (size_t)b * TPB;
  const int ld2 = l * 2 + d;
  for (int q = tid; q < 34 * 48; q += 256) {
    const int rr = q / 48, cc = q % 48;
    const int tr = p0 - 1 + rr;
    const int col = (cc < 32) ? (256 + cc * 8) : ((cc < 40) ? (768 + d * 64 + (cc - 32) * 8) : (896 + d * 64 + (cc - 40) * 8));
    uint4 v = make_uint4(0, 0, 0, 0);
    if (tr >= slo && tr <= shi) v = *(const uint4*)(p.PR + (rowbase + tr) * 1024 + col);
    *(uint4*)(raw + rr * 384 + cc * 8) = v;
  }
  __syncthreads();
  const float* mu0 = p.rwkv_mu + (size_t)(l * 2 + 0) * 1024;
  const float* mu1 = p.rwkv_mu + (size_t)(l * 2 + 1) * 1024;
  {
    const int ca = tid & 63;
    const float m0wd = mu0[768 + d * 64 + ca], m1wd = mu1[768 + d * 64 + ca];
    const float m0ad = mu0[896 + d * 64 + ca], m1ad = mu1[896 + d * 64 + ca];
#pragma unroll 2
    for (int it = 0; it < 8; ++it) {
      const int i = w + 4 * it;
      const bf16_t* r0 = raw + (i + 1) * 384 + ca;
      float u = bf2f(r0[256]), up = bf2f(r0[256 - 384]), un = bf2f(r0[256 + 384]);
      Aw[i * 72 + ca] = f2bf(tanhf_(u + m0wd * (up - u) + m1wd * (un - u)));
      u = bf2f(r0[320]); up = bf2f(r0[320 - 384]); un = bf2f(r0[320 + 384]);
      Aa[i * 72 + ca] = f2bf(u + m0ad * (up - u) + m1ad * (un - u));
    }
  }
  __syncthreads();
  bf16x8 aw[2][2], aa[2][2];
#pragma unroll
  for (int mt = 0; mt < 2; ++mt)
#pragma unroll
    for (int ks = 0; ks < 2; ++ks) {
      aw[mt][ks] = *(const bf16x8*)(Aw + (mt * 16 + fr) * 72 + ks * 32 + fq * 8);
      aa[mt][ks] = *(const bf16x8*)(Aa + (mt * 16 + fr) * 72 + ks * 32 + fq * 8);
    }
  float kkr[2][4][4];
  float ssq[2][4];
#pragma unroll
  for (int mt = 0; mt < 2; ++mt)
#pragma unroll
    for (int j = 0; j < 4; ++j) ssq[mt][j] = 0.f;
#pragma unroll
  for (int nt = 0; nt < 4; ++nt) {
    const int c = w * 64 + nt * 16 + fr;
    const float m0k = mu0[256 + c], m1k = mu1[256 + c], kkc = p.rwkv_k_k[ld2 * 256 + c];
#pragma unroll
    for (int mt = 0; mt < 2; ++mt)
#pragma unroll
      for (int j = 0; j < 4; ++j) {
        const int i = mt * 16 + fq * 4 + j;
        const bf16_t* r0 = raw + (i + 1) * 384 + c;
        const float u = bf2f(r0[0]), up = bf2f(r0[-384]), un = bf2f(r0[384]);
        const float kq = (u + m0k * (up - u) + m1k * (un - u)) * kkc;
        kkr[mt][nt][j] = kq;
        ssq[mt][j] += kq * kq;
      }
  }
  float inv[2][4];
#pragma unroll
  for (int mt = 0; mt < 2; ++mt)
#pragma unroll
    for (int j = 0; j < 4; ++j) {
      const float tot = sum16(ssq[mt][j]);
      inv[mt][j] = frcp(fmaxf(__builtin_amdgcn_sqrtf(tot), 1e-12f));
    }
#pragma unroll
  for (int nt = 0; nt < 4; ++nt) {
    const int c = w * 64 + nt * 16 + fr;
    const bf16_t* wup = p.WupT + ((size_t)(ld2 * 256 + c)) * 64 + fq * 8;
    const bf16_t* aup = p.AupT + ((size_t)(ld2 * 256 + c)) * 64 + fq * 8;
    const bf16x8 bw0 = *(const bf16x8*)wup, bw1 = *(const bf16x8*)(wup + 32);
    const bf16x8 ba0 = *(const bf16x8*)aup, ba1 = *(const bf16x8*)(aup + 32);
    const float w0c = p.rwkv_w0[ld2 * 256 + c], a0c = p.rwkv_a0[ld2 * 256 + c];
#pragma unroll
    for (int mt = 0; mt < 2; ++mt) {
      f32x4 accw = (f32x4){0.f, 0.f, 0.f, 0.f}, acca = (f32x4){0.f, 0.f, 0.f, 0.f};
      accw = MFMA(aw[mt][0], bw0, accw);
      accw = MFMA(aw[mt][1], bw1, accw);
      acca = MFMA(aa[mt][0], ba0, acca);
      acca = MFMA(aa[mt][1], ba1, acca);
#pragma unroll
      for (int j = 0; j < 4; ++j) {
        const int i = mt * 16 + fq * 4 + j;
        const float ew = 0.6065306597f * sigmoidf_(w0c + accw[j]);
        const float a = sigmoidf_(a0c + acca[j]);
        const float kk = kkr[mt][nt][j] * inv[mt][j];
        const size_t o = ((rowbase + p0 + i) * 2 + d) * 256 + c;
        p.PRE[o] = f2bf(ew);
        p.PRE[PRE_ARR + o] = f2bf(a);
        p.PRE[2 * PRE_ARR + o] = f2bf(kk);
      }
    }
  }
  __syncthreads();
}
__device__ __forceinline__ void ssd_conv_tile(const Params& p, int l, int tile, unsigned char* smem);
__device__ __forceinline__ void ssd_dtcum_tile(const Params& p, int l, int tile, unsigned char* smem);
__device__ __forceinline__ void phase_rwkvprep(const Params& p, int l, unsigned char* smem) {
  for (int t = blockIdx.x; t < 1088 + 512 + 544; t += gridDim.x) {
    if (t < 1088) rwkv_prep_tile(p, l, t, smem);
    else if (t < 1600) ssd_conv_tile(p, l, t - 1088, smem);
    else ssd_dtcum_tile(p, l, t - 1600, smem);
  }
}

typedef float v2f __attribute__((ext_vector_type(2)));
template <bool DUAL>
__device__ __forceinline__ void rwkv_tile(const Params& p, int l, int tile, unsigned char* smem) {
  const int part = tile >> 7;
  const int rg = tile & 3, h = (tile >> 2) & 3, b = (tile >> 4) & 3, d = (tile >> 6) & 1;
  const int cbeg = (part == 0) ? 0 : CSPLIT, cend = (part == 0) ? CSPLIT : 136;
  bf16_t* raw = (bf16_t*)smem;
  bf16_t* pre = raw + 34 * 192;
  float* rec = (float*)(smem + 13056 + 12288);
  const int tid = launder(threadIdx.x), lane = tid & 63, w = tid >> 6, fr = lane & 15, fq = lane >> 4;
  const int row = rg * 16 + w * 4 + fq;
  const int c0 = fr * 4;
  const int ld2 = l * 2 + d;
  const size_t rowbase = (size_t)b * TPB;
  const int lc = (tid & 15) * 4;
  const float* mu0 = p.rwkv_mu + (size_t)(l * 2 + 0) * 1024 + h * 64 + lc;
  const float* mu1 = p.rwkv_mu + (size_t)(l * 2 + 1) * 1024 + h * 64 + lc;
  const float4 m0r = *(const float4*)mu0, m1r = *(const float4*)mu1;
  const float4 m0k = *(const float4*)(mu0 + 256), m1k = *(const float4*)(mu1 + 256);
  const float4 m0v = *(const float4*)(mu0 + 512), m1v = *(const float4*)(mu1 + 512);
  const float4 ka4 = *(const float4*)(p.rwkv_k_a + ld2 * 256 + h * 64 + lc);
  v2f sA = {0.f, 0.f}, sB = {0.f, 0.f};
  v2f iA = {(row == c0) ? 1.f : 0.f, (row == c0 + 1) ? 1.f : 0.f}, iB = {(row == c0 + 2) ? 1.f : 0.f, (row == c0 + 3) ? 1.f : 0.f};
  const int pcc = tid % 24, prow = tid / 24;
  const bool pact = tid < 240;
  const bf16_t* rbase_g = p.PR + rowbase * 1024 + (pcc >> 3) * 256 + h * 64 + (pcc & 7) * 8;
  const bf16_t* pbase_g = p.PRE + (size_t)(pcc >> 3) * PRE_ARR + (rowbase * 2 + d) * 256 + h * 64 + (pcc & 7) * 8;
  uint4 pf0, pf1, pf2, pf3, pg0, pg1, pg2, pg3;
#define RW_GEOM(cix_, plo_, slo_, shi_)                                                   \
  {                                                                                       \
    const int st0_ = (cix_) * 32;                                                         \
    if (st0_ < 256) { slo_ = 0; shi_ = 255; plo_ = (d == 0) ? st0_ : 224 - st0_; }         \
    else { slo_ = 256; shi_ = 4351; plo_ = (d == 0) ? st0_ : 4576 - st0_; }                \
  }
#define RW_PF1(dst_, rr_, plo_, slo_, shi_)                                                         \
  {                                                                                                 \
    const int tr_ = (plo_) - 1 + (rr_);                                                             \
    dst_ = make_uint4(0, 0, 0, 0);                                                                  \
    if (pact && (rr_) < 34 && tr_ >= (slo_) && tr_ <= (shi_)) dst_ = *(const uint4*)(rbase_g + (size_t)tr_ * 1024); \
  }
#define RW_PG1(dst_, rr_, plo_)                                                                     \
  {                                                                                                 \
    dst_ = make_uint4(0, 0, 0, 0);                                                                  \
    if (pact && (rr_) < 32) dst_ = *(const uint4*)(pbase_g + (size_t)((plo_) + (rr_)) * 512);       \
  }
#define RW_PREFETCH(cix_)                                                                 \
  {                                                                                       \
    int plo_, slo_, shi_;                                                                 \
    RW_GEOM(cix_, plo_, slo_, shi_);                                                      \
    RW_PF1(pf0, prow, plo_, slo_, shi_); RW_PF1(pf1, prow + 10, plo_, slo_, shi_);        \
    RW_PF1(pf2, prow + 20, plo_, slo_, shi_); RW_PF1(pf3, prow + 30, plo_, slo_, shi_);   \
    RW_PG1(pg0, prow, plo_); RW_PG1(pg1, prow + 10, plo_);                                \
    RW_PG1(pg2, prow + 20, plo_); RW_PG1(pg3, prow + 30, plo_);                           \
  }
#define RW_STASH()                                                                        \
  {                                                                                       \
    if (pact) {                                                                           \
      *(uint4*)(raw + prow * 192 + pcc * 8) = pf0;                                        \
      *(uint4*)(raw + (prow + 10) * 192 + pcc * 8) = pf1;                                 \
      *(uint4*)(raw + (prow + 20) * 192 + pcc * 8) = pf2;                                 \
      if (prow + 30 < 34) *(uint4*)(raw + (prow + 30) * 192 + pcc * 8) = pf3;             \
      *(uint4*)(pre + prow * 192 + pcc * 8) = pg0;                                        \
      *(uint4*)(pre + (prow + 10) * 192 + pcc * 8) = pg1;                                 \
      *(uint4*)(pre + (prow + 20) * 192 + pcc * 8) = pg2;                                 \
      if (prow + 30 < 32) *(uint4*)(pre + (prow + 30) * 192 + pcc * 8) = pg3;             \
    }                                                                                     \
  }
  RW_PREFETCH(cbeg);
  RW_STASH();
  __syncthreads();
  for (int cix = cbeg; cix < cend; ++cix) {
    int plo, slo, shi;
    RW_GEOM(cix, plo, slo, shi);
#pragma unroll
    for (int k = 0; k < 2; ++k) {
      const int i = (tid >> 4) + 16 * k;
      const int ri = (d == 0) ? i + 1 : 32 - i;
      const bf16_t* r0 = raw + ri * 192 + lc;
      const bf16_t* q0 = pre + (ri - 1) * 192 + lc;
      float rs[4], ksv[4], vs[4];
#pragma unroll
      for (int sl = 0; sl < 3; ++sl) {
        const uint2 uc = *(const uint2*)(r0 + sl * 64), up = *(const uint2*)(r0 + sl * 64 - 192), un = *(const uint2*)(r0 + sl * 64 + 192);
        const float4 m0 = (sl == 0) ? m0r : ((sl == 1) ? m0k : m0v);
        const float4 m1 = (sl == 0) ? m1r : ((sl == 1) ? m1k : m1v);
        float* dst = (sl == 0) ? rs : ((sl == 1) ? ksv : vs);
        float u, a, n;
        u = __uint_as_float(uc.x << 16); a = __uint_as_float(up.x << 16); n = __uint_as_float(un.x << 16);
        dst[0] = u + m0.x * (a - u) + m1.x * (n - u);
        u = __uint_as_float(uc.x & 0xffff0000u); a = __uint_as_float(up.x & 0xffff0000u); n = __uint_as_float(un.x & 0xffff0000u);
        dst[1] = u + m0.y * (a - u) + m1.y * (n - u);
        u = __uint_as_float(uc.y << 16); a = __uint_as_float(up.y << 16); n = __uint_as_float(un.y << 16);
        dst[2] = u + m0.z * (a - u) + m1.z * (n - u);
        u = __uint_as_float(uc.y & 0xffff0000u); a = __uint_as_float(up.y & 0xffff0000u); n = __uint_as_float(un.y & 0xffff0000u);
        dst[3] = u + m0.w * (a - u) + m1.w * (n - u);
      }
      const uint2 ue = *(const uint2*)(q0), ua = *(const uint2*)(q0 + 64), uk = *(const uint2*)(q0 + 128);
      const float ew[4] = {__uint_as_float(ue.x << 16), __uint_as_float(ue.x & 0xffff0000u), __uint_as_float(ue.y << 16), __uint_as_float(ue.y & 0xffff0000u)};
      const float av[4] = {__uint_as_float(ua.x << 16), __uint_as_float(ua.x & 0xffff0000u), __uint_as_float(ua.y << 16), __uint_as_float(ua.y & 0xffff0000u)};
      const float kk[4] = {__uint_as_float(uk.x << 16), __uint_as_float(uk.x & 0xffff0000u), __uint_as_float(uk.y << 16), __uint_as_float(uk.y & 0xffff0000u)};
      const float kav[4] = {ka4.x, ka4.y, ka4.z, ka4.w};
      float4 o0, o1, o2, o3, o4, o5;
      float* f0 = (float*)&o0; float* f1 = (float*)&o1; float* f2 = (float*)&o2; float* f3 = (float*)&o3; float* f4 = (float*)&o4; float* f5 = (float*)&o5;
#pragma unroll
      for (int e = 0; e < 4; ++e) {
        f0[e] = __expf(-ew[e]);
        f1[e] = kk[e];
        f2[e] = kk[e] * av[e];
        f3[e] = ksv[e] * (1.f + (av[e] - 1.f) * kav[e]);
        f4[e] = rs[e];
        f5[e] = vs[e];
      }
      float* rp = rec + i * 384 + lc;
      *(float4*)(rp) = o0; *(float4*)(rp + 64) = o1; *(float4*)(rp + 128) = o2;
      *(float4*)(rp + 192) = o3; *(float4*)(rp + 256) = o4; *(float4*)(rp + 320) = o5;
    }
    __syncthreads();
    if (cix + 1 < cend) RW_PREFETCH(cix + 1);
    {
      const float* rp = rec + c0;
      const float* vp = rec + 320 + row;
      float4 w4 = *(const float4*)(rp), kk4 = *(const float4*)(rp + 64), kb4 = *(const float4*)(rp + 128);
      float4 kd4 = *(const float4*)(rp + 192), r4 = *(const float4*)(rp + 256);
      float v = vp[0];
      float ykeep = 0.f, gkeep = 0.f;
#pragma unroll 2
      for (int i = 0; i < 32; ++i) {
        const int inx = (i + 1) & 31;
        const float4 nw4 = *(const float4*)(rp + inx * 384), nkk4 = *(const float4*)(rp + inx * 384 + 64), nkb4 = *(const float4*)(rp + inx * 384 + 128);
        const float4 nkd4 = *(const float4*)(rp + inx * 384 + 192), nr4 = *(const float4*)(rp + inx * 384 + 256);
        const float nv = vp[inx * 384];
        v2f t = sA * (v2f){kk4.x, kk4.y};
        t = sB * (v2f){kk4.z, kk4.w} + t;
        float sa = t.x + t.y, ia = 0.f;
        if (DUAL) {
          v2f ti = iA * (v2f){kk4.x, kk4.y};
          ti = iB * (v2f){kk4.z, kk4.w} + ti;
          ia = ti.x + ti.y;
          sa += dppf<0xB1>(sa); ia += dppf<0xB1>(ia);
          sa += dppf<0x4E>(sa); ia += dppf<0x4E>(ia);
          sa += dppf<0x141>(sa); ia += dppf<0x141>(ia);
          sa += dppf<0x140>(sa); ia += dppf<0x140>(ia);
        } else {
          sa = sum16(sa);
        }
        v2f cA = sA * (v2f){w4.x, w4.y} + (v2f){kd4.x, kd4.y} * v;
        v2f cB = sB * (v2f){w4.z, w4.w} + (v2f){kd4.z, kd4.w} * v;
        sA = cA - (v2f){kb4.x, kb4.y} * sa;
        sB = cB - (v2f){kb4.z, kb4.w} * sa;
        v2f u = sA * (v2f){r4.x, r4.y};
        u = sB * (v2f){r4.z, r4.w} + u;
        float y = u.x + u.y, g = 0.f;
        if (DUAL) {
          iA = iA * (v2f){w4.x, w4.y} - (v2f){kb4.x, kb4.y} * ia;
          iB = iB * (v2f){w4.z, w4.w} - (v2f){kb4.z, kb4.w} * ia;
          v2f ui = iA * (v2f){r4.x, r4.y};
          ui = iB * (v2f){r4.z, r4.w} + ui;
          g = ui.x + ui.y;
          y += dppf<0xB1>(y); g += dppf<0xB1>(g);
          y += dppf<0x4E>(y); g += dppf<0x4E>(g);
          y += dppf<0x141>(y); g += dppf<0x141>(g);
          y += dppf<0x140>(y); g += dppf<0x140>(g);
          if (fr == (i & 15)) gkeep = g;
        } else {
          y = sum16(y);
        }
        if (fr == (i & 15)) ykeep = y;
        if ((i & 15) == 15) {
          const int ii = (i & 16) + fr;
          const int ri = (d == 0) ? ii + 1 : 32 - ii;
          const int pi = plo - 1 + ri;
          p.yR[((size_t)d * TOK + rowbase + pi) * 256 + h * 64 + row] = f2bf(ykeep);
          if (DUAL) p.GID[((size_t)(d * 4 + b) * NSEG1 + (cix - CSPLIT) * 32 + ii) * 256 + h * 64 + row] = f2bf(gkeep);
        }
        w4 = nw4; kk4 = nkk4; kb4 = nkb4; kd4 = nkd4; r4 = nr4; v = nv;
      }
    }
    if (cix + 1 < cend) RW_STASH();
    __syncthreads();
  }
  if (part == 0) *(float4*)(p.SMID + ((size_t)(((d * 4 + b) * 4 + h) * 64 + row)) * 64 + c0) = make_float4(sA.x, sA.y, sB.x, sB.y);
}

__device__ __forceinline__ void rwkv_fix_tile(const Params& p, int tile) {
  const int mb = tile % (NSEG1 / 64), dbh = tile / (NSEG1 / 64), h = dbh & 3, b = (dbh >> 2) & 3, d = dbh >> 4;
  const int tid = launder(threadIdx.x), lane = tid & 63, w = tid >> 6, fr = lane & 15, fq = lane >> 4;
  const size_t rowbase = (size_t)b * TPB;
  const int s0 = mb * 64 + 16 * w;
  const bf16_t* gp = p.GID + ((size_t)(d * 4 + b) * NSEG1 + s0 + fr) * 256 + h * 64 + fq * 8;
  const bf16x8 a0 = *(const bf16x8*)gp, a1 = *(const bf16x8*)(gp + 32);
#pragma unroll
  for (int nt = 0; nt < 4; ++nt) {
    const float* sp = p.SMID + ((size_t)(dbh * 64 + nt * 16 + fr)) * 64 + fq * 8;
    const float4 f0 = *(const float4*)sp, f1 = *(const float4*)(sp + 4), f2 = *(const float4*)(sp + 32), f3 = *(const float4*)(sp + 36);
    union { unsigned u[4]; bf16x8 v; } b0, b1;
    b0.u[0] = pack2(f0.x, f0.y); b0.u[1] = pack2(f0.z, f0.w); b0.u[2] = pack2(f1.x, f1.y); b0.u[3] = pack2(f1.z, f1.w);
    b1.u[0] = pack2(f2.x, f2.y); b1.u[1] = pack2(f2.z, f2.w); b1.u[2] = pack2(f3.x, f3.y); b1.u[3] = pack2(f3.z, f3.w);
    f32x4 acc = (f32x4){0.f, 0.f, 0.f, 0.f};
    acc = MFMA(a0, b0.v, acc);
    acc = MFMA(a1, b1.v, acc);
#pragma unroll
    for (int j = 0; j < 4; ++j) {
      const int st = CSPLIT * 32 + s0 + fq * 4 + j;
      const int pp = (d == 0) ? st : ((st < 256) ? 255 - st : 4607 - st);
      bf16_t* yp = p.yR + ((size_t)d * TOK + rowbase + pp) * 256 + h * 64 + nt * 16 + fr;
      *yp = f2bf(bf2f(*yp) + acc[j]);
    }
  }
}
__device__ __forceinline__ void phase_rwkvfix(const Params& p) {
  for (int t = blockIdx.x; t < 32 * (NSEG1 / 64); t += gridDim.x) rwkv_fix_tile(p, t);
}

__device__ __forceinline__ void ssd_conv_tile(const Params& p, int l, int tile, unsigned char* smem) {
  const int b = tile >> 7, t34 = tile & 127, pp0 = t34 * 34;
  const size_t r0 = (size_t)b * TPB + pp0;
  bf16_t* T = (bf16_t*)smem;
  const int tid = launder(threadIdx.x);
  for (int q = tid; q < 34 * 112; q += 256) {
    const int rr = q / 112, cc = q % 112;
    *(uint4*)(T + (rr + 1) * 896 + cc * 8) = *(const uint4*)(p.PS + (r0 + rr) * 912 + cc * 8);
  }
  if (tid < 224) {
    const int which = tid / 112, cc = tid % 112;
    const bool ex = (which == 0) ? (t34 >= 1) : (t34 + 1 < 128);
    uint4 v = make_uint4(0, 0, 0, 0);
    if (ex) v = *(const uint4*)(p.HALO + ((size_t)(b * 128 + t34) * 2 + which) * 896 + cc * 8);
    *(uint4*)(T + (which ? 35 : 0) * 896 + cc * 8) = v;
  }
  __syncthreads();
  const float* cw = p.ssm_conv_w + (size_t)l * 3 * 896;
  const float* cb = p.ssm_conv_b + (size_t)l * 896;
  for (int c = tid; c < 896; c += 256) {
    const float w0 = cw[c], w1 = cw[896 + c], w2 = cw[1792 + c], bs = cb[c];
    float um = bf2f(T[c]), u0 = bf2f(T[896 + c]);
#pragma unroll 2
    for (int rr = 0; rr < 34; ++rr) {
      const float up = bf2f(T[(rr + 2) * 896 + c]);
      const int pp = pp0 + rr;
      const bool pv = (pp != 0) && (pp != 256), nv = (pp != 255) && (pp != 4351);
      const float v = w0 * (pv ? um : 0.f) + w1 * u0 + w2 * (nv ? up : 0.f) + bs;
      p.PS[(r0 + rr) * 912 + c] = f2bf(siluf_(v));
      um = u0; u0 = up;
    }
  }
  __syncthreads();
}
__device__ __forceinline__ void ssd_dtcum_tile(const Params& p, int l, int tile, unsigned char* smem) {
  const int b = tile / 136, c32 = tile % 136, p0 = c32 * 32;
  float* draw = (float*)smem;
  const int tid = launder(threadIdx.x);
  for (int q = tid; q < 384; q += 256) {
    const int i = q / 12, dh = q % 12;
    draw[q] = bf2f(p.PS[((size_t)b * TPB + p0 + i) * 912 + 896 + dh]);
  }
  __syncthreads();
  if (tid < 12) {
    const int dh = tid, d = dh / 6, h = dh % 6;
    const float a_neg = -__expf(p.ssm_a_log[(l * 2 + d) * 6 + h]);
    const float bias = p.ssm_dt_bias[(l * 2 + d) * 6 + h];
    float cum = 0.f;
    for (int k = 0; k < 32; ++k) {
      const int it = (d == 0) ? k : 31 - k;
      const float dt = softplusf_(draw[it * 12 + dh] + bias);
      cum += dt * a_neg;
      p.DTC[(size_t)dh * TOK + (size_t)b * TPB + p0 + it] = make_float2(dt, cum);
    }
  }
  __syncthreads();
}

__device__ __forceinline__ void ssd_tile(const Params& p, int l, int tile, unsigned char* smem) {
  const int h = tile % 6, b = (tile / 6) & 3, d = tile / 24, g = h / 3;
  bf16_t* Cs0 = (bf16_t*)smem;
  bf16_t* Bs = Cs0 + 2 * 32 * 136;
  bf16_t* Xs = Bs + 32 * 136;
  bf16_t* BtT = Xs + 32 * 72;
  bf16_t* XdT = BtT + 128 * 40;
  bf16_t* Ms = XdT + 64 * 40;
  bf16_t* Sb = Ms + 32 * 40;
  float* dc = (float*)(Sb + 64 * 136);
  const int tid = launder(threadIdx.x), lane = tid & 63, w = tid >> 6, fr = lane & 15, fq = lane >> 4;
  const size_t rowbase = (size_t)b * TPB;
  f32x4 S[4][2];
#pragma unroll
  for (int i = 0; i < 4; ++i)
#pragma unroll
    for (int j = 0; j < 2; ++j) S[i][j] = (f32x4){0.f, 0.f, 0.f, 0.f};
  const int pcc = tid % 40, prow = tid / 40;
  const bool pact = tid < 240;
  const int pcol = (pcc < 16) ? (640 + g * 128 + pcc * 8) : ((pcc < 32) ? (384 + g * 128 + (pcc - 16) * 8) : (h * 64 + (pcc - 32) * 8));
  const bf16_t* pbase = p.PS + rowbase * 912 + pcol;
  const float2* dbase = p.DTC + (size_t)(d * 6 + h) * TOK + rowbase;
  const int drow_stride = (pcc < 32) ? 136 : 72;
  uint4 pf0, pf1, pf2, pf3, pf4, pf5;
  float2 dtc = make_float2(0.f, 0.f);
#define SD_GEOM(cix_, plo_)                                                \
  {                                                                        \
    const int st0_ = (cix_) * 32;                                          \
    if (st0_ < 256) plo_ = (d == 0) ? st0_ : 224 - st0_;                   \
    else plo_ = (d == 0) ? st0_ : 4576 - st0_;                             \
  }
#define SD_PF1(dst_, rr_, plo_)                                                                   \
  {                                                                                               \
    dst_ = make_uint4(0, 0, 0, 0);                                                                \
    if (pact && (rr_) < 32) dst_ = *(const uint4*)(pbase + (size_t)((plo_) + (rr_)) * 912);       \
  }
#define SD_PREFETCH(cix_)                                                          \
  {                                                                                \
    int plo_;                                                                      \
    SD_GEOM(cix_, plo_);                                                           \
    SD_PF1(pf0, prow, plo_); SD_PF1(pf1, prow + 6, plo_); SD_PF1(pf2, prow + 12, plo_); \
    SD_PF1(pf3, prow + 18, plo_); SD_PF1(pf4, prow + 24, plo_); SD_PF1(pf5, prow + 30, plo_); \
    if (tid < 32) dtc = dbase[plo_ + tid];                                         \
  }
#define SD_ST1(src_, rr_, cbuf_)                                                                  \
  {                                                                                               \
    if (pact && (rr_) < 32) {                                                                     \
      const int i_ = (d == 0) ? (rr_) : 31 - (rr_);                                               \
      bf16_t* dst_ = (pcc < 16) ? ((cbuf_) + i_ * 136 + pcc * 8) : ((pcc < 32) ? (Bs + i_ * 136 + (pcc - 16) * 8) : (Xs + i_ * 72 + (pcc - 32) * 8)); \
      *(uint4*)dst_ = src_;                                                                       \
    }                                                                                             \
  }
#define SD_STASH(buf_)                                                              \
  {                                                                                 \
    bf16_t* cbuf_ = Cs0 + (buf_) * 32 * 136;                                        \
    SD_ST1(pf0, prow, cbuf_); SD_ST1(pf1, prow + 6, cbuf_); SD_ST1(pf2, prow + 12, cbuf_); \
    SD_ST1(pf3, prow + 18, cbuf_); SD_ST1(pf4, prow + 24, cbuf_); SD_ST1(pf5, prow + 30, cbuf_); \
    if (tid < 32) {                                                                 \
      const int i_ = (d == 0) ? tid : 31 - tid;                                     \
      dc[(buf_) * 64 + i_] = dtc.x;                                                 \
      dc[(buf_) * 64 + 32 + i_] = dtc.y;                                            \
    }                                                                               \
  }
  (void)drow_stride;
  SD_PREFETCH(0);
  SD_STASH(0);
  __syncthreads();
  for (int cix = 0; cix < 136; ++cix) {
    int plo;
    SD_GEOM(cix, plo);
    const int buf = cix & 1;
    const bf16_t* Cs = Cs0 + buf * 32 * 136;
    const float* dts = dc + buf * 64;
    const float* cums = dts + 32;
    {
      const int j = tid & 31, ng = tid >> 5;
      const float tail = __expf(cums[31] - cums[j]);
      const float dtj = dts[j];
      const uint4 b0 = *(const uint4*)(Bs + j * 136 + ng * 16), b1 = *(const uint4*)(Bs + j * 136 + ng * 16 + 8);
      const uint4 x0 = *(const uint4*)(Xs + j * 72 + ng * 8);
      const unsigned bw[8] = {b0.x, b0.y, b0.z, b0.w, b1.x, b1.y, b1.z, b1.w};
      const unsigned xw[4] = {x0.x, x0.y, x0.z, x0.w};
#pragma unroll
      for (int e = 0; e < 8; ++e) {
        const unsigned pk = pack2(__uint_as_float(bw[e] << 16) * tail, __uint_as_float(bw[e] & 0xffff0000u) * tail);
        BtT[(ng * 16 + 2 * e) * 40 + j] = (bf16_t)(pk & 0xffffu);
        BtT[(ng * 16 + 2 * e + 1) * 40 + j] = (bf16_t)(pk >> 16);
      }
#pragma unroll
      for (int e = 0; e < 4; ++e) {
        const unsigned pk = pack2(__uint_as_float(xw[e] << 16) * dtj, __uint_as_float(xw[e] & 0xffff0000u) * dtj);
        XdT[(ng * 8 + 2 * e) * 40 + j] = (bf16_t)(pk & 0xffffu);
        XdT[(ng * 8 + 2 * e + 1) * 40 + j] = (bf16_t)(pk >> 16);
      }
#pragma unroll
      for (int mt = 0; mt < 4; ++mt)
#pragma unroll
        for (int t = 0; t < 2; ++t)
#pragma unroll
          for (int jj = 0; jj < 4; ++jj) Sb[(mt * 16 + fq * 4 + jj) * 136 + (2 * w + t) * 16 + fr] = f2bf(S[mt][t][jj]);
      const int mi = w >> 1, nj = w & 1;
      f32x4 acc = (f32x4){0.f, 0.f, 0.f, 0.f};
#pragma unroll
      for (int ks = 0; ks < 4; ++ks) {
        bf16x8 a = *(const bf16x8*)(Cs + (mi * 16 + fr) * 136 + ks * 32 + fq * 8);
        bf16x8 bb = *(const bf16x8*)(Bs + (nj * 16 + fr) * 136 + ks * 32 + fq * 8);
        acc = MFMA(a, bb, acc);
      }
      const int jc = nj * 16 + fr;
      const float cj = cums[jc];
#pragma unroll
      for (int jj = 0; jj < 4; ++jj) {
        const int i = mi * 16 + fq * 4 + jj;
        const float v = (jc <= i) ? acc[jj] * __expf(cums[i] - cj) : 0.f;
        Ms[i * 40 + jc] = f2bf(v);
      }
    }
    __syncthreads();
    if (cix + 1 < 136) SD_PREFETCH(cix + 1);
    {
      const int mi = w >> 1;
      bf16x8 am = *(const bf16x8*)(Ms + (mi * 16 + fr) * 40 + fq * 8);
      bf16x8 ac[4];
#pragma unroll
      for (int ks = 0; ks < 4; ++ks) ac[ks] = *(const bf16x8*)(Cs + (mi * 16 + fr) * 136 + ks * 32 + fq * 8);
#pragma unroll
      for (int t = 0; t < 2; ++t) {
        const int pt = 2 * (w & 1) + t;
        f32x4 y1 = (f32x4){0.f, 0.f, 0.f, 0.f}, y2 = (f32x4){0.f, 0.f, 0.f, 0.f};
        bf16x8 bx = *(const bf16x8*)(XdT + (pt * 16 + fr) * 40 + fq * 8);
        y1 = MFMA(am, bx, y1);
#pragma unroll
        for (int ks = 0; ks < 4; ++ks) {
          bf16x8 bs = *(const bf16x8*)(Sb + (pt * 16 + fr) * 136 + ks * 32 + fq * 8);
          y2 = MFMA(ac[ks], bs, y2);
        }
#pragma unroll
        for (int jj = 0; jj < 4; ++jj) {
          const int i = mi * 16 + fq * 4 + jj;
          const int pi = plo + ((d == 0) ? i : 31 - i);
          const float y = y1[jj] + __expf(cums[i]) * y2[jj];
          p.yS[((size_t)d * TOK + rowbase + pi) * 384 + h * 64 + pt * 16 + fr] = f2bf(y);
        }
      }
      const float dec = __expf(cums[31]);
      bf16x8 bt[2];
#pragma unroll
      for (int t = 0; t < 2; ++t) bt[t] = *(const bf16x8*)(BtT + ((2 * w + t) * 16 + fr) * 40 + fq * 8);
#pragma unroll
      for (int mt = 0; mt < 4; ++mt) {
        bf16x8 ax = *(const bf16x8*)(XdT + (mt * 16 + fr) * 40 + fq * 8);
#pragma unroll
        for (int t = 0; t < 2; ++t) {
          S[mt][t] *= dec;
          S[mt][t] = MFMA(ax, bt[t], S[mt][t]);
        }
      }
    }
    if (cix + 1 < 136) SD_STASH(buf ^ 1);
    __syncthreads();
  }
}

__device__ __forceinline__ void attn_tile(const Params& p, int l, int tile, unsigned char* smem) {
  const bool isctx = tile >= 768;
  int qt, head, b;
  if (!isctx) { qt = tile & 31; head = (tile >> 5) % 6; b = tile / 192; }
  else { int tt = tile - 768; qt = tt & 1; head = (tt >> 1) % 6; b = tt / 12; }
  const int hkv = head / 3;
  const int tid = launder(threadIdx.x), lane = tid & 63, w = tid >> 6, fr = lane & 15, fq = lane >> 4;
  bf16_t* Ks = (bf16_t*)smem;
  bf16_t* Vt = Ks + 64 * 72;
  bf16_t* Ps = Vt + 64 * 72 + w * 32 * 72;
  const int q0 = qt * 128;
  const size_t rowb = (size_t)b * TPB;
  const size_t rowq0 = rowb + (isctx ? q0 : 256 + q0);
  bf16x8 qf[2][2];
  float m[2][4], ls[2][4];
  f32x4 o[2][4];
  const float sk = p.attn_sink[l * 6 + head];
#pragma unroll
  for (int mt = 0; mt < 2; ++mt) {
    const int qi0 = (2 * w + mt) * 16;
#pragma unroll
    for (int ks = 0; ks < 2; ++ks) qf[mt][ks] = *(const bf16x8*)(p.PA + (rowq0 + qi0 + fr) * 1024 + head * 64 + ks * 32 + fq * 8);
#pragma unroll
    for (int j = 0; j < 4; ++j) { m[mt][j] = sk; ls[mt][j] = 1.f; }
#pragma unroll
    for (int nt = 0; nt < 4; ++nt) o[mt][nt] = (f32x4){0.f, 0.f, 0.f, 0.f};
  }
  int klo = 0, nb = 0;
  if (!isctx) {
    klo = max(0, q0 - 128);
    const int khi = min(4096, q0 + 256);
    nb = (khi - klo) >> 6;
  }
  const int ntile = nb + 4;
  const int lr = tid >> 3, lc = tid & 7;
  uint4 kr0, kr1, vr0, vr1;
#define KVLOAD(kt_)                                                                              \
  {                                                                                              \
    const size_t kr0_ = ((kt_) < nb) ? rowb + 256 + klo + (kt_) * 64 : rowb + ((kt_) - nb) * 64; \
    const bf16_t* src0 = p.PA + (kr0_ + lr) * 1024 + 384 + hkv * 64 + lc * 8;                    \
    const bf16_t* src1 = src0 + 32 * 1024;                                                       \
    kr0 = *(const uint4*)src0;                                                                   \
    vr0 = *(const uint4*)(src0 + 128);                                                           \
    kr1 = *(const uint4*)src1;                                                                   \
    vr1 = *(const uint4*)(src1 + 128);                                                           \
  }
#define VTSTORE(vr_, rr_)                                                 \
  {                                                                       \
    Vt[(lc * 8 + 0) * 72 + (rr_)] = (bf16_t)((vr_).x & 0xffffu);          \
    Vt[(lc * 8 + 1) * 72 + (rr_)] = (bf16_t)((vr_).x >> 16);              \
    Vt[(lc * 8 + 2) * 72 + (rr_)] = (bf16_t)((vr_).y & 0xffffu);          \
    Vt[(lc * 8 + 3) * 72 + (rr_)] = (bf16_t)((vr_).y >> 16);              \
    Vt[(lc * 8 + 4) * 72 + (rr_)] = (bf16_t)((vr_).z & 0xffffu);          \
    Vt[(lc * 8 + 5) * 72 + (rr_)] = (bf16_t)((vr_).z >> 16);              \
    Vt[(lc * 8 + 6) * 72 + (rr_)] = (bf16_t)((vr_).w & 0xffffu);          \
    Vt[(lc * 8 + 7) * 72 + (rr_)] = (bf16_t)((vr_).w >> 16);              \
  }
  KVLOAD(0);
  for (int kt = 0; kt < ntile; ++kt) {
    __syncthreads();
    *(uint4*)(Ks + lr * 72 + lc * 8) = kr0;
    *(uint4*)(Ks + (lr + 32) * 72 + lc * 8) = kr1;
    VTSTORE(vr0, lr);
    VTSTORE(vr1, lr + 32);
    __syncthreads();
    if (kt + 1 < ntile) KVLOAD(kt + 1);
    f32x4 s[2][4];
#pragma unroll
    for (int mt = 0; mt < 2; ++mt)
#pragma unroll
      for (int nt = 0; nt < 4; ++nt) s[mt][nt] = (f32x4){0.f, 0.f, 0.f, 0.f};
#pragma unroll
    for (int ks = 0; ks < 2; ++ks) {
#pragma unroll
      for (int nt = 0; nt < 4; ++nt) {
        bf16x8 kb = *(const bf16x8*)(Ks + (nt * 16 + fr) * 72 + ks * 32 + fq * 8);
#pragma unroll
        for (int mt = 0; mt < 2; ++mt) s[mt][nt] = MFMA(qf[mt][ks], kb, s[mt][nt]);
      }
    }
    const bool band = kt < nb;
    const int kp0 = klo + kt * 64 + fr;
#pragma unroll
    for (int mt = 0; mt < 2; ++mt) {
      const int qi0 = (2 * w + mt) * 16;
#pragma unroll
      for (int j = 0; j < 4; ++j) {
        const int qp = q0 + qi0 + fq * 4 + j;
        float sv0 = s[mt][0][j], sv1 = s[mt][1][j], sv2 = s[mt][2][j], sv3 = s[mt][3][j];
        if (band) {
          const int dlt = qp - kp0;
          if (dlt > 128 || dlt < -128) sv0 = -INFINITY;
          if (dlt - 16 > 128 || dlt - 16 < -128) sv1 = -INFINITY;
          if (dlt - 32 > 128 || dlt - 32 < -128) sv2 = -INFINITY;
          if (dlt - 48 > 128 || dlt - 48 < -128) sv3 = -INFINITY;
        }
        float mx = fmaxf(fmaxf(sv0, sv1), fmaxf(sv2, sv3));
        mx = max16(mx);
        const float mn = fmaxf(m[mt][j], mx);
        const float alpha = __expf(m[mt][j] - mn);
        const float p0 = __expf(sv0 - mn), p1 = __expf(sv1 - mn), p2 = __expf(sv2 - mn), p3 = __expf(sv3 - mn);
        bf16_t* pr = Ps + (mt * 16 + fq * 4 + j) * 72 + fr;
        pr[0] = f2bf(p0); pr[16] = f2bf(p1); pr[32] = f2bf(p2); pr[48] = f2bf(p3);
        const float rsum = sum16(p0 + p1 + p2 + p3);
        ls[mt][j] = ls[mt][j] * alpha + rsum;
        m[mt][j] = mn;
#pragma unroll
        for (int nt = 0; nt < 4; ++nt) o[mt][nt][j] *= alpha;
      }
    }
    __builtin_amdgcn_wave_barrier();
#pragma unroll
    for (int ks = 0; ks < 2; ++ks) {
      bf16x8 pa[2];
#pragma unroll
      for (int mt = 0; mt < 2; ++mt) pa[mt] = *(const bf16x8*)(Ps + (mt * 16 + fr) * 72 + ks * 32 + fq * 8);
#pragma unroll
      for (int nt = 0; nt < 4; ++nt) {
        bf16x8 vb = *(const bf16x8*)(Vt + (nt * 16 + fr) * 72 + ks * 32 + fq * 8);
#pragma unroll
        for (int mt = 0; mt < 2; ++mt) o[mt][nt] = MFMA(pa[mt], vb, o[mt][nt]);
      }
    }
    __builtin_amdgcn_wave_barrier();
  }
#pragma unroll
  for (int mt = 0; mt < 2; ++mt) {
    const int qi0 = (2 * w + mt) * 16;
#pragma unroll
    for (int j = 0; j < 4; ++j) {
      const size_t r = rowq0 + qi0 + fq * 4 + j;
      const float inv = frcp(ls[mt][j]);
#pragma unroll
      for (int nt = 0; nt < 4; ++nt) {
        const int dc = nt * 16 + fr;
        const float gt = bf2f(p.PA[r * 1024 + 640 + head * 64 + dc]);
        p.PA[r * 1024 + head * 64 + dc] = f2bf(o[mt][nt][j] * inv * siluf_(gt));
      }
    }
  }
  __syncthreads();
}

#ifndef PROBE_DUP
#define PROBE_DUP 0
#endif
__device__ __forceinline__ void phase_probe(const Params& p, int l, unsigned char* smem) {
  if (PROBE_DUP == 1) { for (int t = blockIdx.x; t < 256; t += gridDim.x) { if (t < 128) rwkv_tile<false>(p, l, t, smem); else rwkv_tile<true>(p, l, t, smem); } }
  if (PROBE_DUP == 2) { for (int t = blockIdx.x; t < 48; t += gridDim.x) ssd_tile(p, l, t, smem); }
}
__device__ __forceinline__ void phase_mixers(const Params& p, int l, unsigned char* smem) {
  const int natt = (l == 0) ? 816 : 768;
  const int bid = blockIdx.x, G = gridDim.x;
  if (G == 512) {
    if (bid < 128) {
      __builtin_amdgcn_s_setprio(3);
      rwkv_tile<false>(p, l, bid, smem);
      __builtin_amdgcn_s_setprio(0);
    } else if (bid < 256) {
      __builtin_amdgcn_s_setprio(3);
      rwkv_tile<true>(p, l, bid, smem);
      __builtin_amdgcn_s_setprio(0);
    } else if (bid < 304) {
      __builtin_amdgcn_s_setprio(2);
      ssd_tile(p, l, bid - 256, smem);
      __builtin_amdgcn_s_setprio(0);
    }
    int* tsl = (int*)(smem + 73728);
    const int tid = launder(threadIdx.x);
    if (l == 0) {
      for (;;) {
        __syncthreads();
        if (tid == 0) *tsl = (int)atomicAdd(&p.ctrs[2], 1u);
        __syncthreads();
        const int t = *tsl;
        if (t >= 1440) break;
        deferred_transpose(p, t, smem);
      }
    }
    for (;;) {
      __syncthreads();
      if (tid == 0) *tsl = (int)atomicAdd(&p.ctrs[l], 1u);
      __syncthreads();
      const int t = *tsl;
      if (t >= natt) break;
      attn_tile(p, l, t, smem);
    }
    for (;;) {
      __syncthreads();
      if (tid == 0) *tsl = (int)atomicAdd(&p.ctrs[4 + l], 1u);
      __syncthreads();
      const int j = *tsl;
      if (j >= 136 * 5) break;
      gemm_late_tile(p, l, j / 5, 16 + j % 5, smem);
    }
  } else {
    if (l == 0) for (int t = bid; t < 1440; t += G) deferred_transpose(p, t, smem);
    for (int t = bid; t < 136 * 5; t += G) gemm_late_tile(p, l, t / 5, 16 + t % 5, smem);
    const int total = 304 + natt;
    for (int t = bid; t < total; t += G) {
      if (t < 128) rwkv_tile<false>(p, l, t, smem);
      else if (t < 256) rwkv_tile<true>(p, l, t, smem);
      else if (t < 304) ssd_tile(p, l, t - 256, smem);
      else attn_tile(p, l, t - 304, smem);
    }
  }
}

__device__ __forceinline__ float blo(unsigned u) { return __uint_as_float(u << 16); }
__device__ __forceinline__ float bhi(unsigned u) { return __uint_as_float(u & 0xffff0000u); }
__device__ __forceinline__ void phase_finish(const Params& p, int l) {
  const int tid = launder(threadIdx.x), lane = tid & 63, w = tid >> 6;
  bf16_t* mix = p.hbuf;
  const int cg_ = lane * 4, hh4 = lane >> 4;
  const float* mu0 = p.rwkv_mu + (size_t)(l * 2) * 1024 + cg_;
  const float* mu1 = mu0 + 1024;
  const float4 m0r = *(const float4*)mu0, m1r = *(const float4*)mu1;
  const float4 m0k = *(const float4*)(mu0 + 256), m1k = *(const float4*)(mu1 + 256);
  const float4 m0v = *(const float4*)(mu0 + 512), m1v = *(const float4*)(mu1 + 512);
  const float4 rk4 = *(const float4*)(p.rwkv_r_k + l * 256 + hh4 * 64 + (cg_ & 63));
  const float4 lw4 = *(const float4*)(p.rwkv_ln_w + l * 256 + cg_), lb4 = *(const float4*)(p.rwkv_ln_b + l * 256 + cg_);
  const int cs_ = lane * 6;
  const float2 nw0 = *(const float2*)(p.ssm_norm_w + l * 384 + cs_), nw1 = *(const float2*)(p.ssm_norm_w + l * 384 + cs_ + 2), nw2 = *(const float2*)(p.ssm_norm_w + l * 384 + cs_ + 4);
  const float dsk0 = p.ssm_d[l * 6 + (cs_ >> 6)], dsk1 = p.ssm_d[l * 6 + ((cs_ + 2) >> 6)], dsk2 = p.ssm_d[l * 6 + ((cs_ + 4) >> 6)];
  for (int t = blockIdx.x; t < TOK / 4; t += gridDim.x) {
    const int r = t * 4 + w, pp = r % TPB;
    if (l == 1 && pp < 256) continue;
    const bool isc = pp < 256;
    const int slo = isc ? 0 : 256, shi = isc ? 255 : 4351;
    const bool hp = pp > slo, hn = pp < shi;
    const unsigned* a32 = (const unsigned*)(p.PA + (size_t)r * 1024 + lane * 6);
    const unsigned at0 = a32[0], at1 = a32[1], at2 = a32[2];
    const uint2 ya = *(const uint2*)(p.yR + (size_t)r * 256 + cg_);
    const uint2 yb = *(const uint2*)(p.yR + ((size_t)TOK + r) * 256 + cg_);
    const bf16_t* pr = p.PR + (size_t)r * 1024 + cg_;
    const uint2 z2 = make_uint2(0u, 0u);
    const uint2 rc = *(const uint2*)pr, kc = *(const uint2*)(pr + 256), vc = *(const uint2*)(pr + 512);
    const uint2 rp = hp ? *(const uint2*)(pr - 1024) : z2, kp = hp ? *(const uint2*)(pr + 256 - 1024) : z2, vp = hp ? *(const uint2*)(pr + 512 - 1024) : z2;
    const uint2 rn = hn ? *(const uint2*)(pr + 1024) : z2, kn = hn ? *(const uint2*)(pr + 256 + 1024) : z2, vn = hn ? *(const uint2*)(pr + 512 + 1024) : z2;
    const uint2 g2 = *(const uint2*)(p.PG + (size_t)r * 640 + cg_);
    const unsigned* s0 = (const unsigned*)(p.yS + (size_t)r * 384 + cs_);
    const unsigned* s1 = (const unsigned*)(p.yS + ((size_t)TOK + r) * 384 + cs_);
    const unsigned* xs32 = (const unsigned*)(p.PS + (size_t)r * 912 + cs_);
    const unsigned* z32 = (const unsigned*)(p.PG + (size_t)r * 640 + 256 + cs_);
    const unsigned sa0 = s0[0], sa1 = s0[1], sa2 = s0[2], sb0 = s1[0], sb1 = s1[1], sb2 = s1[2];
    const unsigned xa0 = xs32[0], xa1 = xs32[1], xa2 = xs32[2], za0 = z32[0], za1 = z32[1], za2 = z32[2];
    {
      unsigned* d32 = (unsigned*)(mix + (size_t)r * 1024 + lane * 6);
      d32[0] = at0; d32[1] = at1; d32[2] = at2;
    }
    {
      float y[4] = {blo(ya.x) + blo(yb.x), bhi(ya.x) + bhi(yb.x), blo(ya.y) + blo(yb.y), bhi(ya.y) + bhi(yb.y)};
      const float sm = sum16(y[0] + y[1] + y[2] + y[3]);
      const float mean = sm * (1.f / 64.f);
      float vq = 0.f;
#pragma unroll
      for (int e = 0; e < 4; ++e) { y[e] -= mean; vq += y[e] * y[e]; }
      vq = sum16(vq);
      const float rstd = rsqrtf(vq * (1.f / 64.f) + 64e-5f);
      const float rs0 = blo(rc.x) + m0r.x * (blo(rp.x) - blo(rc.x)) + m1r.x * (blo(rn.x) - blo(rc.x));
      const float rs1 = bhi(rc.x) + m0r.y * (bhi(rp.x) - bhi(rc.x)) + m1r.y * (bhi(rn.x) - bhi(rc.x));
      const float rs2 = blo(rc.y) + m0r.z * (blo(rp.y) - blo(rc.y)) + m1r.z * (blo(rn.y) - blo(rc.y));
      const float rs3 = bhi(rc.y) + m0r.w * (bhi(rp.y) - bhi(rc.y)) + m1r.w * (bhi(rn.y) - bhi(rc.y));
      const float ks0 = blo(kc.x) + m0k.x * (blo(kp.x) - blo(kc.x)) + m1k.x * (blo(kn.x) - blo(kc.x));
      const float ks1 = bhi(kc.x) + m0k.y * (bhi(kp.x) - bhi(kc.x)) + m1k.y * (bhi(kn.x) - bhi(kc.x));
      const float ks2 = blo(kc.y) + m0k.z * (blo(kp.y) - blo(kc.y)) + m1k.z * (blo(kn.y) - blo(kc.y));
      const float ks3 = bhi(kc.y) + m0k.w * (bhi(kp.y) - bhi(kc.y)) + m1k.w * (bhi(kn.y) - bhi(kc.y));
      const float vs0 = blo(vc.x) + m0v.x * (blo(vp.x) - blo(vc.x)) + m1v.x * (blo(vn.x) - blo(vc.x));
      const float vs1 = bhi(vc.x) + m0v.y * (bhi(vp.x) - bhi(vc.x)) + m1v.y * (bhi(vn.x) - bhi(vc.x));
      const float vs2 = blo(vc.y) + m0v.z * (blo(vp.y) - blo(vc.y)) + m1v.z * (blo(vn.y) - blo(vc.y));
      const float vs3 = bhi(vc.y) + m0v.w * (bhi(vp.y) - bhi(vc.y)) + m1v.w * (bhi(vn.y) - bhi(vc.y));
      const float dot = sum16(rs0 * ks0 * rk4.x + rs1 * ks1 * rk4.y + rs2 * ks2 * rk4.z + rs3 * ks3 * rk4.w);
      const float o0 = (y[0] * rstd * lw4.x + lb4.x + dot * vs0) * siluf_(blo(g2.x));
      const float o1 = (y[1] * rstd * lw4.y + lb4.y + dot * vs1) * siluf_(bhi(g2.x));
      const float o2 = (y[2] * rstd * lw4.z + lb4.z + dot * vs2) * siluf_(blo(g2.y));
      const float o3 = (y[3] * rstd * lw4.w + lb4.w + dot * vs3) * siluf_(bhi(g2.y));
      uint2 ov;
      ov.x = pack2(o0, o1);
      ov.y = pack2(o2, o3);
      *(uint2*)(mix + (size_t)r * 1024 + 384 + cg_) = ov;
    }
    {
      const float y0 = (blo(sa0) + blo(sb0) + dsk0 * blo(xa0)) * siluf_(blo(za0));
      const float y1 = (bhi(sa0) + bhi(sb0) + dsk0 * bhi(xa0)) * siluf_(bhi(za0));
      const float y2 = (blo(sa1) + blo(sb1) + dsk1 * blo(xa1)) * siluf_(blo(za1));
      const float y3 = (bhi(sa1) + bhi(sb1) + dsk1 * bhi(xa1)) * siluf_(bhi(za1));
      const float y4 = (blo(sa2) + blo(sb2) + dsk2 * blo(xa2)) * siluf_(blo(za2));
      const float y5 = (bhi(sa2) + bhi(sb2) + dsk2 * bhi(xa2)) * siluf_(bhi(za2));
      float sq = sum16(y0 * y0 + y1 * y1 + y2 * y2 + y3 * y3 + y4 * y4 + y5 * y5);
      sq += __shfl_xor(sq, 16);
      const float rstd = rsqrtf(sq * (1.f / 192.f) + 1e-5f);
      unsigned* dd = (unsigned*)(mix + (size_t)r * 1024 + 640 + cs_);
      dd[0] = pack2(y0 * rstd * nw0.x, y1 * rstd * nw0.y);
      dd[1] = pack2(y2 * rstd * nw1.x, y3 * rstd * nw1.y);
      dd[2] = pack2(y4 * rstd * nw2.x, y5 * rstd * nw2.y);
    }
  }
}

#define XB_TMO      128
#define XB_XCNT(j)  (256  + 64 * (j))
#define XB_XSUB(j)  (1280 + 64 * (j))
#define XB_XGEN(j)  (2304 + 64 * (j))
#define XB_TOP      3328
#define XB_TOPGEN   3392
#define XCD_BAR_WORDS 3456
#define XB_SPIN_CAP (1u << 18)
#define LAS __attribute__((address_space(3)))

__device__ __forceinline__ unsigned xb_ld(unsigned* p)              { return __hip_atomic_load(p, __ATOMIC_RELAXED, __HIP_MEMORY_SCOPE_AGENT); }
__device__ __forceinline__ unsigned xb_add(unsigned* p, unsigned v) { return __hip_atomic_fetch_add(p, v, __ATOMIC_RELAXED, __HIP_MEMORY_SCOPE_AGENT); }
__device__ __forceinline__ unsigned xb_xcc_id() { return (unsigned)__builtin_amdgcn_s_getreg((3 << 11) | 20) & 0xFu; }
#define XB_SPIN(cond, bar) do { unsigned _sp = 0; while (cond) { __builtin_amdgcn_s_sleep(1); \
    if ((++_sp & 255u) == 0u) { if (xb_ld(&(bar)[XB_TMO])) break; if (_sp > XB_SPIN_CAP) { atomicAdd(&(bar)[XB_TMO], 1u); break; } } } } while (0)

struct XcdBarrier {
    unsigned* bar; unsigned x;
    volatile LAS unsigned* st;
};

__device__ __forceinline__ XcdBarrier xcd_barrier_post(unsigned* bar, volatile LAS unsigned* st) {
    XcdBarrier b; b.bar = bar; b.x = xb_xcc_id(); b.st = st;
    if (threadIdx.x == 0) (void)xb_add(&bar[XB_XCNT(b.x)], 1u);
    return b;
}
__device__ __forceinline__ void xcd_barrier_complete(unsigned* bar, unsigned x, unsigned& nloc, unsigned& nx) {
    const unsigned G = gridDim.x * gridDim.y * gridDim.z;
    unsigned sum, cnt, mine, sp = 0u;
    for (;;) {
        sum = 0u; cnt = 0u; mine = 0u;
#pragma unroll
        for (unsigned j = 0; j < 16; ++j) { const unsigned c = xb_ld(&bar[XB_XCNT(j)]); sum += c; cnt += (c > 0u) ? 1u : 0u; mine = (j == x) ? c : mine; }
        if (sum == G) break;
        __builtin_amdgcn_s_sleep(1);
        if ((++sp & 255u) == 0u) { if (xb_ld(&bar[XB_TMO])) break; if (sp > XB_SPIN_CAP) { atomicAdd(&bar[XB_TMO], 1u); break; } }
    }
    nloc = mine > 0u ? mine : 1u; nx = cnt > 0u ? cnt : 1u;
}

__device__ __forceinline__ void xcd_barrier(const XcdBarrier& b) {
    asm volatile("s_waitcnt vmcnt(0)" ::: "memory");
    __syncthreads();
    if (threadIdx.x == 0) {
        unsigned* bar = b.bar;
        __builtin_amdgcn_s_waitcnt(0);
        unsigned nloc = b.st[0], nx = b.st[1];
        if (nloc == 0u) { xcd_barrier_complete(bar, b.x, nloc, nx); b.st[0] = nloc; b.st[1] = nx; }
        const unsigned old = xb_add(&bar[XB_XSUB(b.x)], 1u);
        const unsigned gen = old / nloc;
        if (old + 1u == (gen + 1u) * nloc) {
            __builtin_amdgcn_fence(__ATOMIC_RELEASE, "agent");
            asm volatile("s_waitcnt vmcnt(0)" ::: "memory");
            const unsigned og = xb_add(&bar[XB_TOP], 1u);
            const unsigned tg = og / nx;
            if (og + 1u == (tg + 1u) * nx) xb_add(&bar[XB_TOPGEN], 1u);
            else XB_SPIN(xb_ld(&bar[XB_TOPGEN]) == tg, bar);
            __builtin_amdgcn_fence(__ATOMIC_ACQUIRE, "agent");
            xb_add(&bar[XB_XGEN(b.x)], 1u);
            asm volatile("s_waitcnt vmcnt(0)" ::: "memory");
        } else {
            XB_SPIN(xb_ld(&bar[XB_XGEN(b.x)]) == gen, bar);
            __builtin_amdgcn_fence(__ATOMIC_ACQUIRE, "agent");
            asm volatile("s_waitcnt vmcnt(0)" ::: "memory");
        }
    }
    __syncthreads();
}


__global__ void __launch_bounds__(NTHREADS, LBW) mega(Params p, int ph_lo, int ph_hi) {
  extern __shared__ __attribute__((aligned(16))) unsigned char smem[];
  volatile LAS unsigned* xst = (volatile LAS unsigned*)(smem + LDS_BYTES - 16);
  XcdBarrier xb;
  xb.bar = p.bar; xb.x = 0; xb.st = xst;
  if (ph_hi - ph_lo > 1) {
    if (threadIdx.x == 0) { xst[0] = 0u; xst[1] = 0u; }
    __syncthreads();
    xb = xcd_barrier_post(p.bar, xst);
  }
  for (int ph = ph_lo; ph < ph_hi; ++ph) {
    if (ph > ph_lo) {
      if (ph_hi > 1000) cg::this_grid().sync();
      xcd_barrier(xb);
    }
#ifndef TEST_PH
#define TEST_PH -1
#endif
    if (ph == 0) {
      if (PROBE_DUP == 4) { phase_setup(p, smem); cg::this_grid().sync(); }
      if (TEST_PH < 0 || TEST_PH == 0) phase_setup(p, smem);
    }
    else if (ph == NPHASES - 1) { if (TEST_PH < 0 || TEST_PH == 6) phase_final(p); }
    else {
      const int l = (ph - 1) / 7, s = (ph - 1) % 7;
      if (s == 0) { if (TEST_PH < 0 || TEST_PH == 1) phase_norm(p, l); }
      else if (s == 1) {
        if (PROBE_DUP == 3) { phase_inproj(p, l, smem); cg::this_grid().sync(); }
        if (TEST_PH < 0 || TEST_PH == 2) phase_inproj(p, l, smem);
      }
      else if (s == 2) {
        if (PROBE_DUP == 5) { phase_rwkvprep(p, l, smem); cg::this_grid().sync(); }
        if (TEST_PH < 0 || TEST_PH == 10) phase_rwkvprep(p, l, smem);
      }
      else if (s == 3) {
        if (PROBE_DUP == 1 || PROBE_DUP == 2) { phase_probe(p, l, smem); cg::this_grid().sync(); }
        if (TEST_PH < 0 || TEST_PH == 3 || (TEST_PH >= 7 && TEST_PH <= 9)) phase_mixers(p, l, smem);
      }
      else if (s == 4) { phase_rwkvfix(p); }
      else if (s == 5) { if (TEST_PH < 0 || TEST_PH == 4) phase_finish(p, l); }
      else { if (TEST_PH < 0 || TEST_PH == 5) phase_outproj(p, l, smem); }
    }
  }
}

extern "C" void kernel_launch(void* const* d_in, const int* in_sizes, int n_in, void* d_out, int out_size, void* d_ws,
                              size_t ws_size, hipStream_t stream) {
  static int grid_blocks = 0;
  if (!grid_blocks) {
    int dev = 0, cus = 0, per_cu = 0;
    hipGetDevice(&dev);
    hipDeviceGetAttribute(&cus, hipDeviceAttributeMultiprocessorCount, dev);
    hipFuncSetAttribute((const void*)mega, hipFuncAttributeMaxDynamicSharedMemorySize, LDS_BYTES);
    hipOccupancyMaxActiveBlocksPerMultiprocessor(&per_cu, (const void*)mega, NTHREADS, LDS_BYTES);
    if (per_cu < 1) per_cu = 1;
    if (per_cu > 2) per_cu = 2;
    grid_blocks = cus * per_cu;
  }
  Params p{};
  const float** fp = (const float**)&p;
  for (int i = 0; i < 27; ++i) fp[i] = (const float*)d_in[i];
  p.out = (float*)d_out;
  unsigned char* ws = (unsigned char*)d_ws;
  size_t off = 0;
  auto take = [&](size_t bytes) { unsigned char* r = ws + off; off += (bytes + 255) & ~(size_t)255; return r; };
  p.WtIn = (bf16_t*)take((size_t)2 * 3712 * 1024 * 2);
  p.WtOut = (bf16_t*)take((size_t)2 * 1024 * 1024 * 2);
  p.WupT = (bf16_t*)take((size_t)65536 * 2);
  p.AupT = (bf16_t*)take((size_t)65536 * 2);
  p.rope = (float*)take(1024 * 2 * 4);
  p.mod = (float*)take((size_t)2 * 5 * 3072 * 4);
  p.ctxcur = (float*)take((size_t)4 * 256 * 1024 * 4);
  p.PRE = (bf16_t*)take((size_t)3 * TOK * 512 * 2);
  p.hbuf = p.PRE;
  p.PA = (bf16_t*)take((size_t)TOK * 1024 * 2);
  p.PR = (bf16_t*)take((size_t)TOK * 1024 * 2);
  p.PG = (bf16_t*)take((size_t)TOK * 640 * 2);
  p.PS = (bf16_t*)take((size_t)TOK * 912 * 2);
  p.yR = (bf16_t*)take((size_t)2 * TOK * 256 * 2);
  p.HALO = (bf16_t*)take((size_t)512 * 2 * 896 * 2);
  p.DTC = (float2*)take((size_t)12 * TOK * 8);
  p.GID = (bf16_t*)take((size_t)8 * NSEG1 * 256 * 2);
  p.SMID = (float*)take((size_t)32 * 64 * 64 * 4);
  p.ctrs = (unsigned*)take(256);
  p.bar = (unsigned*)take((size_t)XCD_BAR_WORDS * 4);
  p.rstd = (float*)take((size_t)TOK * 4);
  p.yS = (bf16_t*)take((size_t)2 * TOK * 384 * 2);
  if (off > ws_size) { fprintf(stderr, "workspace too small: need %zu have %zu\n", off, ws_size); return; }
#if ONE_LAUNCH
  hipMemsetAsync(p.bar, 0, (size_t)XCD_BAR_WORDS * 4, stream);
  int lo = 0, hi = NPHASES;
  void* args[] = {&p, &lo, &hi};
  hipError_t e = hipLaunchCooperativeKernel((const void*)mega, dim3(grid_blocks), dim3(NTHREADS), args, LDS_BYTES, stream);
  if (e != hipSuccess) fprintf(stderr, "cooperative launch failed: %s (grid %d)\n", hipGetErrorString(e), grid_blocks);
#else
  for (int ph = 0; ph < NPHASES; ++ph)
    hipLaunchKernelGGL(mega, dim3(grid_blocks), dim3(NTHREADS), LDS_BYTES, stream, p, ph, ph + 1);
#endif
}
```

```cpp
#include <hip/hip_runtime.h>
#include <hip/hip_bf16.h>
#include <hip/hip_cooperative_groups.h>
#include <cstdio>
namespace cg = cooperative_groups;

#ifndef TEST_PH
#define TEST_PH -1
#endif
#ifndef ONE_LAUNCH
#define ONE_LAUNCH 1
#endif

typedef unsigned short bf16_t;
#define GLAS __attribute__((address_space(3)))
using bf16x8 = __attribute__((ext_vector_type(8))) short;
using f32x4 = __attribute__((ext_vector_type(4))) float;

#define TOK 17408
#define TPB 4352
#define NTHREADS 256
#define LDS_BYTES 76800
#define NPHASES 16
#define CSPLIT 78
#define NSEG1 ((136 - CSPLIT) * 32)
#ifndef LBW
#define LBW 2
#endif

struct Params {
  const float *x, *c, *ctx, *c_ctx, *ada_w, *ada_b, *norm_w, *w_in, *w_out, *attn_sink, *rwkv_mu, *rwkv_w0,
      *rwkv_w_up, *rwkv_a0, *rwkv_a_up, *rwkv_k_k, *rwkv_k_a, *rwkv_r_k, *rwkv_ln_w, *rwkv_ln_b, *ssm_conv_w,
      *ssm_conv_b, *ssm_a_log, *ssm_dt_bias, *ssm_d, *ssm_norm_w, *final_norm_w;
  float* out;
  bf16_t *WtIn, *WtOut, *WupT, *AupT;
  float *rope, *mod, *ctxcur;
  bf16_t *hbuf, *PA, *PR, *PG, *PS;
  bf16_t* yR;
  bf16_t* yS;
  bf16_t* PRE;
  bf16_t* HALO;
  float2* DTC;
  bf16_t* GID;
  float* SMID;
  unsigned* ctrs;
  unsigned* bar;
  float* rstd;
};

__device__ __forceinline__ float bf2f(bf16_t v) { return __uint_as_float(((unsigned)v) << 16); }
typedef __bf16 hbf2 __attribute__((ext_vector_type(2)));
typedef float hf2 __attribute__((ext_vector_type(2)));
__device__ __forceinline__ unsigned pack2(float a, float b) {
  hf2 v = {a, b};
  hbf2 r = __builtin_convertvector(v, hbf2);
  return *(unsigned*)&r;
}
__device__ __forceinline__ bf16_t f2bf(float f) { return (bf16_t)(pack2(f, 0.f) & 0xffffu); }
__device__ __forceinline__ float frcp(float x) { return __builtin_amdgcn_rcpf(x); }
__device__ __forceinline__ float sigmoidf_(float x) { return frcp(1.f + __expf(-x)); }
__device__ __forceinline__ float siluf_(float x) { return x * frcp(1.f + __expf(-x)); }
__device__ __forceinline__ float softplusf_(float x) {
  if (x > 15.f) return x;
  float e = __expf(x);
  return (e < 0.01f) ? e * (1.f - e * (0.5f - e * 0.33333333f)) : __logf(1.f + e);
}
__device__ __forceinline__ float tanhf_(float x) {
  float e = __expf(2.f * x);
  return 1.f - 2.f * frcp(e + 1.f);
}

template <int CTRL>
__device__ __forceinline__ float dppf(float x) {
  return __int_as_float(__builtin_amdgcn_update_dpp(0, __float_as_int(x), CTRL, 0xF, 0xF, true));
}
__device__ __forceinline__ float sum16(float x) {
  x += dppf<0xB1>(x);
  x += dppf<0x4E>(x);
  x += dppf<0x141>(x);
  x += dppf<0x140>(x);
  return x;
}
__device__ __forceinline__ float max16(float x) {
  x = fmaxf(x, dppf<0xB1>(x));
  x = fmaxf(x, dppf<0x4E>(x));
  x = fmaxf(x, dppf<0x141>(x));
  x = fmaxf(x, dppf<0x140>(x));
  return x;
}
__device__ __forceinline__ float sum64(float x) {
#pragma unroll
  for (int o = 32; o >= 1; o >>= 1) x += __shfl_xor(x, o);
  return x;
}
__device__ __forceinline__ float sum32(float x) {
#pragma unroll
  for (int o = 16; o >= 1; o >>= 1) x += __shfl_xor(x, o);
  return x;
}
__device__ __forceinline__ int launder(int x) { asm volatile("" : "+v"(x)); return x; }
#define MFMA(a, b, c) __builtin_amdgcn_mfma_f32_16x16x32_bf16(a, b, c, 0, 0, 0)

__device__ __forceinline__ void transpose_tile(const float* __restrict__ W, int N, int Kdim, bf16_t* __restrict__ Wt, int k0, int n0,
                               unsigned char* smem) {
  float* T = (float*)smem;
  const int tid = launder(threadIdx.x);
#pragma unroll 4
  for (int it = 0; it < 16; ++it) {
    int kk = (tid >> 6) + 4 * it, nn = tid & 63, n = n0 + nn;
    T[kk * 65 + nn] = (n < N) ? W[(size_t)(k0 + kk) * N + n] : 0.f;
  }
  __syncthreads();
#pragma unroll
  for (int it = 0; it < 2; ++it) {
    int nn = (tid >> 3) + 32 * it, kc = tid & 7;
    uint4 o;
    o.x = pack2(T[(kc * 8 + 0) * 65 + nn], T[(kc * 8 + 1) * 65 + nn]);
    o.y = pack2(T[(kc * 8 + 2) * 65 + nn], T[(kc * 8 + 3) * 65 + nn]);
    o.z = pack2(T[(kc * 8 + 4) * 65 + nn], T[(kc * 8 + 5) * 65 + nn]);
    o.w = pack2(T[(kc * 8 + 6) * 65 + nn], T[(kc * 8 + 7) * 65 + nn]);
    *(uint4*)(Wt + (size_t)(n0 + nn) * Kdim + k0 + kc * 8) = o;
  }
  __syncthreads();
}

__device__ void sincos_d(double x, float& c, float& s) {
  double n = rint(x * 0.63661977236758134308);
  double r = x - n * 1.57079632679489661923;
  double r2 = r * r;
  double sn = r * (1.0 + r2 * (-1.0 / 6 + r2 * (1.0 / 120 + r2 * (-1.0 / 5040 + r2 * (1.0 / 362880 + r2 * (-1.0 / 39916800 + r2 * (1.0 / 6227020800.0)))))));
  double cs = 1.0 + r2 * (-0.5 + r2 * (1.0 / 24 + r2 * (-1.0 / 720 + r2 * (1.0 / 40320 + r2 * (-1.0 / 3628800 + r2 * (1.0 / 479001600.0 + r2 * (-1.0 / 87178291200.0)))))));
  int q = ((int)n) & 3;
  double co, so;
  if (q == 0) { co = cs; so = sn; }
  else if (q == 1) { co = -sn; so = cs; }
  else if (q == 2) { co = -cs; so = -sn; }
  else { co = sn; so = -cs; }
  c = (float)co;
  s = (float)so;
}

__device__ __forceinline__ void deferred_transpose(const Params& p, int t, unsigned char* smem) {
  if (t < 928) {
    const int kt = t / 58, nt = t % 58;
    transpose_tile(p.w_in + (size_t)1024 * 3596, 3596, 1024, p.WtIn + (size_t)3712 * 1024, kt * 64, nt * 64, smem);
  } else {
    const int tt = t - 928, l = tt >> 8, r = tt & 255, kt = r >> 4, nt = r & 15;
    transpose_tile(p.w_out + (size_t)l * 1024 * 1024, 1024, 1024, p.WtOut + (size_t)l * 1024 * 1024, kt * 64, nt * 64, smem);
  }
}
__device__ __forceinline__ void phase_setup(const Params& p, unsigned char* smem) {
  const int T_WIN = 16 * 58, T_WOUT = 0, T_ADA = 2 * 96, T_MISC = 17;
  const int total = T_WIN + T_WOUT + T_ADA + T_MISC;
  const int tid = launder(threadIdx.x);
  if (blockIdx.x == 0 && tid < 8) p.ctrs[tid] = 0u;
  for (int t = blockIdx.x; t < total; t += gridDim.x) {
    if (t < T_WIN) {
      int kt = t / 58, nt = t % 58;
      transpose_tile(p.w_in, 3596, 1024, p.WtIn, kt * 64, nt * 64, smem);
    } else if (t < T_WIN + T_WOUT + T_ADA) {
      int tt = t - T_WIN - T_WOUT, l = tt / 96, n0 = (tt % 96) * 32;
      float* cact = (float*)smem;
      for (int i = tid; i < 5120; i += 256) {
        int j = i >> 10, k = i & 1023;
        float v = (j < 4) ? p.c[j * 1024 + k] : p.c_ctx[k];
        cact[i] = siluf_(v);
      }
      __syncthreads();
      int col = tid & 31, kg = tid >> 5;
      float a0 = 0, a1 = 0, a2 = 0, a3 = 0, a4 = 0;
      const float* wp = p.ada_w + ((size_t)l * 1024 + kg * 128) * 3072 + n0 + col;
#pragma unroll 8
      for (int k = 0; k < 128; ++k) {
        float w = wp[(size_t)k * 3072];
        int kk = kg * 128 + k;
        a0 += cact[kk] * w; a1 += cact[1024 + kk] * w; a2 += cact[2048 + kk] * w; a3 += cact[3072 + kk] * w; a4 += cact[4096 + kk] * w;
      }
      float* red = cact + 5120;
      red[(kg * 5 + 0) * 32 + col] = a0; red[(kg * 5 + 1) * 32 + col] = a1; red[(kg * 5 + 2) * 32 + col] = a2;
      red[(kg * 5 + 3) * 32 + col] = a3; red[(kg * 5 + 4) * 32 + col] = a4;
      __syncthreads();
      if (tid < 160) {
        int j = tid >> 5, cc = tid & 31;
        float s = 0;
#pragma unroll
        for (int g = 0; g < 8; ++g) s += red[(g * 5 + j) * 32 + cc];
        p.mod[(size_t)(l * 5 + j) * 3072 + n0 + cc] = s + p.ada_b[l * 3072 + n0 + cc];
      }
      __syncthreads();
    } else {
      int tt = t - T_WIN - T_WOUT - T_ADA;
      if (tt < 16) {
        for (int i = tid; i < 8192; i += 256) {
          int idx = tt * 8192 + i;
          int arr = idx >> 16, e = idx & 65535;
          int ld = e >> 14, rem = e & 16383, n = rem >> 6, k = rem & 63;
          const float* src = arr ? p.rwkv_a_up : p.rwkv_w_up;
          bf16_t* dst = arr ? p.AupT : p.WupT;
          dst[e] = f2bf(src[((size_t)ld * 64 + k) * 256 + n]);
        }
      } else {
        for (int i = tid; i < 1024; i += 256) {
          int pos = i >> 4, f = i & 15;
          float inv32 = exp2f(-(float)f * 0.83048202372184058f);
          float c, s;
          sincos_d((double)((float)pos * inv32), c, s);
          p.rope[i * 2] = c;
          p.rope[i * 2 + 1] = s;
        }
      }
    }
  }
}

__device__ __forceinline__ void phase_norm(const Params& p, int l) {
  const int tid = launder(threadIdx.x), lane = tid & 63, w = tid >> 6;
  for (int t = blockIdx.x; t < TOK / 4; t += gridDim.x) {
    int r = t * 4 + w, b = r / TPB, pp = r % TPB;
    const float* src;
    if (l == 0) src = (pp < 256) ? p.ctx + ((size_t)b * 256 + pp) * 1024 : p.x + ((size_t)b * 4096 + pp - 256) * 1024;
    else src = (pp < 256) ? p.ctxcur + ((size_t)b * 256 + pp) * 1024 : p.out + ((size_t)b * 4096 + pp - 256) * 1024;
    const float* md = p.mod + (size_t)(l * 5 + ((pp < 256) ? 4 : b)) * 3072;
    const float* nw = p.norm_w + l * 1024;
    float4 v[4];
    float ss = 0;
#pragma unroll
    for (int i = 0; i < 4; ++i) {
      v[i] = *(const float4*)(src + lane * 4 + 256 * i);
      ss += v[i].x * v[i].x + v[i].y * v[i].y + v[i].z * v[i].z + v[i].w * v[i].w;
    }
    ss = sum64(ss);
    float rstd = rsqrtf(ss * (1.f / 1024.f) + 1e-6f);
    if (lane == 0) p.rstd[r] = rstd;
#pragma unroll
    for (int i = 0; i < 4; ++i) {
      int k = lane * 4 + 256 * i;
      float4 n4 = *(const float4*)(nw + k), sc = *(const float4*)(md + 1024 + k), sh = *(const float4*)(md + k);
      float h0 = v[i].x * rstd * n4.x * (1.f + sc.x) + sh.x;
      float h1 = v[i].y * rstd * n4.y * (1.f + sc.y) + sh.y;
      float h2 = v[i].z * rstd * n4.z * (1.f + sc.z) + sh.z;
      float h3 = v[i].w * rstd * n4.w * (1.f + sc.w) + sh.w;
      uint2 o;
      o.x = pack2(h0, h1);
      o.y = pack2(h2, h3);
      *(uint2*)(p.hbuf + (size_t)r * 1024 + k) = o;
    }
  }
}

__device__ __forceinline__ void phase_final(const Params& p) {
  const int tid = launder(threadIdx.x), lane = tid & 63, w = tid >> 6;
  for (int t = blockIdx.x; t < 16384 / 4; t += gridDim.x) {
    int r = t * 4 + w;
    float* src = p.out + (size_t)r * 1024;
    float4 v[4];
    float ss = 0;
#pragma unroll
    for (int i = 0; i < 4; ++i) {
      v[i] = *(const float4*)(src + lane * 4 + 256 * i);
      ss += v[i].x * v[i].x + v[i].y * v[i].y + v[i].z * v[i].z + v[i].w * v[i].w;
    }
    ss = sum64(ss);
    float rstd = rsqrtf(ss * (1.f / 1024.f) + 1e-6f);
#pragma unroll
    for (int i = 0; i < 4; ++i) {
      int k = lane * 4 + 256 * i;
      float4 n4 = *(const float4*)(p.final_norm_w + k);
      float4 o;
      o.x = v[i].x * rstd * n4.x; o.y = v[i].y * rstd * n4.y; o.z = v[i].z * rstd * n4.z; o.w = v[i].w * rstd * n4.w;
      *(float4*)(src + k) = o;
    }
  }
}

template <int MODE>
__device__ __forceinline__ void gemm_tile(const Params& p, int l, int mt_, int nt_, unsigned char* smem) {
  const bf16_t* A = p.hbuf;
  const bf16_t* Bt = (MODE == 0) ? p.WtIn + (size_t)l * 3712 * 1024 : p.WtOut + (size_t)l * 1024 * 1024;
  const int m0 = mt_ * 128, n0 = nt_ * 128;
  bf16_t* As = (bf16_t*)smem;
  bf16_t* Bs = As + 2 * 128 * 72;
  const int tid = launder(threadIdx.x), lane = tid & 63, w = tid >> 6, wr = w >> 1, wc = w & 1, fr = lane & 15, fq = lane >> 4;
  f32x4 acc[4][4];
#pragma unroll
  for (int i = 0; i < 4; ++i)
#pragma unroll
    for (int j = 0; j < 4; ++j) acc[i][j] = (f32x4){0.f, 0.f, 0.f, 0.f};
  unsigned char* lds = smem;
  int sR[4], sC[4];
#pragma unroll
  for (int i = 0; i < 4; ++i) {
    const int bo = tid * 16 + i * 4096;
    const int st = bo >> 10, sb = bo & 1023, swz = sb ^ (((sb >> 9) & 1) << 5);
    sR[i] = (st >> 1) * 16 + (swz >> 6);
    sC[i] = (st & 1) * 32 + ((swz & 63) >> 1);
  }
  const bf16_t* Ag0 = A + (size_t)(m0 + sR[0]) * 1024 + sC[0];
  const bf16_t* Ag1 = A + (size_t)(m0 + sR[1]) * 1024 + sC[1];
  const bf16_t* Ag2 = A + (size_t)(m0 + sR[2]) * 1024 + sC[2];
  const bf16_t* Ag3 = A + (size_t)(m0 + sR[3]) * 1024 + sC[3];
  const bf16_t* Bg0 = Bt + (size_t)(n0 + sR[0]) * 1024 + sC[0];
  const bf16_t* Bg1 = Bt + (size_t)(n0 + sR[1]) * 1024 + sC[1];
  const bf16_t* Bg2 = Bt + (size_t)(n0 + sR[2]) * 1024 + sC[2];
  const bf16_t* Bg3 = Bt + (size_t)(n0 + sR[3]) * 1024 + sC[3];
#define GL_STAGE(q_, kt_)                                                                                                              \
  {                                                                                                                                    \
    unsigned char* base_ = lds + (q_) * 32768 + tid * 16;                                                                              \
    __builtin_amdgcn_global_load_lds((const unsigned*)(Ag0 + (kt_) * 64), (GLAS unsigned*)(base_), 16, 0, 0);                          \
    __builtin_amdgcn_global_load_lds((const unsigned*)(Ag1 + (kt_) * 64), (GLAS unsigned*)(base_ + 4096), 16, 0, 0);                   \
    __builtin_amdgcn_global_load_lds((const unsigned*)(Ag2 + (kt_) * 64), (GLAS unsigned*)(base_ + 8192), 16, 0, 0);                   \
    __builtin_amdgcn_global_load_lds((const unsigned*)(Ag3 + (kt_) * 64), (GLAS unsigned*)(base_ + 12288), 16, 0, 0);                  \
    __builtin_amdgcn_global_load_lds((const unsigned*)(Bg0 + (kt_) * 64), (GLAS unsigned*)(base_ + 16384), 16, 0, 0);                  \
    __builtin_amdgcn_global_load_lds((const unsigned*)(Bg1 + (kt_) * 64), (GLAS unsigned*)(base_ + 16384 + 4096), 16, 0, 0);           \
    __builtin_amdgcn_global_load_lds((const unsigned*)(Bg2 + (kt_) * 64), (GLAS unsigned*)(base_ + 16384 + 8192), 16, 0, 0);           \
    __builtin_amdgcn_global_load_lds((const unsigned*)(Bg3 + (kt_) * 64), (GLAS unsigned*)(base_ + 16384 + 12288), 16, 0, 0);          \
  }
  const int lo = (fr * 64 + fq * 16) ^ ((fr >> 3) << 5);
#define GL_COMPUTE(q_)                                                                                 \
  {                                                                                                    \
    const unsigned char* Ab = lds + (q_) * 32768 + (wr * 4) * 2048 + lo;                               \
    const unsigned char* Bb = lds + (q_) * 32768 + 16384 + (wc * 4) * 2048 + lo;                       \
    _Pragma("unroll") for (int ks = 0; ks < 2; ++ks) {                                                 \
      bf16x8 a[4], b[4];                                                                               \
      _Pragma("unroll") for (int i = 0; i < 4; ++i) {                                                  \
        a[i] = *(const bf16x8*)(Ab + i * 2048 + ks * 1024);                                            \
        b[i] = *(const bf16x8*)(Bb + i * 2048 + ks * 1024);                                            \
      }                                                                                                \
      _Pragma("unroll") for (int i = 0; i < 4; ++i)                                                    \
        _Pragma("unroll") for (int j = 0; j < 4; ++j) acc[i][j] = MFMA(a[i], b[j], acc[i][j]);         \
    }                                                                                                  \
  }
  GL_STAGE(0, 0);
  asm volatile("s_waitcnt vmcnt(0)" ::: "memory");
  __builtin_amdgcn_s_barrier();
  for (int kt = 0; kt < 16; ++kt) {
    const int q = kt & 1;
    if (kt + 1 < 16) GL_STAGE(q ^ 1, kt + 1);
    GL_COMPUTE(q);
    asm volatile("s_waitcnt vmcnt(0) lgkmcnt(0)" ::: "memory");
    __builtin_amdgcn_s_barrier();
  }
  const int cbase = n0 + wc * 64;
  if (MODE == 0) {
    bf16_t* dst;
    int ld, coff;
    if (cbase < 1024) { dst = p.PA; ld = 1024; coff = cbase; }
    else if (cbase < 2048) { dst = p.PR; ld = 1024; coff = cbase - 1024; }
    else if (cbase < 2688) { dst = p.PG; ld = 640; coff = cbase - 2048; }
    else { dst = p.PS; ld = 912; coff = cbase - 2688; }
    bf16_t* wbuf = (bf16_t*)smem + w * (64 * 72);
#pragma unroll
    for (int i = 0; i < 4; ++i) {
#pragma unroll
      for (int j = 0; j < 4; ++j) {
        const int r = m0 + wr * 64 + i * 16 + fq * 4 + j;
        const int pp = r % TPB;
        float v0 = acc[i][0][j], v1 = acc[i][1][j], v2 = acc[i][2][j], v3 = acc[i][3][j];
        if (cbase < 512 && pp >= 256) {
          const int tt = pp - 256, rp = tt >> 6, cp = tt & 63;
          const float2 cs0 = *(const float2*)(p.rope + (rp * 16 + fr) * 2);
          const float2 cs1 = *(const float2*)(p.rope + (cp * 16 + fr) * 2);
          float n0_ = v0 * cs0.x - v1 * cs0.y, n1_ = v0 * cs0.y + v1 * cs0.x;
          float n2_ = v2 * cs1.x - v3 * cs1.y, n3_ = v2 * cs1.y + v3 * cs1.x;
          v0 = n0_; v1 = n1_; v2 = n2_; v3 = n3_;
        }
        if (cbase < 384) { v0 *= 0.125f; v1 *= 0.125f; v2 *= 0.125f; v3 *= 0.125f; }
        bf16_t* o = wbuf + (i * 16 + fq * 4 + j) * 72 + fr;
        o[0] = f2bf(v0); o[16] = f2bf(v1); o[32] = f2bf(v2); o[48] = f2bf(v3);
      }
    }
    __builtin_amdgcn_wave_barrier();
    {
      const int ch = lane & 7;
      const bool chv = (cbase + ch * 8) < 3600;
      const bool halo = (cbase >= 2688) && (cbase + 64 <= 3584);
#pragma unroll
      for (int t = 0; t < 8; ++t) {
        const int rl = (lane >> 3) + 8 * t;
        const uint4 v = *(const uint4*)(wbuf + rl * 72 + ch * 8);
        const int r = m0 + wr * 64 + rl;
        if (chv) *(uint4*)(dst + (size_t)r * ld + coff + ch * 8) = v;
        if (halo) {
          const int pp = r % TPB, q34 = pp % 34, t34 = pp / 34, bb = r / TPB;
          if (q34 == 33 && t34 + 1 < 128) *(uint4*)(p.HALO + ((size_t)(bb * 128 + t34 + 1) * 2 + 0) * 896 + coff + ch * 8) = v;
          if (q34 == 0 && t34 >= 1) *(uint4*)(p.HALO + ((size_t)(bb * 128 + t34 - 1) * 2 + 1) * 896 + coff + ch * 8) = v;
        }
      }
    }
  } else {
    float* wbuf = (float*)smem + w * (64 * 68);
#pragma unroll
    for (int i = 0; i < 4; ++i)
#pragma unroll
      for (int j = 0; j < 4; ++j) {
        float* o = wbuf + (i * 16 + fq * 4 + j) * 68 + fr;
        o[0] = acc[i][0][j]; o[16] = acc[i][1][j]; o[32] = acc[i][2][j]; o[48] = acc[i][3][j];
      }
    __builtin_amdgcn_wave_barrier();
    {
      const int ch = lane & 15;
      const int b = m0 / TPB, pp0 = (m0 % TPB) + wr * 64;
      const bool isc = pp0 < 256;
      const float4 g4 = *(const float4*)(p.mod + (size_t)(l * 5 + (isc ? 4 : b)) * 3072 + 2048 + cbase + ch * 4);
      const float* resb;
      float* dstb;
      if (l == 0) {
        resb = isc ? p.ctx + ((size_t)b * 256 + pp0) * 1024 : p.x + ((size_t)b * 4096 + pp0 - 256) * 1024;
        dstb = isc ? p.ctxcur + ((size_t)b * 256 + pp0) * 1024 : p.out + ((size_t)b * 4096 + pp0 - 256) * 1024;
      } else {
        resb = p.out + ((size_t)b * 4096 + pp0 - 256) * 1024;
        dstb = p.out + ((size_t)b * 4096 + pp0 - 256) * 1024;
      }
#pragma unroll
      for (int t = 0; t < 16; ++t) {
        const int rl = (lane >> 4) + 4 * t;
        const float4 a4 = *(const float4*)(wbuf + rl * 68 + ch * 4);
        const float4 r4 = *(const float4*)(resb + (size_t)rl * 1024 + cbase + ch * 4);
        float4 o4;
        o4.x = r4.x + g4.x * a4.x; o4.y = r4.y + g4.y * a4.y; o4.z = r4.z + g4.z * a4.z; o4.w = r4.w + g4.w * a4.w;
        *(float4*)(dstb + (size_t)rl * 1024 + cbase + ch * 4) = o4;
      }
    }
  }
  __syncthreads();
}

#define G_COMPUTE(buf_)                                                                 \
  {                                                                                     \
    const bf16_t* Ac = As + (buf_) * 128 * 72 + (wr * 64 + fr) * 72 + fq * 8;           \
    const bf16_t* Bc = Bs + (buf_) * 128 * 72 + (wc * 64 + fr) * 72 + fq * 8;           \
    _Pragma("unroll") for (int ks = 0; ks < 2; ++ks) {                                  \
      bf16x8 a[4], b[4];                                                                \
      _Pragma("unroll") for (int i = 0; i < 4; ++i) {                                   \
        a[i] = *(const bf16x8*)(Ac + i * 16 * 72 + ks * 32);                            \
        b[i] = *(const bf16x8*)(Bc + i * 16 * 72 + ks * 32);                            \
      }                                                                                 \
      _Pragma("unroll") for (int i = 0; i < 4; ++i)                                     \
        _Pragma("unroll") for (int j = 0; j < 4; ++j) acc[i][j] = MFMA(a[i], b[j], acc[i][j]); \
    }                                                                                   \
  }
__device__ __forceinline__ void gemm_late_tile(const Params& p, int l, int mt_, int nt_, unsigned char* smem) {
  const bf16_t* Bt = p.WtIn + (size_t)l * 3712 * 1024;
  const int m0 = mt_ * 128, n0 = nt_ * 128;
  bf16_t* As = (bf16_t*)smem;
  bf16_t* Bs = As + 2 * 128 * 72;
  const int tid = launder(threadIdx.x), lane = tid & 63, w = tid >> 6, wr = w >> 1, wc = w & 1, fr = lane & 15, fq = lane >> 4;
  f32x4 acc[4][4];
#pragma unroll
  for (int i = 0; i < 4; ++i)
#pragma unroll
    for (int j = 0; j < 4; ++j) acc[i][j] = (f32x4){0.f, 0.f, 0.f, 0.f};
  const int lrow = tid >> 3, lkc = tid & 7;
  const int bb = m0 / TPB, pp0 = m0 % TPB;
  const bool isc0 = pp0 < 256;
  const float* xbase;
  if (l == 0) xbase = isc0 ? p.ctx + ((size_t)bb * 256 + pp0) * 1024 : p.x + ((size_t)bb * 4096 + pp0 - 256) * 1024;
  else xbase = isc0 ? p.ctxcur + ((size_t)bb * 256 + pp0) * 1024 : p.out + ((size_t)bb * 4096 + pp0 - 256) * 1024;
  const float* xr = xbase + (size_t)lrow * 1024 + lkc * 8;
  const float* md = p.mod + (size_t)(l * 5 + (isc0 ? 4 : bb)) * 3072 + lkc * 8;
  const float* nwp = p.norm_w + l * 1024 + lkc * 8;
  const float rs0 = p.rstd[m0 + lrow], rs1 = p.rstd[m0 + lrow + 32], rs2 = p.rstd[m0 + lrow + 64], rs3 = p.rstd[m0 + lrow + 96];
  const bf16_t* Bg = Bt + (size_t)(n0 + lrow) * 1024 + lkc * 8;
  float4 xa0, xb0, xa1, xb1, xa2, xb2, xa3, xb3, nwa, nwb, sca, scb, sha, shb;
  uint4 lb0, lb1, lb2, lb3;
#define L_LOAD(kt_)                                                                                   \
  {                                                                                                   \
    const int ko_ = (kt_) * 64;                                                                       \
    xa0 = *(const float4*)(xr + ko_); xb0 = *(const float4*)(xr + ko_ + 4);                            \
    xa1 = *(const float4*)(xr + 32 * 1024 + ko_); xb1 = *(const float4*)(xr + 32 * 1024 + ko_ + 4);    \
    xa2 = *(const float4*)(xr + 64 * 1024 + ko_); xb2 = *(const float4*)(xr + 64 * 1024 + ko_ + 4);    \
    xa3 = *(const float4*)(xr + 96 * 1024 + ko_); xb3 = *(const float4*)(xr + 96 * 1024 + ko_ + 4);    \
    lb0 = *(const uint4*)(Bg + ko_); lb1 = *(const uint4*)(Bg + (size_t)32 * 1024 + ko_);              \
    lb2 = *(const uint4*)(Bg + (size_t)64 * 1024 + ko_); lb3 = *(const uint4*)(Bg + (size_t)96 * 1024 + ko_); \
    nwa = *(const float4*)(nwp + ko_); nwb = *(const float4*)(nwp + ko_ + 4);                          \
    sca = *(const float4*)(md + 1024 + ko_); scb = *(const float4*)(md + 1024 + ko_ + 4);              \
    sha = *(const float4*)(md + ko_); shb = *(const float4*)(md + ko_ + 4);                            \
  }
#define L_ROW(xa_, xb_, rs_, i_, buf_)                                                                \
  {                                                                                                   \
    uint4 o_;                                                                                         \
    o_.x = pack2(xa_.x * rs_ * nwa.x * (1.f + sca.x) + sha.x, xa_.y * rs_ * nwa.y * (1.f + sca.y) + sha.y); \
    o_.y = pack2(xa_.z * rs_ * nwa.z * (1.f + sca.z) + sha.z, xa_.w * rs_ * nwa.w * (1.f + sca.w) + sha.w); \
    o_.z = pack2(xb_.x * rs_ * nwb.x * (1.f + scb.x) + shb.x, xb_.y * rs_ * nwb.y * (1.f + scb.y) + shb.y); \
    o_.w = pack2(xb_.z * rs_ * nwb.z * (1.f + scb.z) + shb.z, xb_.w * rs_ * nwb.w * (1.f + scb.w) + shb.w); \
    *(uint4*)(As + (buf_) * 128 * 72 + (lrow + 32 * (i_)) * 72 + lkc * 8) = o_;                       \
  }
#define L_STORE(buf_)                                                                                 \
  {                                                                                                   \
    L_ROW(xa0, xb0, rs0, 0, buf_) L_ROW(xa1, xb1, rs1, 1, buf_) L_ROW(xa2, xb2, rs2, 2, buf_) L_ROW(xa3, xb3, rs3, 3, buf_) \
    *(uint4*)(Bs + (buf_) * 128 * 72 + lrow * 72 + lkc * 8) = lb0;                                    \
    *(uint4*)(Bs + (buf_) * 128 * 72 + (lrow + 32) * 72 + lkc * 8) = lb1;                             \
    *(uint4*)(Bs + (buf_) * 128 * 72 + (lrow + 64) * 72 + lkc * 8) = lb2;                             \
    *(uint4*)(Bs + (buf_) * 128 * 72 + (lrow + 96) * 72 + lkc * 8) = lb3;                             \
  }
  L_LOAD(0);
  L_STORE(0);
  __syncthreads();
  for (int kt = 0; kt < 16; ++kt) {
    L_LOAD((kt + 1 < 16) ? kt + 1 : 15);
    G_COMPUTE(kt & 1);
    L_STORE((kt + 1) & 1);
    __syncthreads();
  }
  const int cbase = n0 + wc * 64;
    bf16_t* dst;
    int ld, coff;
    if (cbase < 1024) { dst = p.PA; ld = 1024; coff = cbase; }
    else if (cbase < 2048) { dst = p.PR; ld = 1024; coff = cbase - 1024; }
    else if (cbase < 2688) { dst = p.PG; ld = 640; coff = cbase - 2048; }
    else { dst = p.PS; ld = 912; coff = cbase - 2688; }
    bf16_t* wbuf = (bf16_t*)smem + w * (64 * 72);
#pragma unroll
    for (int i = 0; i < 4; ++i) {
#pragma unroll
      for (int j = 0; j < 4; ++j) {
        const int r = m0 + wr * 64 + i * 16 + fq * 4 + j;
        const int pp = r % TPB;
        float v0 = acc[i][0][j], v1 = acc[i][1][j], v2 = acc[i][2][j], v3 = acc[i][3][j];
        if (cbase < 512 && pp >= 256) {
          const int tt = pp - 256, rp = tt >> 6, cp = tt & 63;
          const float2 cs0 = *(const float2*)(p.rope + (rp * 16 + fr) * 2);
          const float2 cs1 = *(const float2*)(p.rope + (cp * 16 + fr) * 2);
          float n0_ = v0 * cs0.x - v1 * cs0.y, n1_ = v0 * cs0.y + v1 * cs0.x;
          float n2_ = v2 * cs1.x - v3 * cs1.y, n3_ = v2 * cs1.y + v3 * cs1.x;
          v0 = n0_; v1 = n1_; v2 = n2_; v3 = n3_;
        }
        if (cbase < 384) { v0 *= 0.125f; v1 *= 0.125f; v2 *= 0.125f; v3 *= 0.125f; }
        bf16_t* o = wbuf + (i * 16 + fq * 4 + j) * 72 + fr;
        o[0] = f2bf(v0); o[16] = f2bf(v1); o[32] = f2bf(v2); o[48] = f2bf(v3);
      }
    }
    __builtin_amdgcn_wave_barrier();
    {
      const int ch = lane & 7;
      const bool chv = (cbase + ch * 8) < 3600;
      const bool halo = (cbase >= 2688) && (cbase + 64 <= 3584);
#pragma unroll
      for (int t = 0; t < 8; ++t) {
        const int rl = (lane >> 3) + 8 * t;
        const uint4 v = *(const uint4*)(wbuf + rl * 72 + ch * 8);
        const int r = m0 + wr * 64 + rl;
        if (chv) *(uint4*)(dst + (size_t)r * ld + coff + ch * 8) = v;
        if (halo) {
          const int pp = r % TPB, q34 = pp % 34, t34 = pp / 34, bb = r / TPB;
          if (q34 == 33 && t34 + 1 < 128) *(uint4*)(p.HALO + ((size_t)(bb * 128 + t34 + 1) * 2 + 0) * 896 + coff + ch * 8) = v;
          if (q34 == 0 && t34 >= 1) *(uint4*)(p.HALO + ((size_t)(bb * 128 + t34 - 1) * 2 + 1) * 896 + coff + ch * 8) = v;
        }
      }
    }
  __syncthreads();
}

__device__ __forceinline__ void phase_inproj(const Params& p, int l, unsigned char* smem) {
  if ((gridDim.x & 7) == 0) {
    const int x = blockIdx.x & 7, slot = blockIdx.x >> 3, nslot = gridDim.x >> 3;
    for (int j = slot; j < 17 * 24; j += nslot) { const int ne = j % 24; gemm_tile<0>(p, l, (j / 24) * 8 + x, (ne < 16) ? ne : ne + 5, smem); }
  } else {
    for (int t = blockIdx.x; t < 136 * 24; t += gridDim.x) { const int ne = t % 24; gemm_tile<0>(p, l, t / 24, (ne < 16) ? ne : ne + 5, smem); }
  }
}
__device__ __forceinline__ void phase_outproj(const Params& p, int l, unsigned char* smem) {
  if ((gridDim.x & 7) == 0) {
    const int x = blockIdx.x & 7, slot = blockIdx.x >> 3, nslot = gridDim.x >> 3;
    for (int j = slot; j < 17 * 8; j += nslot) {
      const int mt = (j >> 3) * 8 + x, nt = j & 7;
      if (l == 1 && (mt % 34) < 2) continue;
      gemm_tile<1>(p, l, mt, nt, smem);
    }
  } else {
    for (int t = blockIdx.x; t < 136 * 8; t += gridDim.x) {
      int mt = t >> 3, nt = t & 7;
      if (l == 1 && (mt % 34) < 2) continue;
      gemm_tile<1>(p, l, mt, nt, smem);
    }
  }
}

#define PRE_ARR ((size_t)TOK * 512)
__device__ __forceinline__ void rwkv_prep_tile(const Params& p, int l, int tile, unsigned char* smem) {
  const int d = tile & 1, tb = (tile >> 1) % 136, b = tile / 272;
  bf16_t* raw = (bf16_t*)smem;
  bf16_t* Aw = raw + 34 * 384;
  bf16_t* Aa = Aw + 32 * 72;
  const int tid = launder(threadIdx.x), lane = tid & 63, w = tid >> 6, fr = lane & 15, fq = lane >> 4;
  const int p0 = tb * 32;
  const int slo = (p0 < 256) ? 0 : 256, shi = (p0 < 256) ? 255 : 4351;
  const size_t rowbase = (size_t)b * TPB;
  const int ld2 = l * 2 + d;
  for (int q = tid; q < 34 * 48; q += 256) {
    const int rr = q / 48, cc = q % 48;
    const int tr = p0 - 1 + rr;
    const int col = (cc < 32) ? (256 + cc * 8) : ((cc < 40) ? (768 + d * 64 + (cc - 32) * 8) : (896 + d * 64 + (cc - 40) * 8));
    uint4 v = make_uint4(0, 0, 0, 0);
    if (tr >= slo && tr <= shi) v = *(const uint4*)(p.PR + (rowbase + tr) * 1024 + col);
    *(uint4*)(raw + rr * 384 + cc * 8) = v;
  }
  __syncthreads();
  const float* mu0 = p.rwkv_mu + (size_t)(l * 2 + 0) * 1024;
  const float* mu1 = p.rwkv_mu + (size_t)(l * 2 + 1) * 1024;
  {
    const int ca = tid & 63;
    const float m0wd = mu0[768 + d * 64 + ca], m1wd = mu1[768 + d * 64 + ca];
    const float m0ad = mu0[896 + d * 64 + ca], m1ad = mu1[896 + d * 64 + ca];
#pragma unroll 2
    for (int it = 0; it < 8; ++it) {
      const int i = w + 4 * it;
      const bf16_t* r0 = raw + (i + 1) * 384 + ca;
      float u = bf2f(r0[256]), up = bf2f(r0[256 - 384]), un = bf2f(r0[256 + 384]);
      Aw[i * 72 + ca] = f2bf(tanhf_(u + m0wd * (up - u) + m1wd * (un - u)));
      u = bf2f(r0[320]); up = bf2f(r0[320 - 384]); un = bf2f(r0[320 + 384]);
      Aa[i * 72 + ca] = f2bf(u + m0ad * (up - u) + m1ad * (un - u));
    }
  }
  __syncthreads();
  bf16x8 aw[2][2], aa[2][2];
#pragma unroll
  for (int mt = 0; mt < 2; ++mt)
#pragma unroll
    for (int ks = 0; ks < 2; ++ks) {
      aw[mt][ks] = *(const bf16x8*)(Aw + (mt * 16 + fr) * 72 + ks * 32 + fq * 8);
      aa[mt][ks] = *(const bf16x8*)(Aa + (mt * 16 + fr) * 72 + ks * 32 + fq * 8);
    }
  float kkr[2][4][4];
  float ssq[2][4];
#pragma unroll
  for (int mt = 0; mt < 2; ++mt)
#pragma unroll
    for (int j = 0; j < 4; ++j) ssq[mt][j] = 0.f;
#pragma unroll
  for (int nt = 0; nt < 4; ++nt) {
    const int c = w * 64 + nt * 16 + fr;
    const float m0k = mu0[256 + c], m1k = mu1[256 + c], kkc = p.rwkv_k_k[ld2 * 256 + c];
#pragma unroll
    for (int mt = 0; mt < 2; ++mt)
#pragma unroll
      for (int j = 0; j < 4; ++j) {
        const int i = mt * 16 + fq * 4 + j;
        const bf16_t* r0 = raw + (i + 1) * 384 + c;
        const float u = bf2f(r0[0]), up = bf2f(r0[-384]), un = bf2f(r0[384]);
        const float kq = (u + m0k * (up - u) + m1k * (un - u)) * kkc;
        kkr[mt][nt][j] = kq;
        ssq[mt][j] += kq * kq;
      }
  }
  float inv[2][4];
#pragma unroll
  for (int mt = 0; mt < 2; ++mt)
#pragma unroll
    for (int j = 0; j < 4; ++j) {
      const float tot = sum16(ssq[mt][j]);
      inv[mt][j] = frcp(fmaxf(__builtin_amdgcn_sqrtf(tot), 1e-12f));
    }
  __syncthreads();
  bf16_t* stg = (bf16_t*)smem;
#pragma unroll
  for (int nt = 0; nt < 4; ++nt) {
    const int c = w * 64 + nt * 16 + fr;
    const bf16_t* wup = p.WupT + ((size_t)(ld2 * 256 + c)) * 64 + fq * 8;
    const bf16_t* aup = p.AupT + ((size_t)(ld2 * 256 + c)) * 64 + fq * 8;
    const bf16x8 bw0 = *(const bf16x8*)wup, bw1 = *(const bf16x8*)(wup + 32);
    const bf16x8 ba0 = *(const bf16x8*)aup, ba1 = *(const bf16x8*)(aup + 32);
    const float w0c = p.rwkv_w0[ld2 * 256 + c], a0c = p.rwkv_a0[ld2 * 256 + c];
#pragma unroll
    for (int mt = 0; mt < 2; ++mt) {
      f32x4 accw = (f32x4){0.f, 0.f, 0.f, 0.f}, acca = (f32x4){0.f, 0.f, 0.f, 0.f};
      accw = MFMA(aw[mt][0], bw0, accw);
      accw = MFMA(aw[mt][1], bw1, accw);
      acca = MFMA(aa[mt][0], ba0, acca);
      acca = MFMA(aa[mt][1], ba1, acca);
#pragma unroll
      for (int j = 0; j < 4; ++j) {
        const int i = mt * 16 + fq * 4 + j;
        const float ew = 0.6065306597f * sigmoidf_(w0c + accw[j]);
        const float a = sigmoidf_(a0c + acca[j]);
        const float kk = kkr[mt][nt][j] * inv[mt][j];
        bf16_t* o = stg + i * 264 + c;
        o[0] = f2bf(ew);
        o[32 * 264] = f2bf(a);
        o[2 * 32 * 264] = f2bf(kk);
      }
    }
  }
  __syncthreads();
#pragma unroll
  for (int t = 0; t < 12; ++t) {
    const int q = tid + 256 * t;
    const int arr = q >> 10, i = (q >> 5) & 31, ch = q & 31;
    const uint4 v = *(const uint4*)(stg + (arr * 32 + i) * 264 + ch * 8);
    *(uint4*)(p.PRE + (size_t)arr * PRE_ARR + ((rowbase + p0 + i) * 2 + d) * 256 + ch * 8) = v;
  }
  __syncthreads();
}
__device__ __forceinline__ void ssd_conv_tile(const Params& p, int l, int tile, unsigned char* smem);
__device__ __forceinline__ void ssd_dtcum_tile(const Params& p, int l, int tile, unsigned char* smem);
__device__ __forceinline__ void phase_rwkvprep(const Params& p, int l, unsigned char* smem) {
  for (int t = blockIdx.x; t < 1088 + 512 + 544; t += gridDim.x) {
    if (t < 1088) rwkv_prep_tile(p, l, t, smem);
    else if (t < 1600) ssd_conv_tile(p, l, t - 1088, smem);
    else ssd_dtcum_tile(p, l, t - 1600, smem);
  }
}

typedef float v2f __attribute__((ext_vector_type(2)));
template <bool DUAL>
__device__ __forceinline__ void rwkv_tile(const Params& p, int l, int tile, unsigned char* smem) {
  const int part = tile >> 7;
  const int rg = tile & 3, h = (tile >> 2) & 3, b = (tile >> 4) & 3, d = (tile >> 6) & 1;
  const int cbeg = (part == 0) ? 0 : CSPLIT, cend = (part == 0) ? CSPLIT : 136;
  bf16_t* raw = (bf16_t*)smem;
  bf16_t* pre = raw + 34 * 192;
  float* rec = (float*)(smem + 13056 + 12288);
  const int tid = launder(threadIdx.x), lane = tid & 63, w = tid >> 6, fr = lane & 15, fq = lane >> 4;
  const int row = rg * 16 + w * 4 + fq;
  const int c0 = fr * 4;
  const int ld2 = l * 2 + d;
  const size_t rowbase = (size_t)b * TPB;
  const int lc = (tid & 15) * 4;
  const float* mu0 = p.rwkv_mu + (size_t)(l * 2 + 0) * 1024 + h * 64 + lc;
  const float* mu1 = p.rwkv_mu + (size_t)(l * 2 + 1) * 1024 + h * 64 + lc;
  const float4 m0r = *(const float4*)mu0, m1r = *(const float4*)mu1;
  const float4 m0k = *(const float4*)(mu0 + 256), m1k = *(const float4*)(mu1 + 256);
  const float4 m0v = *(const float4*)(mu0 + 512), m1v = *(const float4*)(mu1 + 512);
  const float4 ka4 = *(const float4*)(p.rwkv_k_a + ld2 * 256 + h * 64 + lc);
  v2f sA = {0.f, 0.f}, sB = {0.f, 0.f};
  v2f iA = {(row == c0) ? 1.f : 0.f, (row == c0 + 1) ? 1.f : 0.f}, iB = {(row == c0 + 2) ? 1.f : 0.f, (row == c0 + 3) ? 1.f : 0.f};
  const int pcc = tid % 24, prow = tid / 24;
  const bool pact = tid < 240;
  const bf16_t* rbase_g = p.PR + rowbase * 1024 + (pcc >> 3) * 256 + h * 64 + (pcc & 7) * 8;
  const bf16_t* pbase_g = p.PRE + (size_t)(pcc >> 3) * PRE_ARR + (rowbase * 2 + d) * 256 + h * 64 + (pcc & 7) * 8;
  uint4 pf0, pf1, pf2, pf3, pg0, pg1, pg2, pg3;
#define RW_GEOM(cix_, plo_, slo_, shi_)                                                   \
  {                                                                                       \
    const int st0_ = (cix_) * 32;                                                         \
    if (st0_ < 256) { slo_ = 0; shi_ = 255; plo_ = (d == 0) ? st0_ : 224 - st0_; }         \
    else { slo_ = 256; shi_ = 4351; plo_ = (d == 0) ? st0_ : 4576 - st0_; }                \
  }
#define RW_PF1(dst_, rr_, plo_, slo_, shi_)                                                         \
  {                                                                                                 \
    const int tr_ = (plo_) - 1 + (rr_);                                                             \
    dst_ = make_uint4(0, 0, 0, 0);                                                                  \
    if (pact && (rr_) < 34 && tr_ >= (slo_) && tr_ <= (shi_)) dst_ = *(const uint4*)(rbase_g + (size_t)tr_ * 1024); \
  }
#define RW_PG1(dst_, rr_, plo_)                                                                     \
  {                                                                                                 \
    dst_ = make_uint4(0, 0, 0, 0);                                                                  \
    if (pact && (rr_) < 32) dst_ = *(const uint4*)(pbase_g + (size_t)((plo_) + (rr_)) * 512);       \
  }
#define RW_PREFETCH(cix_)                                                                 \
  {                                                                                       \
    int plo_, slo_, shi_;                                                                 \
    RW_GEOM(cix_, plo_, slo_, shi_);                                                      \
    RW_PF1(pf0, prow, plo_, slo_, shi_); RW_PF1(pf1, prow + 10, plo_, slo_, shi_);        \
    RW_PF1(pf2, prow + 20, plo_, slo_, shi_); RW_PF1(pf3, prow + 30, plo_, slo_, shi_);   \
    RW_PG1(pg0, prow, plo_); RW_PG1(pg1, prow + 10, plo_);                                \
    RW_PG1(pg2, prow + 20, plo_); RW_PG1(pg3, prow + 30, plo_);                           \
  }
#define RW_STASH()                                                                        \
  {                                                                                       \
    if (pact) {                                                                           \
      *(uint4*)(raw + prow * 192 + pcc * 8) = pf0;                                        \
      *(uint4*)(raw + (prow + 10) * 192 + pcc * 8) = pf1;                                 \
      *(uint4*)(raw + (prow + 20) * 192 + pcc * 8) = pf2;                                 \
      if (prow + 30 < 34) *(uint4*)(raw + (prow + 30) * 192 + pcc * 8) = pf3;             \
      *(uint4*)(pre + prow * 192 + pcc * 8) = pg0;                                        \
      *(uint4*)(pre + (prow + 10) * 192 + pcc * 8) = pg1;                                 \
      *(uint4*)(pre + (prow + 20) * 192 + pcc * 8) = pg2;                                 \
      if (prow + 30 < 32) *(uint4*)(pre + (prow + 30) * 192 + pcc * 8) = pg3;             \
    }                                                                                     \
  }
  RW_PREFETCH(cbeg);
  RW_STASH();
  __syncthreads();
  for (int cix = cbeg; cix < cend; ++cix) {
    int plo, slo, shi;
    RW_GEOM(cix, plo, slo, shi);
#pragma unroll
    for (int k = 0; k < 2; ++k) {
      const int i = (tid >> 4) + 16 * k;
      const int ri = (d == 0) ? i + 1 : 32 - i;
      const bf16_t* r0 = raw + ri * 192 + lc;
      const bf16_t* q0 = pre + (ri - 1) * 192 + lc;
      float rs[4], ksv[4], vs[4];
#pragma unroll
      for (int sl = 0; sl < 3; ++sl) {
        const uint2 uc = *(const uint2*)(r0 + sl * 64), up = *(const uint2*)(r0 + sl * 64 - 192), un = *(const uint2*)(r0 + sl * 64 + 192);
        const float4 m0 = (sl == 0) ? m0r : ((sl == 1) ? m0k : m0v);
        const float4 m1 = (sl == 0) ? m1r : ((sl == 1) ? m1k : m1v);
        float* dst = (sl == 0) ? rs : ((sl == 1) ? ksv : vs);
        float u, a, n;
        u = __uint_as_float(uc.x << 16); a = __uint_as_float(up.x << 16); n = __uint_as_float(un.x << 16);
        dst[0] = u + m0.x * (a - u) + m1.x * (n - u);
        u = __uint_as_float(uc.x & 0xffff0000u); a = __uint_as_float(up.x & 0xffff0000u); n = __uint_as_float(un.x & 0xffff0000u);
        dst[1] = u + m0.y * (a - u) + m1.y * (n - u);
        u = __uint_as_float(uc.y << 16); a = __uint_as_float(up.y << 16); n = __uint_as_float(un.y << 16);
        dst[2] = u + m0.z * (a - u) + m1.z * (n - u);
        u = __uint_as_float(uc.y & 0xffff0000u); a = __uint_as_float(up.y & 0xffff0000u); n = __uint_as_float(un.y & 0xffff0000u);
        dst[3] = u + m0.w * (a - u) + m1.w * (n - u);
      }
      const uint2 ue = *(const uint2*)(q0), ua = *(const uint2*)(q0 + 64), uk = *(const uint2*)(q0 + 128);
      const float ew[4] = {__uint_as_float(ue.x << 16), __uint_as_float(ue.x & 0xffff0000u), __uint_as_float(ue.y << 16), __uint_as_float(ue.y & 0xffff0000u)};
      const float av[4] = {__uint_as_float(ua.x << 16), __uint_as_float(ua.x & 0xffff0000u), __uint_as_float(ua.y << 16), __uint_as_float(ua.y & 0xffff0000u)};
      const float kk[4] = {__uint_as_float(uk.x << 16), __uint_as_float(uk.x & 0xffff0000u), __uint_as_float(uk.y << 16), __uint_as_float(uk.y & 0xffff0000u)};
      const float kav[4] = {ka4.x, ka4.y, ka4.z, ka4.w};
      float4 o0, o1, o2, o3, o4, o5;
      float* f0 = (float*)&o0; float* f1 = (float*)&o1; float* f2 = (float*)&o2; float* f3 = (float*)&o3; float* f4 = (float*)&o4; float* f5 = (float*)&o5;
#pragma unroll
      for (int e = 0; e < 4; ++e) {
        f0[e] = __expf(-ew[e]);
        f1[e] = kk[e];
        f2[e] = kk[e] * av[e];
        f3[e] = ksv[e] * (1.f + (av[e] - 1.f) * kav[e]);
        f4[e] = rs[e];
        f5[e] = vs[e];
      }
      float* rp = rec + i * 384 + lc;
      *(float4*)(rp) = o0; *(float4*)(rp + 64) = o1; *(float4*)(rp + 128) = o2;
      *(float4*)(rp + 192) = o3; *(float4*)(rp + 256) = o4; *(float4*)(rp + 320) = o5;
    }
    __syncthreads();
    if (cix + 1 < cend) RW_PREFETCH(cix + 1);
    {
      const float* rp = rec + c0;
      const float* vp = rec + 320 + row;
      float4 w4 = *(const float4*)(rp), kk4 = *(const float4*)(rp + 64), kb4 = *(const float4*)(rp + 128);
      float4 kd4 = *(const float4*)(rp + 192), r4 = *(const float4*)(rp + 256);
      float v = vp[0];
      float ykeep = 0.f, gkeep = 0.f;
#pragma unroll 2
      for (int i = 0; i < 32; ++i) {
        const int inx = (i + 1) & 31;
        const float4 nw4 = *(const float4*)(rp + inx * 384), nkk4 = *(const float4*)(rp + inx * 384 + 64), nkb4 = *(const float4*)(rp + inx * 384 + 128);
        const float4 nkd4 = *(const float4*)(rp + inx * 384 + 192), nr4 = *(const float4*)(rp + inx * 384 + 256);
        const float nv = vp[inx * 384];
        v2f t = sA * (v2f){kk4.x, kk4.y};
        t = sB * (v2f){kk4.z, kk4.w} + t;
        float sa = t.x + t.y, ia = 0.f;
        if (DUAL) {
          v2f ti = iA * (v2f){kk4.x, kk4.y};
          ti = iB * (v2f){kk4.z, kk4.w} + ti;
          ia = ti.x + ti.y;
          sa += dppf<0xB1>(sa); ia += dppf<0xB1>(ia);
          sa += dppf<0x4E>(sa); ia += dppf<0x4E>(ia);
          sa += dppf<0x141>(sa); ia += dppf<0x141>(ia);
          sa += dppf<0x140>(sa); ia += dppf<0x140>(ia);
        } else {
          sa = sum16(sa);
        }
        v2f cA = sA * (v2f){w4.x, w4.y} + (v2f){kd4.x, kd4.y} * v;
        v2f cB = sB * (v2f){w4.z, w4.w} + (v2f){kd4.z, kd4.w} * v;
        sA = cA - (v2f){kb4.x, kb4.y} * sa;
        sB = cB - (v2f){kb4.z, kb4.w} * sa;
        v2f u = sA * (v2f){r4.x, r4.y};
        u = sB * (v2f){r4.z, r4.w} + u;
        float y = u.x + u.y, g = 0.f;
        if (DUAL) {
          iA = iA * (v2f){w4.x, w4.y} - (v2f){kb4.x, kb4.y} * ia;
          iB = iB * (v2f){w4.z, w4.w} - (v2f){kb4.z, kb4.w} * ia;
          v2f ui = iA * (v2f){r4.x, r4.y};
          ui = iB * (v2f){r4.z, r4.w} + ui;
          g = ui.x + ui.y;
          y += dppf<0xB1>(y); g += dppf<0xB1>(g);
          y += dppf<0x4E>(y); g += dppf<0x4E>(g);
          y += dppf<0x141>(y); g += dppf<0x141>(g);
          y += dppf<0x140>(y); g += dppf<0x140>(g);
          if (fr == (i & 15)) gkeep = g;
        } else {
          y = sum16(y);
        }
        if (fr == (i & 15)) ykeep = y;
        if ((i & 15) == 15) {
          const int ii = (i & 16) + fr;
          const int ri = (d == 0) ? ii + 1 : 32 - ii;
          const int pi = plo - 1 + ri;
          p.yR[((size_t)d * TOK + rowbase + pi) * 256 + h * 64 + row] = f2bf(ykeep);
          if (DUAL) p.GID[((size_t)(d * 4 + b) * NSEG1 + (cix - CSPLIT) * 32 + ii) * 256 + h * 64 + row] = f2bf(gkeep);
        }
        w4 = nw4; kk4 = nkk4; kb4 = nkb4; kd4 = nkd4; r4 = nr4; v = nv;
      }
    }
    if (cix + 1 < cend) RW_STASH();
    __syncthreads();
  }
  if (part == 0) *(float4*)(p.SMID + ((size_t)(((d * 4 + b) * 4 + h) * 64 + row)) * 64 + c0) = make_float4(sA.x, sA.y, sB.x, sB.y);
}

__device__ __forceinline__ void rwkv_fix_tile(const Params& p, int tile) {
  const int mb = tile % (NSEG1 / 64), dbh = tile / (NSEG1 / 64), h = dbh & 3, b = (dbh >> 2) & 3, d = dbh >> 4;
  const int tid = launder(threadIdx.x), lane = tid & 63, w = tid >> 6, fr = lane & 15, fq = lane >> 4;
  const size_t rowbase = (size_t)b * TPB;
  const int s0 = mb * 64 + 16 * w;
  const bf16_t* gp = p.GID + ((size_t)(d * 4 + b) * NSEG1 + s0 + fr) * 256 + h * 64 + fq * 8;
  const bf16x8 a0 = *(const bf16x8*)gp, a1 = *(const bf16x8*)(gp + 32);
#pragma unroll
  for (int nt = 0; nt < 4; ++nt) {
    const float* sp = p.SMID + ((size_t)(dbh * 64 + nt * 16 + fr)) * 64 + fq * 8;
    const float4 f0 = *(const float4*)sp, f1 = *(const float4*)(sp + 4), f2 = *(const float4*)(sp + 32), f3 = *(const float4*)(sp + 36);
    union { unsigned u[4]; bf16x8 v; } b0, b1;
    b0.u[0] = pack2(f0.x, f0.y); b0.u[1] = pack2(f0.z, f0.w); b0.u[2] = pack2(f1.x, f1.y); b0.u[3] = pack2(f1.z, f1.w);
    b1.u[0] = pack2(f2.x, f2.y); b1.u[1] = pack2(f2.z, f2.w); b1.u[2] = pack2(f3.x, f3.y); b1.u[3] = pack2(f3.z, f3.w);
    f32x4 acc = (f32x4){0.f, 0.f, 0.f, 0.f};
    acc = MFMA(a0, b0.v, acc);
    acc = MFMA(a1, b1.v, acc);
#pragma unroll
    for (int j = 0; j < 4; ++j) {
      const int st = CSPLIT * 32 + s0 + fq * 4 + j;
      const int pp = (d == 0) ? st : ((st < 256) ? 255 - st : 4607 - st);
      bf16_t* yp = p.yR + ((size_t)d * TOK + rowbase + pp) * 256 + h * 64 + nt * 16 + fr;
      *yp = f2bf(bf2f(*yp) + acc[j]);
    }
  }
}
__device__ __forceinline__ void phase_rwkvfix(const Params& p) {
  for (int t = blockIdx.x; t < 32 * (NSEG1 / 64); t += gridDim.x) rwkv_fix_tile(p, t);
}

__device__ __forceinline__ void ssd_conv_tile(const Params& p, int l, int tile, unsigned char* smem) {
  const int b = tile >> 7, t34 = tile & 127, pp0 = t34 * 34;
  const size_t r0 = (size_t)b * TPB + pp0;
  bf16_t* T = (bf16_t*)smem;
  const int tid = launder(threadIdx.x);
  for (int q = tid; q < 34 * 112; q += 256) {
    const int rr = q / 112, cc = q % 112;
    *(uint4*)(T + (rr + 1) * 896 + cc * 8) = *(const uint4*)(p.PS + (r0 + rr) * 912 + cc * 8);
  }
  if (tid < 224) {
    const int which = tid / 112, cc = tid % 112;
    const bool ex = (which == 0) ? (t34 >= 1) : (t34 + 1 < 128);
    uint4 v = make_uint4(0, 0, 0, 0);
    if (ex) v = *(const uint4*)(p.HALO + ((size_t)(b * 128 + t34) * 2 + which) * 896 + cc * 8);
    *(uint4*)(T + (which ? 35 : 0) * 896 + cc * 8) = v;
  }
  __syncthreads();
  const float* cw = p.ssm_conv_w + (size_t)l * 3 * 896;
  const float* cb = p.ssm_conv_b + (size_t)l * 896;
  for (int c = tid; c < 896; c += 256) {
    const float w0 = cw[c], w1 = cw[896 + c], w2 = cw[1792 + c], bs = cb[c];
    float um = bf2f(T[c]), u0 = bf2f(T[896 + c]);
#pragma unroll 2
    for (int rr = 0; rr < 34; ++rr) {
      const float up = bf2f(T[(rr + 2) * 896 + c]);
      const int pp = pp0 + rr;
      const bool pv = (pp != 0) && (pp != 256), nv = (pp != 255) && (pp != 4351);
      const float v = w0 * (pv ? um : 0.f) + w1 * u0 + w2 * (nv ? up : 0.f) + bs;
      p.PS[(r0 + rr) * 912 + c] = f2bf(siluf_(v));
      um = u0; u0 = up;
    }
  }
  __syncthreads();
}
__device__ __forceinline__ void ssd_dtcum_tile(const Params& p, int l, int tile, unsigned char* smem) {
  const int b = tile / 136, c32 = tile % 136, p0 = c32 * 32;
  float* draw = (float*)smem;
  const int tid = launder(threadIdx.x);
  for (int q = tid; q < 384; q += 256) {
    const int i = q / 12, dh = q % 12;
    draw[q] = bf2f(p.PS[((size_t)b * TPB + p0 + i) * 912 + 896 + dh]);
  }
  __syncthreads();
  if (tid < 12) {
    const int dh = tid, d = dh / 6, h = dh % 6;
    const float a_neg = -__expf(p.ssm_a_log[(l * 2 + d) * 6 + h]);
    const float bias = p.ssm_dt_bias[(l * 2 + d) * 6 + h];
    float cum = 0.f;
    for (int k = 0; k < 32; ++k) {
      const int it = (d == 0) ? k : 31 - k;
      const float dt = softplusf_(draw[it * 12 + dh] + bias);
      cum += dt * a_neg;
      p.DTC[(size_t)dh * TOK + (size_t)b * TPB + p0 + it] = make_float2(dt, cum);
    }
  }
  __syncthreads();
}

__device__ __forceinline__ void ssd_tile(const Params& p, int l, int tile, unsigned char* smem) {
  const int h = tile % 6, b = (tile / 6) & 3, d = tile / 24, g = h / 3;
  bf16_t* Cs0 = (bf16_t*)smem;
  bf16_t* Bs = Cs0 + 2 * 32 * 136;
  bf16_t* Xs = Bs + 32 * 136;
  bf16_t* BtT = Xs + 32 * 72;
  bf16_t* XdT = BtT + 128 * 40;
  bf16_t* Ms = XdT + 64 * 40;
  bf16_t* Sb = Ms + 32 * 40;
  float* dc = (float*)(Sb + 64 * 136);
  const int tid = launder(threadIdx.x), lane = tid & 63, w = tid >> 6, fr = lane & 15, fq = lane >> 4;
  const size_t rowbase = (size_t)b * TPB;
  f32x4 S[4][2];
#pragma unroll
  for (int i = 0; i < 4; ++i)
#pragma unroll
    for (int j = 0; j < 2; ++j) S[i][j] = (f32x4){0.f, 0.f, 0.f, 0.f};
  const int pcc = tid % 40, prow = tid / 40;
  const bool pact = tid < 240;
  const int pcol = (pcc < 16) ? (640 + g * 128 + pcc * 8) : ((pcc < 32) ? (384 + g * 128 + (pcc - 16) * 8) : (h * 64 + (pcc - 32) * 8));
  const bf16_t* pbase = p.PS + rowbase * 912 + pcol;
  const float2* dbase = p.DTC + (size_t)(d * 6 + h) * TOK + rowbase;
  const int drow_stride = (pcc < 32) ? 136 : 72;
  uint4 pf0, pf1, pf2, pf3, pf4, pf5;
  float2 dtc = make_float2(0.f, 0.f);
#define SD_GEOM(cix_, plo_)                                                \
  {                                                                        \
    const int st0_ = (cix_) * 32;                                          \
    if (st0_ < 256) plo_ = (d == 0) ? st0_ : 224 - st0_;                   \
    else plo_ = (d == 0) ? st0_ : 4576 - st0_;                             \
  }
#define SD_PF1(dst_, rr_, plo_)                                                                   \
  {                                                                                               \
    dst_ = make_uint4(0, 0, 0, 0);                                                                \
    if (pact && (rr_) < 32) dst_ = *(const uint4*)(pbase + (size_t)((plo_) + (rr_)) * 912);       \
  }
#define SD_PREFETCH(cix_)                                                          \
  {                                                                                \
    int plo_;                                                                      \
    SD_GEOM(cix_, plo_);                                                           \
    SD_PF1(pf0, prow, plo_); SD_PF1(pf1, prow + 6, plo_); SD_PF1(pf2, prow + 12, plo_); \
    SD_PF1(pf3, prow + 18, plo_); SD_PF1(pf4, prow + 24, plo_); SD_PF1(pf5, prow + 30, plo_); \
    if (tid < 32) dtc = dbase[plo_ + tid];                                         \
  }
#define SD_ST1(src_, rr_, cbuf_)                                                                  \
  {                                                                                               \
    if (pact && (rr_) < 32) {                                                                     \
      const int i_ = (d == 0) ? (rr_) : 31 - (rr_);                                               \
      bf16_t* dst_ = (pcc < 16) ? ((cbuf_) + i_ * 136 + pcc * 8) : ((pcc < 32) ? (Bs + i_ * 136 + (pcc - 16) * 8) : (Xs + i_ * 72 + (pcc - 32) * 8)); \
      *(uint4*)dst_ = src_;                                                                       \
    }                                                                                             \
  }
#define SD_STASH(buf_)                                                              \
  {                                                                                 \
    bf16_t* cbuf_ = Cs0 + (buf_) * 32 * 136;                                        \
    SD_ST1(pf0, prow, cbuf_); SD_ST1(pf1, prow + 6, cbuf_); SD_ST1(pf2, prow + 12, cbuf_); \
    SD_ST1(pf3, prow + 18, cbuf_); SD_ST1(pf4, prow + 24, cbuf_); SD_ST1(pf5, prow + 30, cbuf_); \
    if (tid < 32) {                                                                 \
      const int i_ = (d == 0) ? tid : 31 - tid;                                     \
      dc[(buf_) * 64 + i_] = dtc.x;                                                 \
      dc[(buf_) * 64 + 32 + i_] = dtc.y;                                            \
    }                                                                               \
  }
  (void)drow_stride;
  SD_PREFETCH(0);
  SD_STASH(0);
  __syncthreads();
  for (int cix = 0; cix < 136; ++cix) {
    int plo;
    SD_GEOM(cix, plo);
    const int buf = cix & 1;
    const bf16_t* Cs = Cs0 + buf * 32 * 136;
    const float* dts = dc + buf * 64;
    const float* cums = dts + 32;
    {
      const int j = tid & 31, ng = tid >> 5;
      const float tail = __expf(cums[31] - cums[j]);
      const float dtj = dts[j];
      const uint4 b0 = *(const uint4*)(Bs + j * 136 + ng * 16), b1 = *(const uint4*)(Bs + j * 136 + ng * 16 + 8);
      const uint4 x0 = *(const uint4*)(Xs + j * 72 + ng * 8);
      const unsigned bw[8] = {b0.x, b0.y, b0.z, b0.w, b1.x, b1.y, b1.z, b1.w};
      const unsigned xw[4] = {x0.x, x0.y, x0.z, x0.w};
#pragma unroll
      for (int e = 0; e < 8; ++e) {
        const unsigned pk = pack2(__uint_as_float(bw[e] << 16) * tail, __uint_as_float(bw[e] & 0xffff0000u) * tail);
        BtT[(ng * 16 + 2 * e) * 40 + j] = (bf16_t)(pk & 0xffffu);
        BtT[(ng * 16 + 2 * e + 1) * 40 + j] = (bf16_t)(pk >> 16);
      }
#pragma unroll
      for (int e = 0; e < 4; ++e) {
        const unsigned pk = pack2(__uint_as_float(xw[e] << 16) * dtj, __uint_as_float(xw[e] & 0xffff0000u) * dtj);
        XdT[(ng * 8 + 2 * e) * 40 + j] = (bf16_t)(pk & 0xffffu);
        XdT[(ng * 8 + 2 * e + 1) * 40 + j] = (bf16_t)(pk >> 16);
      }
#pragma unroll
      for (int mt = 0; mt < 4; ++mt)
#pragma unroll
        for (int t = 0; t < 2; ++t)
#pragma unroll
          for (int jj = 0; jj < 4; ++jj) Sb[(mt * 16 + fq * 4 + jj) * 136 + (2 * w + t) * 16 + fr] = f2bf(S[mt][t][jj]);
      const int mi = w >> 1, nj = w & 1;
      f32x4 acc = (f32x4){0.f, 0.f, 0.f, 0.f};
#pragma unroll
      for (int ks = 0; ks < 4; ++ks) {
        bf16x8 a = *(const bf16x8*)(Cs + (mi * 16 + fr) * 136 + ks * 32 + fq * 8);
        bf16x8 bb = *(const bf16x8*)(Bs + (nj * 16 + fr) * 136 + ks * 32 + fq * 8);
        acc = MFMA(a, bb, acc);
      }
      const int jc = nj * 16 + fr;
      const float cj = cums[jc];
#pragma unroll
      for (int jj = 0; jj < 4; ++jj) {
        const int i = mi * 16 + fq * 4 + jj;
        const float v = (jc <= i) ? acc[jj] * __expf(cums[i] - cj) : 0.f;
        Ms[i * 40 + jc] = f2bf(v);
      }
    }
    __syncthreads();
    if (cix + 1 < 136) SD_PREFETCH(cix + 1);
    {
      const int mi = w >> 1;
      bf16x8 am = *(const bf16x8*)(Ms + (mi * 16 + fr) * 40 + fq * 8);
      bf16x8 ac[4];
#pragma unroll
      for (int ks = 0; ks < 4; ++ks) ac[ks] = *(const bf16x8*)(Cs + (mi * 16 + fr) * 136 + ks * 32 + fq * 8);
#pragma unroll
      for (int t = 0; t < 2; ++t) {
        const int pt = 2 * (w & 1) + t;
        f32x4 y1 = (f32x4){0.f, 0.f, 0.f, 0.f}, y2 = (f32x4){0.f, 0.f, 0.f, 0.f};
        bf16x8 bx = *(const bf16x8*)(XdT + (pt * 16 + fr) * 40 + fq * 8);
        y1 = MFMA(am, bx, y1);
#pragma unroll
        for (int ks = 0; ks < 4; ++ks) {
          bf16x8 bs = *(const bf16x8*)(Sb + (pt * 16 + fr) * 136 + ks * 32 + fq * 8);
          y2 = MFMA(ac[ks], bs, y2);
        }
#pragma unroll
        for (int jj = 0; jj < 4; ++jj) {
          const int i = mi * 16 + fq * 4 + jj;
          const int pi = plo + ((d == 0) ? i : 31 - i);
          const float y = y1[jj] + __expf(cums[i]) * y2[jj];
          p.yS[((size_t)d * TOK + rowbase + pi) * 384 + h * 64 + pt * 16 + fr] = f2bf(y);
        }
      }
      const float dec = __expf(cums[31]);
      bf16x8 bt[2];
#pragma unroll
      for (int t = 0; t < 2; ++t) bt[t] = *(const bf16x8*)(BtT + ((2 * w + t) * 16 + fr) * 40 + fq * 8);
#pragma unroll
      for (int mt = 0; mt < 4; ++mt) {
        bf16x8 ax = *(const bf16x8*)(XdT + (mt * 16 + fr) * 40 + fq * 8);
#pragma unroll
        for (int t = 0; t < 2; ++t) {
          S[mt][t] *= dec;
          S[mt][t] = MFMA(ax, bt[t], S[mt][t]);
        }
      }
    }
    if (cix + 1 < 136) SD_STASH(buf ^ 1);
    __syncthreads();
  }
}

__device__ __forceinline__ void attn_tile(const Params& p, int l, int tile, unsigned char* smem) {
  const bool isctx = tile >= 768;
  int qt, head, b;
  if (!isctx) { qt = tile & 31; head = (tile >> 5) % 6; b = tile / 192; }
  else { int tt = tile - 768; qt = tt & 1; head = (tt >> 1) % 6; b = tt / 12; }
  const int hkv = head / 3;
  const int tid = launder(threadIdx.x), lane = tid & 63, w = tid >> 6, fr = lane & 15, fq = lane >> 4;
  bf16_t* Ks = (bf16_t*)smem;
  bf16_t* Vt = Ks + 64 * 72;
  bf16_t* Ps = Vt + 64 * 72 + w * 32 * 72;
  const int q0 = qt * 128;
  const size_t rowb = (size_t)b * TPB;
  const size_t rowq0 = rowb + (isctx ? q0 : 256 + q0);
  bf16x8 qf[2][2];
  float m[2][4], ls[2][4];
  f32x4 o[2][4];
  const float sk = p.attn_sink[l * 6 + head];
#pragma unroll
  for (int mt = 0; mt < 2; ++mt) {
    const int qi0 = (2 * w + mt) * 16;
#pragma unroll
    for (int ks = 0; ks < 2; ++ks) qf[mt][ks] = *(const bf16x8*)(p.PA + (rowq0 + qi0 + fr) * 1024 + head * 64 + ks * 32 + fq * 8);
#pragma unroll
    for (int j = 0; j < 4; ++j) { m[mt][j] = sk; ls[mt][j] = 1.f; }
#pragma unroll
    for (int nt = 0; nt < 4; ++nt) o[mt][nt] = (f32x4){0.f, 0.f, 0.f, 0.f};
  }
  int klo = 0, nb = 0;
  if (!isctx) {
    klo = max(0, q0 - 128);
    const int khi = min(4096, q0 + 256);
    nb = (khi - klo) >> 6;
  }
  const int ntile = nb + 4;
  const int lr = tid >> 3, lc = tid & 7;
  uint4 kr0, kr1, vr0, vr1;
#define KVLOAD(kt_)                                                                              \
  {                                                                                              \
    const size_t kr0_ = ((kt_) < nb) ? rowb + 256 + klo + (kt_) * 64 : rowb + ((kt_) - nb) * 64; \
    const bf16_t* src0 = p.PA + (kr0_ + lr) * 1024 + 384 + hkv * 64 + lc * 8;                    \
    const bf16_t* src1 = src0 + 32 * 1024;                                                       \
    kr0 = *(const uint4*)src0;                                                                   \
    vr0 = *(const uint4*)(src0 + 128);                                                           \
    kr1 = *(const uint4*)src1;                                                                   \
    vr1 = *(const uint4*)(src1 + 128);                                                           \
  }
#define VTSTORE(vr_, rr_)                                                 \
  {                                                                       \
    Vt[(lc * 8 + 0) * 72 + (rr_)] = (bf16_t)((vr_).x & 0xffffu);          \
    Vt[(lc * 8 + 1) * 72 + (rr_)] = (bf16_t)((vr_).x >> 16);              \
    Vt[(lc * 8 + 2) * 72 + (rr_)] = (bf16_t)((vr_).y & 0xffffu);          \
    Vt[(lc * 8 + 3) * 72 + (rr_)] = (bf16_t)((vr_).y >> 16);              \
    Vt[(lc * 8 + 4) * 72 + (rr_)] = (bf16_t)((vr_).z & 0xffffu);          \
    Vt[(lc * 8 + 5) * 72 + (rr_)] = (bf16_t)((vr_).z >> 16);              \
    Vt[(lc * 8 + 6) * 72 + (rr_)] = (bf16_t)((vr_).w & 0xffffu);          \
    Vt[(lc * 8 + 7) * 72 + (rr_)] = (bf16_t)((vr_).w >> 16);              \
  }
  KVLOAD(0);
  for (int kt = 0; kt < ntile; ++kt) {
    __syncthreads();
    *(uint4*)(Ks + lr * 72 + lc * 8) = kr0;
    *(uint4*)(Ks + (lr + 32) * 72 + lc * 8) = kr1;
    VTSTORE(vr0, lr);
    VTSTORE(vr1, lr + 32);
    __syncthreads();
    if (kt + 1 < ntile) KVLOAD(kt + 1);
    f32x4 s[2][4];
#pragma unroll
    for (int mt = 0; mt < 2; ++mt)
#pragma unroll
      for (int nt = 0; nt < 4; ++nt) s[mt][nt] = (f32x4){0.f, 0.f, 0.f, 0.f};
#pragma unroll
    for (int ks = 0; ks < 2; ++ks) {
#pragma unroll
      for (int nt = 0; nt < 4; ++nt) {
        bf16x8 kb = *(const bf16x8*)(Ks + (nt * 16 + fr) * 72 + ks * 32 + fq * 8);
#pragma unroll
        for (int mt = 0; mt < 2; ++mt) s[mt][nt] = MFMA(qf[mt][ks], kb, s[mt][nt]);
      }
    }
    const bool band = kt < nb;
    const int kp0 = klo + kt * 64 + fr;
#pragma unroll
    for (int mt = 0; mt < 2; ++mt) {
      const int qi0 = (2 * w + mt) * 16;
#pragma unroll
      for (int j = 0; j < 4; ++j) {
        const int qp = q0 + qi0 + fq * 4 + j;
        float sv0 = s[mt][0][j], sv1 = s[mt][1][j], sv2 = s[mt][2][j], sv3 = s[mt][3][j];
        if (band) {
          const int dlt = qp - kp0;
          if (dlt > 128 || dlt < -128) sv0 = -INFINITY;
          if (dlt - 16 > 128 || dlt - 16 < -128) sv1 = -INFINITY;
          if (dlt - 32 > 128 || dlt - 32 < -128) sv2 = -INFINITY;
          if (dlt - 48 > 128 || dlt - 48 < -128) sv3 = -INFINITY;
        }
        float mx = fmaxf(fmaxf(sv0, sv1), fmaxf(sv2, sv3));
        mx = max16(mx);
        const float mn = fmaxf(m[mt][j], mx);
        const float alpha = __expf(m[mt][j] - mn);
        const float p0 = __expf(sv0 - mn), p1 = __expf(sv1 - mn), p2 = __expf(sv2 - mn), p3 = __expf(sv3 - mn);
        bf16_t* pr = Ps + (mt * 16 + fq * 4 + j) * 72 + fr;
        pr[0] = f2bf(p0); pr[16] = f2bf(p1); pr[32] = f2bf(p2); pr[48] = f2bf(p3);
        const float rsum = sum16(p0 + p1 + p2 + p3);
        ls[mt][j] = ls[mt][j] * alpha + rsum;
        m[mt][j] = mn;
#pragma unroll
        for (int nt = 0; nt < 4; ++nt) o[mt][nt][j] *= alpha;
      }
    }
    __builtin_amdgcn_wave_barrier();
#pragma unroll
    for (int ks = 0; ks < 2; ++ks) {
      bf16x8 pa[2];
#pragma unroll
      for (int mt = 0; mt < 2; ++mt) pa[mt] = *(const bf16x8*)(Ps + (mt * 16 + fr) * 72 + ks * 32 + fq * 8);
#pragma unroll
      for (int nt = 0; nt < 4; ++nt) {
        bf16x8 vb = *(const bf16x8*)(Vt + (nt * 16 + fr) * 72 + ks * 32 + fq * 8);
#pragma unroll
        for (int mt = 0; mt < 2; ++mt) o[mt][nt] = MFMA(pa[mt], vb, o[mt][nt]);
      }
    }
    __builtin_amdgcn_wave_barrier();
  }
#pragma unroll
  for (int mt = 0; mt < 2; ++mt) {
    const int qi0 = (2 * w + mt) * 16;
#pragma unroll
    for (int j = 0; j < 4; ++j) {
      const size_t r = rowq0 + qi0 + fq * 4 + j;
      const float inv = frcp(ls[mt][j]);
#pragma unroll
      for (int nt = 0; nt < 4; ++nt) {
        const int dc = nt * 16 + fr;
        const float gt = bf2f(p.PA[r * 1024 + 640 + head * 64 + dc]);
        p.PA[r * 1024 + head * 64 + dc] = f2bf(o[mt][nt][j] * inv * siluf_(gt));
      }
    }
  }
  __syncthreads();
}

#ifndef PROBE_DUP
#define PROBE_DUP 0
#endif
__device__ __forceinline__ void phase_probe(const Params& p, int l, unsigned char* smem) {
  if (PROBE_DUP == 1) { for (int t = blockIdx.x; t < 256; t += gridDim.x) { if (t < 128) rwkv_tile<false>(p, l, t, smem); else rwkv_tile<true>(p, l, t, smem); } }
  if (PROBE_DUP == 2) { for (int t = blockIdx.x; t < 48; t += gridDim.x) ssd_tile(p, l, t, smem); }
}
__device__ __forceinline__ void phase_mixers(const Params& p, int l, unsigned char* smem) {
  const int natt = (l == 0) ? 816 : 768;
  const int bid = blockIdx.x, G = gridDim.x;
  if (G == 512) {
    if (bid < 128) {
      __builtin_amdgcn_s_setprio(3);
      rwkv_tile<false>(p, l, bid, smem);
      __builtin_amdgcn_s_setprio(0);
    } else if (bid < 256) {
      __builtin_amdgcn_s_setprio(3);
      rwkv_tile<true>(p, l, bid, smem);
      __builtin_amdgcn_s_setprio(0);
    } else if (bid < 304) {
      __builtin_amdgcn_s_setprio(2);
      ssd_tile(p, l, bid - 256, smem);
      __builtin_amdgcn_s_setprio(0);
    }
    int* tsl = (int*)(smem + 73728);
    const int tid = launder(threadIdx.x);
    if (l == 0) {
      for (;;) {
        __syncthreads();
        if (tid == 0) *tsl = (int)atomicAdd(&p.ctrs[2], 1u);
        __syncthreads();
        const int t = *tsl;
        if (t >= 1440) break;
        deferred_transpose(p, t, smem);
      }
    }
    for (;;) {
      __syncthreads();
      if (tid == 0) *tsl = (int)atomicAdd(&p.ctrs[l], 1u);
      __syncthreads();
      const int t = *tsl;
      if (t >= natt) break;
      attn_tile(p, l, t, smem);
    }
    for (;;) {
      __syncthreads();
      if (tid == 0) *tsl = (int)atomicAdd(&p.ctrs[4 + l], 1u);
      __syncthreads();
      const int j = *tsl;
      if (j >= 136 * 5) break;
      gemm_late_tile(p, l, j / 5, 16 + j % 5, smem);
    }
  } else {
    if (l == 0) for (int t = bid; t < 1440; t += G) deferred_transpose(p, t, smem);
    for (int t = bid; t < 136 * 5; t += G) gemm_late_tile(p, l, t / 5, 16 + t % 5, smem);
    const int total = 304 + natt;
    for (int t = bid; t < total; t += G) {
      if (t < 128) rwkv_tile<false>(p, l, t, smem);
      else if (t < 256) rwkv_tile<true>(p, l, t, smem);
      else if (t < 304) ssd_tile(p, l, t - 256, smem);
      else attn_tile(p, l, t - 304, smem);
    }
  }
}

__device__ __forceinline__ float blo(unsigned u) { return __uint_as_float(u << 16); }
__device__ __forceinline__ float bhi(unsigned u) { return __uint_as_float(u & 0xffff0000u); }
__device__ __forceinline__ void phase_finish(const Params& p, int l) {
  const int tid = launder(threadIdx.x), lane = tid & 63, w = tid >> 6;
  bf16_t* mix = p.hbuf;
  const int cg_ = lane * 4, hh4 = lane >> 4;
  const float* mu0 = p.rwkv_mu + (size_t)(l * 2) * 1024 + cg_;
  const float* mu1 = mu0 + 1024;
  const float4 m0r = *(const float4*)mu0, m1r = *(const float4*)mu1;
  const float4 m0k = *(const float4*)(mu0 + 256), m1k = *(const float4*)(mu1 + 256);
  const float4 m0v = *(const float4*)(mu0 + 512), m1v = *(const float4*)(mu1 + 512);
  const float4 rk4 = *(const float4*)(p.rwkv_r_k + l * 256 + hh4 * 64 + (cg_ & 63));
  const float4 lw4 = *(const float4*)(p.rwkv_ln_w + l * 256 + cg_), lb4 = *(const float4*)(p.rwkv_ln_b + l * 256 + cg_);
  const int cs_ = lane * 6;
  const float2 nw0 = *(const float2*)(p.ssm_norm_w + l * 384 + cs_), nw1 = *(const float2*)(p.ssm_norm_w + l * 384 + cs_ + 2), nw2 = *(const float2*)(p.ssm_norm_w + l * 384 + cs_ + 4);
  const float dsk0 = p.ssm_d[l * 6 + (cs_ >> 6)], dsk1 = p.ssm_d[l * 6 + ((cs_ + 2) >> 6)], dsk2 = p.ssm_d[l * 6 + ((cs_ + 4) >> 6)];
  for (int t = blockIdx.x; t < TOK / 4; t += gridDim.x) {
    const int r = t * 4 + w, pp = r % TPB;
    if (l == 1 && pp < 256) continue;
    const bool isc = pp < 256;
    const int slo = isc ? 0 : 256, shi = isc ? 255 : 4351;
    const bool hp = pp > slo, hn = pp < shi;
    const unsigned* a32 = (const unsigned*)(p.PA + (size_t)r * 1024 + lane * 6);
    const unsigned at0 = a32[0], at1 = a32[1], at2 = a32[2];
    const uint2 ya = *(const uint2*)(p.yR + (size_t)r * 256 + cg_);
    const uint2 yb = *(const uint2*)(p.yR + ((size_t)TOK + r) * 256 + cg_);
    const bf16_t* pr = p.PR + (size_t)r * 1024 + cg_;
    const uint2 z2 = make_uint2(0u, 0u);
    const uint2 rc = *(const uint2*)pr, kc = *(const uint2*)(pr + 256), vc = *(const uint2*)(pr + 512);
    const uint2 rp = hp ? *(const uint2*)(pr - 1024) : z2, kp = hp ? *(const uint2*)(pr + 256 - 1024) : z2, vp = hp ? *(const uint2*)(pr + 512 - 1024) : z2;
    const uint2 rn = hn ? *(const uint2*)(pr + 1024) : z2, kn = hn ? *(const uint2*)(pr + 256 + 1024) : z2, vn = hn ? *(const uint2*)(pr + 512 + 1024) : z2;
    const uint2 g2 = *(const uint2*)(p.PG + (size_t)r * 640 + cg_);
    const unsigned* s0 = (const unsigned*)(p.yS + (size_t)r * 384 + cs_);
    const unsigned* s1 = (const unsigned*)(p.yS + ((size_t)TOK + r) * 384 + cs_);
    const unsigned* xs32 = (const unsigned*)(p.PS + (size_t)r * 912 + cs_);
    const unsigned* z32 = (const unsigned*)(p.PG + (size_t)r * 640 + 256 + cs_);
    const unsigned sa0 = s0[0], sa1 = s0[1], sa2 = s0[2], sb0 = s1[0], sb1 = s1[1], sb2 = s1[2];
    const unsigned xa0 = xs32[0], xa1 = xs32[1], xa2 = xs32[2], za0 = z32[0], za1 = z32[1], za2 = z32[2];
    {
      unsigned* d32 = (unsigned*)(mix + (size_t)r * 1024 + lane * 6);
      d32[0] = at0; d32[1] = at1; d32[2] = at2;
    }
    {
      float y[4] = {blo(ya.x) + blo(yb.x), bhi(ya.x) + bhi(yb.x), blo(ya.y) + blo(yb.y), bhi(ya.y) + bhi(yb.y)};
      const float sm = sum16(y[0] + y[1] + y[2] + y[3]);
      const float mean = sm * (1.f / 64.f);
      float vq = 0.f;
#pragma unroll
      for (int e = 0; e < 4; ++e) { y[e] -= mean; vq += y[e] * y[e]; }
      vq = sum16(vq);
      const float rstd = rsqrtf(vq * (1.f / 64.f) + 64e-5f);
      const float rs0 = blo(rc.x) + m0r.x * (blo(rp.x) - blo(rc.x)) + m1r.x * (blo(rn.x) - blo(rc.x));
      const float rs1 = bhi(rc.x) + m0r.y * (bhi(rp.x) - bhi(rc.x)) + m1r.y * (bhi(rn.x) - bhi(rc.x));
      const float rs2 = blo(rc.y) + m0r.z * (blo(rp.y) - blo(rc.y)) + m1r.z * (blo(rn.y) - blo(rc.y));
      const float rs3 = bhi(rc.y) + m0r.w * (bhi(rp.y) - bhi(rc.y)) + m1r.w * (bhi(rn.y) - bhi(rc.y));
      const float ks0 = blo(kc.x) + m0k.x * (blo(kp.x) - blo(kc.x)) + m1k.x * (blo(kn.x) - blo(kc.x));
      const float ks1 = bhi(kc.x) + m0k.y * (bhi(kp.x) - bhi(kc.x)) + m1k.y * (bhi(kn.x) - bhi(kc.x));
      const float ks2 = blo(kc.y) + m0k.z * (blo(kp.y) - blo(kc.y)) + m1k.z * (blo(kn.y) - blo(kc.y));
      const float ks3 = bhi(kc.y) + m0k.w * (bhi(kp.y) - bhi(kc.y)) + m1k.w * (bhi(kn.y) - bhi(kc.y));
      const float vs0 = blo(vc.x) + m0v.x * (blo(vp.x) - blo(vc.x)) + m1v.x * (blo(vn.x) - blo(vc.x));
      const float vs1 = bhi(vc.x) + m0v.y * (bhi(vp.x) - bhi(vc.x)) + m1v.y * (bhi(vn.x) - bhi(vc.x));
      const float vs2 = blo(vc.y) + m0v.z * (blo(vp.y) - blo(vc.y)) + m1v.z * (blo(vn.y) - blo(vc.y));
      const float vs3 = bhi(vc.y) + m0v.w * (bhi(vp.y) - bhi(vc.y)) + m1v.w * (bhi(vn.y) - bhi(vc.y));
      const float dot = sum16(rs0 * ks0 * rk4.x + rs1 * ks1 * rk4.y + rs2 * ks2 * rk4.z + rs3 * ks3 * rk4.w);
      const float o0 = (y[0] * rstd * lw4.x + lb4.x + dot * vs0) * siluf_(blo(g2.x));
      const float o1 = (y[1] * rstd * lw4.y + lb4.y + dot * vs1) * siluf_(bhi(g2.x));
      const float o2 = (y[2] * rstd * lw4.z + lb4.z + dot * vs2) * siluf_(blo(g2.y));
      const float o3 = (y[3] * rstd * lw4.w + lb4.w + dot * vs3) * siluf_(bhi(g2.y));
      uint2 ov;
      ov.x = pack2(o0, o1);
      ov.y = pack2(o2, o3);
      *(uint2*)(mix + (size_t)r * 1024 + 384 + cg_) = ov;
    }
    {
      const float y0 = (blo(sa0) + blo(sb0) + dsk0 * blo(xa0)) * siluf_(blo(za0));
      const float y1 = (bhi(sa0) + bhi(sb0) + dsk0 * bhi(xa0)) * siluf_(bhi(za0));
      const float y2 = (blo(sa1) + blo(sb1) + dsk1 * blo(xa1)) * siluf_(blo(za1));
      const float y3 = (bhi(sa1) + bhi(sb1) + dsk1 * bhi(xa1)) * siluf_(bhi(za1));
      const float y4 = (blo(sa2) + blo(sb2) + dsk2 * blo(xa2)) * siluf_(blo(za2));
      const float y5 = (bhi(sa2) + bhi(sb2) + dsk2 * bhi(xa2)) * siluf_(bhi(za2));
      float sq = sum16(y0 * y0 + y1 * y1 + y2 * y2 + y3 * y3 + y4 * y4 + y5 * y5);
      sq += __shfl_xor(sq, 16);
      const float rstd = rsqrtf(sq * (1.f / 192.f) + 1e-5f);
      unsigned* dd = (unsigned*)(mix + (size_t)r * 1024 + 640 + cs_);
      dd[0] = pack2(y0 * rstd * nw0.x, y1 * rstd * nw0.y);
      dd[1] = pack2(y2 * rstd * nw1.x, y3 * rstd * nw1.y);
      dd[2] = pack2(y4 * rstd * nw2.x, y5 * rstd * nw2.y);
    }
  }
}

#define XB_TMO      128
#define XB_XCNT(j)  (256  + 64 * (j))
#define XB_XSUB(j)  (1280 + 64 * (j))
#define XB_XGEN(j)  (2304 + 64 * (j))
#define XB_TOP      3328
#define XB_TOPGEN   3392
#define XCD_BAR_WORDS 3456
#define XB_SPIN_CAP (1u << 18)
#define LAS __attribute__((address_space(3)))

__device__ __forceinline__ unsigned xb_ld(unsigned* p)              { return __hip_atomic_load(p, __ATOMIC_RELAXED, __HIP_MEMORY_SCOPE_AGENT); }
__device__ __forceinline__ unsigned xb_add(unsigned* p, unsigned v) { return __hip_atomic_fetch_add(p, v, __ATOMIC_RELAXED, __HIP_MEMORY_SCOPE_AGENT); }
__device__ __forceinline__ unsigned xb_xcc_id() { return (unsigned)__builtin_amdgcn_s_getreg((3 << 11) | 20) & 0xFu; }
#define XB_SPIN(cond, bar) do { unsigned _sp = 0; while (cond) { __builtin_amdgcn_s_sleep(1); \
    if ((++_sp & 255u) == 0u) { if (xb_ld(&(bar)[XB_TMO])) break; if (_sp > XB_SPIN_CAP) { atomicAdd(&(bar)[XB_TMO], 1u); break; } } } } while (0)

struct XcdBarrier {
    unsigned* bar; unsigned x;
    volatile LAS unsigned* st;
};

__device__ __forceinline__ XcdBarrier xcd_barrier_post(unsigned* bar, volatile LAS unsigned* st) {
    XcdBarrier b; b.bar = bar; b.x = xb_xcc_id(); b.st = st;
    if (threadIdx.x == 0) (void)xb_add(&bar[XB_XCNT(b.x)], 1u);
    return b;
}
__device__ __forceinline__ void xcd_barrier_complete(unsigned* bar, unsigned x, unsigned& nloc, unsigned& nx) {
    const unsigned G = gridDim.x * gridDim.y * gridDim.z;
    unsigned sum, cnt, mine, sp = 0u;
    for (;;) {
        sum = 0u; cnt = 0u; mine = 0u;
#pragma unroll
        for (unsigned j = 0; j < 16; ++j) { const unsigned c = xb_ld(&bar[XB_XCNT(j)]); sum += c; cnt += (c > 0u) ? 1u : 0u; mine = (j == x) ? c : mine; }
        if (sum == G) break;
        __builtin_amdgcn_s_sleep(1);
        if ((++sp & 255u) == 0u) { if (xb_ld(&bar[XB_TMO])) break; if (sp > XB_SPIN_CAP) { atomicAdd(&bar[XB_TMO], 1u); break; } }
    }
    nloc = mine > 0u ? mine : 1u; nx = cnt > 0u ? cnt : 1u;
}

__device__ __forceinline__ void xcd_barrier(const XcdBarrier& b) {
    asm volatile("s_waitcnt vmcnt(0)" ::: "memory");
    __syncthreads();
    if (threadIdx.x == 0) {
        unsigned* bar = b.bar;
        __builtin_amdgcn_s_waitcnt(0);
        unsigned nloc = b.st[0], nx = b.st[1];
        if (nloc == 0u) { xcd_barrier_complete(bar, b.x, nloc, nx); b.st[0] = nloc; b.st[1] = nx; }
        const unsigned old = xb_add(&bar[XB_XSUB(b.x)], 1u);
        const unsigned gen = old / nloc;
        if (old + 1u == (gen + 1u) * nloc) {
            __builtin_amdgcn_fence(__ATOMIC_RELEASE, "agent");
            asm volatile("s_waitcnt vmcnt(0)" ::: "memory");
            const unsigned og = xb_add(&bar[XB_TOP], 1u);
            const unsigned tg = og / nx;
            if (og + 1u == (tg + 1u) * nx) xb_add(&bar[XB_TOPGEN], 1u);
            else XB_SPIN(xb_ld(&bar[XB_TOPGEN]) == tg, bar);
            __builtin_amdgcn_fence(__ATOMIC_ACQUIRE, "agent");
            xb_add(&bar[XB_XGEN(b.x)], 1u);
            asm volatile("s_waitcnt vmcnt(0)" ::: "memory");
        } else {
            XB_SPIN(xb_ld(&bar[XB_XGEN(b.x)]) == gen, bar);
            __builtin_amdgcn_fence(__ATOMIC_ACQUIRE, "agent");
            asm volatile("s_waitcnt vmcnt(0)" ::: "memory");
        }
    }
    __syncthreads();
}


__global__ void __launch_bounds__(NTHREADS, LBW) mega(Params p, int ph_lo, int ph_hi) {
  extern __shared__ __attribute__((aligned(16))) unsigned char smem[];
  volatile LAS unsigned* xst = (volatile LAS unsigned*)(smem + LDS_BYTES - 16);
  XcdBarrier xb;
  xb.bar = p.bar; xb.x = 0; xb.st = xst;
  if (ph_hi - ph_lo > 1) {
    if (threadIdx.x == 0) { xst[0] = 0u; xst[1] = 0u; }
    __syncthreads();
    xb = xcd_barrier_post(p.bar, xst);
  }
  for (int ph = ph_lo; ph < ph_hi; ++ph) {
    if (ph > ph_lo) {
      if (ph_hi > 1000) cg::this_grid().sync();
      xcd_barrier(xb);
    }
#ifndef TEST_PH
#define TEST_PH -1
#endif
    if (ph == 0) {
      if (PROBE_DUP == 4) { phase_setup(p, smem); cg::this_grid().sync(); }
      if (TEST_PH < 0 || TEST_PH == 0) phase_setup(p, smem);
    }
    else if (ph == NPHASES - 1) { if (TEST_PH < 0 || TEST_PH == 6) phase_final(p); }
    else {
      const int l = (ph - 1) / 7, s = (ph - 1) % 7;
      if (s == 0) { if (TEST_PH < 0 || TEST_PH == 1) phase_norm(p, l); }
      else if (s == 1) {
        if (PROBE_DUP == 3) { phase_inproj(p, l, smem); cg::this_grid().sync(); }
        if (TEST_PH < 0 || TEST_PH == 2) phase_inproj(p, l, smem);
      }
      else if (s == 2) {
        if (PROBE_DUP == 5) { phase_rwkvprep(p, l, smem); cg::this_grid().sync(); }
        if (TEST_PH < 0 || TEST_PH == 10) phase_rwkvprep(p, l, smem);
      }
      else if (s == 3) {
        if (PROBE_DUP == 1 || PROBE_DUP == 2) { phase_probe(p, l, smem); cg::this_grid().sync(); }
        if (TEST_PH < 0 || TEST_PH == 3 || (TEST_PH >= 7 && TEST_PH <= 9)) phase_mixers(p, l, smem);
      }
      else if (s == 4) { phase_rwkvfix(p); }
      else if (s == 5) { if (TEST_PH < 0 || TEST_PH == 4) phase_finish(p, l); }
      else { if (TEST_PH < 0 || TEST_PH == 5) phase_outproj(p, l, smem); }
    }
  }
}

extern "C" void kernel_launch(void* const* d_in, const int* in_sizes, int n_in, void* d_out, int out_size, void* d_ws,
                              size_t ws_size, hipStream_t stream) {
  static int grid_blocks = 0;
  if (!grid_blocks) {
    int dev = 0, cus = 0, per_cu = 0;
    hipGetDevice(&dev);
    hipDeviceGetAttribute(&cus, hipDeviceAttributeMultiprocessorCount, dev);
    hipFuncSetAttribute((const void*)mega, hipFuncAttributeMaxDynamicSharedMemorySize, LDS_BYTES);
    hipOccupancyMaxActiveBlocksPerMultiprocessor(&per_cu, (const void*)mega, NTHREADS, LDS_BYTES);
    if (per_cu < 1) per_cu = 1;
    if (per_cu > 2) per_cu = 2;
    grid_blocks = cus * per_cu;
  }
  Params p{};
  const float** fp = (const float**)&p;
  for (int i = 0; i < 27; ++i) fp[i] = (const float*)d_in[i];
  p.out = (float*)d_out;
  unsigned char* ws = (unsigned char*)d_ws;
  size_t off = 0;
  auto take = [&](size_t bytes) { unsigned char* r = ws + off; off += (bytes + 255) & ~(size_t)255; return r; };
  p.WtIn = (bf16_t*)take((size_t)2 * 3712 * 1024 * 2);
  p.WtOut = (bf16_t*)take((size_t)2 * 1024 * 1024 * 2);
  p.WupT = (bf16_t*)take((size_t)65536 * 2);
  p.AupT = (bf16_t*)take((size_t)65536 * 2);
  p.rope = (float*)take(1024 * 2 * 4);
  p.mod = (float*)take((size_t)2 * 5 * 3072 * 4);
  p.ctxcur = (float*)take((size_t)4 * 256 * 1024 * 4);
  p.PRE = (bf16_t*)take((size_t)3 * TOK * 512 * 2);
  p.hbuf = p.PRE;
  p.PA = (bf16_t*)take((size_t)TOK * 1024 * 2);
  p.PR = (bf16_t*)take((size_t)TOK * 1024 * 2);
  p.PG = (bf16_t*)take((size_t)TOK * 640 * 2);
  p.PS = (bf16_t*)take((size_t)TOK * 912 * 2);
  p.yR = (bf16_t*)take((size_t)2 * TOK * 256 * 2);
  p.HALO = (bf16_t*)take((size_t)512 * 2 * 896 * 2);
  p.DTC = (float2*)take((size_t)12 * TOK * 8);
  p.GID = (bf16_t*)take((size_t)8 * NSEG1 * 256 * 2);
  p.SMID = (float*)take((size_t)32 * 64 * 64 * 4);
  p.ctrs = (unsigned*)take(256);
  p.bar = (unsigned*)take((size_t)XCD_BAR_WORDS * 4);
  p.rstd = (float*)take((size_t)TOK * 4);
  p.yS = (bf16_t*)take((size_t)2 * TOK * 384 * 2);
  if (off > ws_size) { fprintf(stderr, "workspace too small: need %zu have %zu\n", off, ws_size); return; }
#if ONE_LAUNCH
  hipMemsetAsync(p.bar, 0, (size_t)XCD_BAR_WORDS * 4, stream);
  int lo = 0, hi = NPHASES;
  void* args[] = {&p, &lo, &hi};
  hipError_t e = hipLaunchCooperativeKernel((const void*)mega, dim3(grid_blocks), dim3(NTHREADS), args, LDS_BYTES, stream);
  if (e != hipSuccess) fprintf(stderr, "cooperative launch failed: %s (grid %d)\n", hipGetErrorString(e), grid_blocks);
#else
  for (int ph = 0; ph < NPHASES; ++ph)
    hipLaunchKernelGGL(mega, dim3(grid_blocks), dim3(NTHREADS), LDS_BYTES, stream, p, ph, ph + 1);
#endif
}
```

```cpp
#include <hip/hip_runtime.h>
#include <hip/hip_bf16.h>
#include <hip/hip_cooperative_groups.h>
#include <cstdio>
namespace cg = cooperative_groups;

#ifndef TEST_PH
#define TEST_PH -1
#endif
#ifndef ONE_LAUNCH
#define ONE_LAUNCH 1
#endif

typedef unsigned short bf16_t;
#define GLAS __attribute__((address_space(3)))
using bf16x8 = __attribute__((ext_vector_type(8))) short;
using f32x4 = __attribute__((ext_vector_type(4))) float;

#define TOK 17408
#define TPB 4352
#define NTHREADS 256
#define LDS_BYTES 76800
#define NPHASES 16
#define CSPLIT 78
#define NSEG1 ((136 - CSPLIT) * 32)
#ifndef LBW
#define LBW 2
#endif

struct Params {
  const float *x, *c, *ctx, *c_ctx, *ada_w, *ada_b, *norm_w, *w_in, *w_out, *attn_sink, *rwkv_mu, *rwkv_w0,
      *rwkv_w_up, *rwkv_a0, *rwkv_a_up, *rwkv_k_k, *rwkv_k_a, *rwkv_r_k, *rwkv_ln_w, *rwkv_ln_b, *ssm_conv_w,
      *ssm_conv_b, *ssm_a_log, *ssm_dt_bias, *ssm_d, *ssm_norm_w, *final_norm_w;
  float* out;
  bf16_t *WtIn, *WtOut, *WupT, *AupT;
  float *rope, *mod, *ctxcur;
  bf16_t *hbuf, *PA, *PR, *PG, *PS;
  bf16_t* yR;
  bf16_t* yS;
  bf16_t* PRE;
  bf16_t* HALO;
  float2* DTC;
  bf16_t* GID;
  float* SMID;
  unsigned* ctrs;
  unsigned* bar;
  float* rstd;
};

__device__ __forceinline__ float bf2f(bf16_t v) { return __uint_as_float(((unsigned)v) << 16); }
typedef __bf16 hbf2 __attribute__((ext_vector_type(2)));
typedef float hf2 __attribute__((ext_vector_type(2)));
__device__ __forceinline__ unsigned pack2(float a, float b) {
  hf2 v = {a, b};
  hbf2 r = __builtin_convertvector(v, hbf2);
  return *(unsigned*)&r;
}
__device__ __forceinline__ bf16_t f2bf(float f) { return (bf16_t)(pack2(f, 0.f) & 0xffffu); }
__device__ __forceinline__ float blo(unsigned u) { return __uint_as_float(u << 16); }
__device__ __forceinline__ float bhi(unsigned u) { return __uint_as_float(u & 0xffff0000u); }
__device__ __forceinline__ float frcp(float x) { return __builtin_amdgcn_rcpf(x); }
__device__ __forceinline__ float sigmoidf_(float x) { return frcp(1.f + __expf(-x)); }
__device__ __forceinline__ float siluf_(float x) { return x * frcp(1.f + __expf(-x)); }
__device__ __forceinline__ float softplusf_(float x) {
  if (x > 15.f) return x;
  float e = __expf(x);
  return (e < 0.01f) ? e * (1.f - e * (0.5f - e * 0.33333333f)) : __logf(1.f + e);
}
__device__ __forceinline__ float tanhf_(float x) {
  float e = __expf(2.f * x);
  return 1.f - 2.f * frcp(e + 1.f);
}

template <int CTRL>
__device__ __forceinline__ float dppf(float x) {
  return __int_as_float(__builtin_amdgcn_update_dpp(0, __float_as_int(x), CTRL, 0xF, 0xF, true));
}
__device__ __forceinline__ float sum16(float x) {
  x += dppf<0xB1>(x);
  x += dppf<0x4E>(x);
  x += dppf<0x141>(x);
  x += dppf<0x140>(x);
  return x;
}
__device__ __forceinline__ float max16(float x) {
  x = fmaxf(x, dppf<0xB1>(x));
  x = fmaxf(x, dppf<0x4E>(x));
  x = fmaxf(x, dppf<0x141>(x));
  x = fmaxf(x, dppf<0x140>(x));
  return x;
}
__device__ __forceinline__ float sum64(float x) {
#pragma unroll
  for (int o = 32; o >= 1; o >>= 1) x += __shfl_xor(x, o);
  return x;
}
__device__ __forceinline__ float sum32(float x) {
#pragma unroll
  for (int o = 16; o >= 1; o >>= 1) x += __shfl_xor(x, o);
  return x;
}
__device__ __forceinline__ int launder(int x) { asm volatile("" : "+v"(x)); return x; }
#define MFMA(a, b, c) __builtin_amdgcn_mfma_f32_16x16x32_bf16(a, b, c, 0, 0, 0)

__device__ __forceinline__ void transpose_tile(const float* __restrict__ W, int N, int Kdim, bf16_t* __restrict__ Wt, int k0, int n0,
                               unsigned char* smem) {
  float* T = (float*)smem;
  const int tid = launder(threadIdx.x);
#pragma unroll 4
  for (int it = 0; it < 16; ++it) {
    int kk = (tid >> 6) + 4 * it, nn = tid & 63, n = n0 + nn;
    T[kk * 65 + nn] = (n < N) ? W[(size_t)(k0 + kk) * N + n] : 0.f;
  }
  __syncthreads();
#pragma unroll
  for (int it = 0; it < 2; ++it) {
    int nn = (tid >> 3) + 32 * it, kc = tid & 7;
    uint4 o;
    o.x = pack2(T[(kc * 8 + 0) * 65 + nn], T[(kc * 8 + 1) * 65 + nn]);
    o.y = pack2(T[(kc * 8 + 2) * 65 + nn], T[(kc * 8 + 3) * 65 + nn]);
    o.z = pack2(T[(kc * 8 + 4) * 65 + nn], T[(kc * 8 + 5) * 65 + nn]);
    o.w = pack2(T[(kc * 8 + 6) * 65 + nn], T[(kc * 8 + 7) * 65 + nn]);
    *(uint4*)(Wt + (size_t)(n0 + nn) * Kdim + k0 + kc * 8) = o;
  }
  __syncthreads();
}

__device__ void sincos_d(double x, float& c, float& s) {
  double n = rint(x * 0.63661977236758134308);
  double r = x - n * 1.57079632679489661923;
  double r2 = r * r;
  double sn = r * (1.0 + r2 * (-1.0 / 6 + r2 * (1.0 / 120 + r2 * (-1.0 / 5040 + r2 * (1.0 / 362880 + r2 * (-1.0 / 39916800 + r2 * (1.0 / 6227020800.0)))))));
  double cs = 1.0 + r2 * (-0.5 + r2 * (1.0 / 24 + r2 * (-1.0 / 720 + r2 * (1.0 / 40320 + r2 * (-1.0 / 3628800 + r2 * (1.0 / 479001600.0 + r2 * (-1.0 / 87178291200.0)))))));
  int q = ((int)n) & 3;
  double co, so;
  if (q == 0) { co = cs; so = sn; }
  else if (q == 1) { co = -sn; so = cs; }
  else if (q == 2) { co = -cs; so = -sn; }
  else { co = sn; so = -cs; }
  c = (float)co;
  s = (float)so;
}

__device__ __forceinline__ void deferred_transpose(const Params& p, int t, unsigned char* smem) {
  if (t < 928) {
    const int kt = t / 58, nt = t % 58;
    transpose_tile(p.w_in + (size_t)1024 * 3596, 3596, 1024, p.WtIn + (size_t)3712 * 1024, kt * 64, nt * 64, smem);
  } else {
    const int tt = t - 928, l = tt >> 8, r = tt & 255, kt = r >> 4, nt = r & 15;
    transpose_tile(p.w_out + (size_t)l * 1024 * 1024, 1024, 1024, p.WtOut + (size_t)l * 1024 * 1024, kt * 64, nt * 64, smem);
  }
}
__device__ __forceinline__ void phase_setup(const Params& p, unsigned char* smem) {
  const int T_WIN = 16 * 58, T_WOUT = 0, T_ADA = 2 * 96, T_MISC = 17;
  const int total = T_WIN + T_WOUT + T_ADA + T_MISC;
  const int tid = launder(threadIdx.x);
  if (blockIdx.x == 0 && tid < 8) p.ctrs[tid] = 0u;
  for (int t = blockIdx.x; t < total; t += gridDim.x) {
    if (t < T_WIN) {
      int kt = t / 58, nt = t % 58;
      transpose_tile(p.w_in, 3596, 1024, p.WtIn, kt * 64, nt * 64, smem);
    } else if (t < T_WIN + T_WOUT + T_ADA) {
      int tt = t - T_WIN - T_WOUT, l = tt / 96, n0 = (tt % 96) * 32;
      float* cact = (float*)smem;
      for (int i = tid; i < 5120; i += 256) {
        int j = i >> 10, k = i & 1023;
        float v = (j < 4) ? p.c[j * 1024 + k] : p.c_ctx[k];
        cact[i] = siluf_(v);
      }
      __syncthreads();
      int col = tid & 31, kg = tid >> 5;
      float a0 = 0, a1 = 0, a2 = 0, a3 = 0, a4 = 0;
      const float* wp = p.ada_w + ((size_t)l * 1024 + kg * 128) * 3072 + n0 + col;
#pragma unroll 8
      for (int k = 0; k < 128; ++k) {
        float w = wp[(size_t)k * 3072];
        int kk = kg * 128 + k;
        a0 += cact[kk] * w; a1 += cact[1024 + kk] * w; a2 += cact[2048 + kk] * w; a3 += cact[3072 + kk] * w; a4 += cact[4096 + kk] * w;
      }
      float* red = cact + 5120;
      red[(kg * 5 + 0) * 32 + col] = a0; red[(kg * 5 + 1) * 32 + col] = a1; red[(kg * 5 + 2) * 32 + col] = a2;
      red[(kg * 5 + 3) * 32 + col] = a3; red[(kg * 5 + 4) * 32 + col] = a4;
      __syncthreads();
      if (tid < 160) {
        int j = tid >> 5, cc = tid & 31;
        float s = 0;
#pragma unroll
        for (int g = 0; g < 8; ++g) s += red[(g * 5 + j) * 32 + cc];
        p.mod[(size_t)(l * 5 + j) * 3072 + n0 + cc] = s + p.ada_b[l * 3072 + n0 + cc];
      }
      __syncthreads();
    } else {
      int tt = t - T_WIN - T_WOUT - T_ADA;
      if (tt < 16) {
        for (int i = tid; i < 8192; i += 256) {
          int idx = tt * 8192 + i;
          int arr = idx >> 16, e = idx & 65535;
          int ld = e >> 14, rem = e & 16383, n = rem >> 6, k = rem & 63;
          const float* src = arr ? p.rwkv_a_up : p.rwkv_w_up;
          bf16_t* dst = arr ? p.AupT : p.WupT;
          dst[e] = f2bf(src[((size_t)ld * 64 + k) * 256 + n]);
        }
      } else {
        for (int i = tid; i < 1024; i += 256) {
          int pos = i >> 4, f = i & 15;
          float inv32 = exp2f(-(float)f * 0.83048202372184058f);
          float c, s;
          sincos_d((double)((float)pos * inv32), c, s);
          p.rope[i * 2] = c;
          p.rope[i * 2 + 1] = s;
        }
      }
    }
  }
}

__device__ __forceinline__ void phase_norm(const Params& p, int l) {
  const int tid = launder(threadIdx.x), lane = tid & 63, w = tid >> 6;
  for (int t = blockIdx.x; t < TOK / 4; t += gridDim.x) {
    int r = t * 4 + w, b = r / TPB, pp = r % TPB;
    const float* src;
    if (l == 0) src = (pp < 256) ? p.ctx + ((size_t)b * 256 + pp) * 1024 : p.x + ((size_t)b * 4096 + pp - 256) * 1024;
    else src = (pp < 256) ? p.ctxcur + ((size_t)b * 256 + pp) * 1024 : p.out + ((size_t)b * 4096 + pp - 256) * 1024;
    const float* md = p.mod + (size_t)(l * 5 + ((pp < 256) ? 4 : b)) * 3072;
    const float* nw = p.norm_w + l * 1024;
    float4 v[4];
    float ss = 0;
#pragma unroll
    for (int i = 0; i < 4; ++i) {
      v[i] = *(const float4*)(src + lane * 4 + 256 * i);
      ss += v[i].x * v[i].x + v[i].y * v[i].y + v[i].z * v[i].z + v[i].w * v[i].w;
    }
    ss = sum64(ss);
    float rstd = rsqrtf(ss * (1.f / 1024.f) + 1e-6f);
    if (lane == 0) p.rstd[r] = rstd;
#pragma unroll
    for (int i = 0; i < 4; ++i) {
      int k = lane * 4 + 256 * i;
      float4 n4 = *(const float4*)(nw + k), sc = *(const float4*)(md + 1024 + k), sh = *(const float4*)(md + k);
      float h0 = v[i].x * rstd * n4.x * (1.f + sc.x) + sh.x;
      float h1 = v[i].y * rstd * n4.y * (1.f + sc.y) + sh.y;
      float h2 = v[i].z * rstd * n4.z * (1.f + sc.z) + sh.z;
      float h3 = v[i].w * rstd * n4.w * (1.f + sc.w) + sh.w;
      uint2 o;
      o.x = pack2(h0, h1);
      o.y = pack2(h2, h3);
      *(uint2*)(p.hbuf + (size_t)r * 1024 + k) = o;
    }
  }
}

__device__ __forceinline__ void phase_final(const Params& p) {
  const int tid = launder(threadIdx.x), lane = tid & 63, w = tid >> 6;
  for (int t = blockIdx.x; t < 16384 / 4; t += gridDim.x) {
    int r = t * 4 + w;
    float* src = p.out + (size_t)r * 1024;
    float4 v[4];
    float ss = 0;
#pragma unroll
    for (int i = 0; i < 4; ++i) {
      v[i] = *(const float4*)(src + lane * 4 + 256 * i);
      ss += v[i].x * v[i].x + v[i].y * v[i].y + v[i].z * v[i].z + v[i].w * v[i].w;
    }
    ss = sum64(ss);
    float rstd = rsqrtf(ss * (1.f / 1024.f) + 1e-6f);
#pragma unroll
    for (int i = 0; i < 4; ++i) {
      int k = lane * 4 + 256 * i;
      float4 n4 = *(const float4*)(p.final_norm_w + k);
      float4 o;
      o.x = v[i].x * rstd * n4.x; o.y = v[i].y * rstd * n4.y; o.z = v[i].z * rstd * n4.z; o.w = v[i].w * rstd * n4.w;
      *(float4*)(src + k) = o;
    }
  }
}

template <int MODE>
__device__ __forceinline__ void gemm_tile(const Params& p, int l, int mt_, int nt_, unsigned char* smem) {
  const bf16_t* A = p.hbuf;
  const bf16_t* Bt = (MODE == 0) ? p.WtIn + (size_t)l * 3712 * 1024 : p.WtOut + (size_t)l * 1024 * 1024;
  const int m0 = mt_ * 128, n0 = nt_ * 128;
  bf16_t* As = (bf16_t*)smem;
  bf16_t* Bs = As + 2 * 128 * 72;
  const int tid = launder(threadIdx.x), lane = tid & 63, w = tid >> 6, wr = w >> 1, wc = w & 1, fr = lane & 15, fq = lane >> 4;
  f32x4 acc[4][4];
#pragma unroll
  for (int i = 0; i < 4; ++i)
#pragma unroll
    for (int j = 0; j < 4; ++j) acc[i][j] = (f32x4){0.f, 0.f, 0.f, 0.f};
  unsigned char* lds = smem;
  int sR[4], sC[4];
#pragma unroll
  for (int i = 0; i < 4; ++i) {
    const int bo = tid * 16 + i * 4096;
    const int st = bo >> 10, sb = bo & 1023, swz = sb ^ (((sb >> 9) & 1) << 5);
    sR[i] = (st >> 1) * 16 + (swz >> 6);
    sC[i] = (st & 1) * 32 + ((swz & 63) >> 1);
  }
  const bf16_t* Ag0 = A + (size_t)(m0 + sR[0]) * 1024 + sC[0];
  const bf16_t* Ag1 = A + (size_t)(m0 + sR[1]) * 1024 + sC[1];
  const bf16_t* Ag2 = A + (size_t)(m0 + sR[2]) * 1024 + sC[2];
  const bf16_t* Ag3 = A + (size_t)(m0 + sR[3]) * 1024 + sC[3];
  const bf16_t* Bg0 = Bt + (size_t)(n0 + sR[0]) * 1024 + sC[0];
  const bf16_t* Bg1 = Bt + (size_t)(n0 + sR[1]) * 1024 + sC[1];
  const bf16_t* Bg2 = Bt + (size_t)(n0 + sR[2]) * 1024 + sC[2];
  const bf16_t* Bg3 = Bt + (size_t)(n0 + sR[3]) * 1024 + sC[3];
#define GL_STAGE(q_, kt_)                                                                                                              \
  {                                                                                                                                    \
    unsigned char* base_ = lds + (q_) * 32768 + tid * 16;                                                                              \
    __builtin_amdgcn_global_load_lds((const unsigned*)(Ag0 + (kt_) * 64), (GLAS unsigned*)(base_), 16, 0, 0);                          \
    __builtin_amdgcn_global_load_lds((const unsigned*)(Ag1 + (kt_) * 64), (GLAS unsigned*)(base_ + 4096), 16, 0, 0);                   \
    __builtin_amdgcn_global_load_lds((const unsigned*)(Ag2 + (kt_) * 64), (GLAS unsigned*)(base_ + 8192), 16, 0, 0);                   \
    __builtin_amdgcn_global_load_lds((const unsigned*)(Ag3 + (kt_) * 64), (GLAS unsigned*)(base_ + 12288), 16, 0, 0);                  \
    __builtin_amdgcn_global_load_lds((const unsigned*)(Bg0 + (kt_) * 64), (GLAS unsigned*)(base_ + 16384), 16, 0, 0);                  \
    __builtin_amdgcn_global_load_lds((const unsigned*)(Bg1 + (kt_) * 64), (GLAS unsigned*)(base_ + 16384 + 4096), 16, 0, 0);           \
    __builtin_amdgcn_global_load_lds((const unsigned*)(Bg2 + (kt_) * 64), (GLAS unsigned*)(base_ + 16384 + 8192), 16, 0, 0);           \
    __builtin_amdgcn_global_load_lds((const unsigned*)(Bg3 + (kt_) * 64), (GLAS unsigned*)(base_ + 16384 + 12288), 16, 0, 0);          \
  }
  const int lo = (fr * 64 + fq * 16) ^ ((fr >> 3) << 5);
#define GL_COMPUTE(q_)                                                                                 \
  {                                                                                                    \
    const unsigned char* Ab = lds + (q_) * 32768 + (wr * 4) * 2048 + lo;                               \
    const unsigned char* Bb = lds + (q_) * 32768 + 16384 + (wc * 4) * 2048 + lo;                       \
    _Pragma("unroll") for (int ks = 0; ks < 2; ++ks) {                                                 \
      bf16x8 a[4], b[4];                                                                               \
      _Pragma("unroll") for (int i = 0; i < 4; ++i) {                                                  \
        a[i] = *(const bf16x8*)(Ab + i * 2048 + ks * 1024);                                            \
        b[i] = *(const bf16x8*)(Bb + i * 2048 + ks * 1024);                                            \
      }                                                                                                \
      _Pragma("unroll") for (int i = 0; i < 4; ++i)                                                    \
        _Pragma("unroll") for (int j = 0; j < 4; ++j) acc[i][j] = MFMA(a[i], b[j], acc[i][j]);         \
    }                                                                                                  \
  }
  GL_STAGE(0, 0);
  asm volatile("s_waitcnt vmcnt(0)" ::: "memory");
  __builtin_amdgcn_s_barrier();
  for (int kt = 0; kt < 16; ++kt) {
    const int q = kt & 1;
    if (kt + 1 < 16) GL_STAGE(q ^ 1, kt + 1);
    GL_COMPUTE(q);
    asm volatile("s_waitcnt vmcnt(0) lgkmcnt(0)" ::: "memory");
    __builtin_amdgcn_s_barrier();
  }
  const int cbase = n0 + wc * 64;
  if (MODE == 0) {
    bf16_t* dst;
    int ld, coff;
    if (cbase < 1024) { dst = p.PA; ld = 1024; coff = cbase; }
    else if (cbase < 2048) { dst = p.PR; ld = 1024; coff = cbase - 1024; }
    else if (cbase < 2688) { dst = p.PG; ld = 640; coff = cbase - 2048; }
    else { dst = p.PS; ld = 912; coff = cbase - 2688; }
    bf16_t* wbuf = (bf16_t*)smem + w * (64 * 72);
#pragma unroll
    for (int i = 0; i < 4; ++i) {
#pragma unroll
      for (int j = 0; j < 4; ++j) {
        const int r = m0 + wr * 64 + i * 16 + fq * 4 + j;
        const int pp = r % TPB;
        float v0 = acc[i][0][j], v1 = acc[i][1][j], v2 = acc[i][2][j], v3 = acc[i][3][j];
        if (cbase < 512 && pp >= 256) {
          const int tt = pp - 256, rp = tt >> 6, cp = tt & 63;
          const float2 cs0 = *(const float2*)(p.rope + (rp * 16 + fr) * 2);
          const float2 cs1 = *(const float2*)(p.rope + (cp * 16 + fr) * 2);
          float n0_ = v0 * cs0.x - v1 * cs0.y, n1_ = v0 * cs0.y + v1 * cs0.x;
          float n2_ = v2 * cs1.x - v3 * cs1.y, n3_ = v2 * cs1.y + v3 * cs1.x;
          v0 = n0_; v1 = n1_; v2 = n2_; v3 = n3_;
        }
        if (cbase < 384) { v0 *= 0.125f; v1 *= 0.125f; v2 *= 0.125f; v3 *= 0.125f; }
        bf16_t* o = wbuf + (i * 16 + fq * 4 + j) * 72 + fr;
        o[0] = f2bf(v0); o[16] = f2bf(v1); o[32] = f2bf(v2); o[48] = f2bf(v3);
      }
    }
    __builtin_amdgcn_wave_barrier();
    {
      const int ch = lane & 7;
      const bool chv = (cbase + ch * 8) < 3600;
      const bool halo = (cbase >= 2688) && (cbase + 64 <= 3584);
#pragma unroll
      for (int t = 0; t < 8; ++t) {
        const int rl = (lane >> 3) + 8 * t;
        const uint4 v = *(const uint4*)(wbuf + rl * 72 + ch * 8);
        const int r = m0 + wr * 64 + rl;
        if (chv) *(uint4*)(dst + (size_t)r * ld + coff + ch * 8) = v;
        if (halo) {
          const int pp = r % TPB, q34 = pp % 34, t34 = pp / 34, bb = r / TPB;
          if (q34 == 33 && t34 + 1 < 128) *(uint4*)(p.HALO + ((size_t)(bb * 128 + t34 + 1) * 2 + 0) * 896 + coff + ch * 8) = v;
          if (q34 == 0 && t34 >= 1) *(uint4*)(p.HALO + ((size_t)(bb * 128 + t34 - 1) * 2 + 1) * 896 + coff + ch * 8) = v;
        }
      }
    }
  } else {
    float* wbuf = (float*)smem + w * (64 * 68);
#pragma unroll
    for (int i = 0; i < 4; ++i)
#pragma unroll
      for (int j = 0; j < 4; ++j) {
        float* o = wbuf + (i * 16 + fq * 4 + j) * 68 + fr;
        o[0] = acc[i][0][j]; o[16] = acc[i][1][j]; o[32] = acc[i][2][j]; o[48] = acc[i][3][j];
      }
    __builtin_amdgcn_wave_barrier();
    {
      const int ch = lane & 15;
      const int b = m0 / TPB, pp0 = (m0 % TPB) + wr * 64;
      const bool isc = pp0 < 256;
      const float4 g4 = *(const float4*)(p.mod + (size_t)(l * 5 + (isc ? 4 : b)) * 3072 + 2048 + cbase + ch * 4);
      const float* resb;
      float* dstb;
      if (l == 0) {
        resb = isc ? p.ctx + ((size_t)b * 256 + pp0) * 1024 : p.x + ((size_t)b * 4096 + pp0 - 256) * 1024;
        dstb = isc ? p.ctxcur + ((size_t)b * 256 + pp0) * 1024 : p.out + ((size_t)b * 4096 + pp0 - 256) * 1024;
      } else {
        resb = p.out + ((size_t)b * 4096 + pp0 - 256) * 1024;
        dstb = p.out + ((size_t)b * 4096 + pp0 - 256) * 1024;
      }
#pragma unroll
      for (int t = 0; t < 16; ++t) {
        const int rl = (lane >> 4) + 4 * t;
        const float4 a4 = *(const float4*)(wbuf + rl * 68 + ch * 4);
        const float4 r4 = *(const float4*)(resb + (size_t)rl * 1024 + cbase + ch * 4);
        float4 o4;
        o4.x = r4.x + g4.x * a4.x; o4.y = r4.y + g4.y * a4.y; o4.z = r4.z + g4.z * a4.z; o4.w = r4.w + g4.w * a4.w;
        *(float4*)(dstb + (size_t)rl * 1024 + cbase + ch * 4) = o4;
      }
    }
  }
  __syncthreads();
}

#define G_COMPUTE(buf_)                                                                 \
  {                                                                                     \
    const bf16_t* Ac = As + (buf_) * 128 * 72 + (wr * 64 + fr) * 72 + fq * 8;           \
    const bf16_t* Bc = Bs + (buf_) * 128 * 72 + (wc * 64 + fr) * 72 + fq * 8;           \
    _Pragma("unroll") for (int ks = 0; ks < 2; ++ks) {                                  \
      bf16x8 a[4], b[4];                                                                \
      _Pragma("unroll") for (int i = 0; i < 4; ++i) {                                   \
        a[i] = *(const bf16x8*)(Ac + i * 16 * 72 + ks * 32);                            \
        b[i] = *(const bf16x8*)(Bc + i * 16 * 72 + ks * 32);                            \
      }                                                                                 \
      _Pragma("unroll") for (int i = 0; i < 4; ++i)                                     \
        _Pragma("unroll") for (int j = 0; j < 4; ++j) acc[i][j] = MFMA(a[i], b[j], acc[i][j]); \
    }                                                                                   \
  }
__device__ __forceinline__ void gemm_late_tile(const Params& p, int l, int mt_, int nt_, unsigned char* smem) {
  const bf16_t* Bt = p.WtIn + (size_t)l * 3712 * 1024;
  const int m0 = mt_ * 128, n0 = nt_ * 128;
  bf16_t* As = (bf16_t*)smem;
  bf16_t* Bs = As + 2 * 128 * 72;
  const int tid = launder(threadIdx.x), lane = tid & 63, w = tid >> 6, wr = w >> 1, wc = w & 1, fr = lane & 15, fq = lane >> 4;
  f32x4 acc[4][4];
#pragma unroll
  for (int i = 0; i < 4; ++i)
#pragma unroll
    for (int j = 0; j < 4; ++j) acc[i][j] = (f32x4){0.f, 0.f, 0.f, 0.f};
  const int lrow = tid >> 3, lkc = tid & 7;
  const int bb = m0 / TPB, pp0 = m0 % TPB;
  const bool isc0 = pp0 < 256;
  const float* xbase;
  if (l == 0) xbase = isc0 ? p.ctx + ((size_t)bb * 256 + pp0) * 1024 : p.x + ((size_t)bb * 4096 + pp0 - 256) * 1024;
  else xbase = isc0 ? p.ctxcur + ((size_t)bb * 256 + pp0) * 1024 : p.out + ((size_t)bb * 4096 + pp0 - 256) * 1024;
  const float* xr = xbase + (size_t)lrow * 1024 + lkc * 8;
  const float* md = p.mod + (size_t)(l * 5 + (isc0 ? 4 : bb)) * 3072 + lkc * 8;
  const float* nwp = p.norm_w + l * 1024 + lkc * 8;
  const float rs0 = p.rstd[m0 + lrow], rs1 = p.rstd[m0 + lrow + 32], rs2 = p.rstd[m0 + lrow + 64], rs3 = p.rstd[m0 + lrow + 96];
  const bf16_t* Bg = Bt + (size_t)(n0 + lrow) * 1024 + lkc * 8;
  float4 xa0, xb0, xa1, xb1, xa2, xb2, xa3, xb3, nwa, nwb, sca, scb, sha, shb;
  uint4 lb0, lb1, lb2, lb3;
#define L_LOAD(kt_)                                                                                   \
  {                                                                                                   \
    const int ko_ = (kt_) * 64;                                                                       \
    xa0 = *(const float4*)(xr + ko_); xb0 = *(const float4*)(xr + ko_ + 4);                            \
    xa1 = *(const float4*)(xr + 32 * 1024 + ko_); xb1 = *(const float4*)(xr + 32 * 1024 + ko_ + 4);    \
    xa2 = *(const float4*)(xr + 64 * 1024 + ko_); xb2 = *(const float4*)(xr + 64 * 1024 + ko_ + 4);    \
    xa3 = *(const float4*)(xr + 96 * 1024 + ko_); xb3 = *(const float4*)(xr + 96 * 1024 + ko_ + 4);    \
    lb0 = *(const uint4*)(Bg + ko_); lb1 = *(const uint4*)(Bg + (size_t)32 * 1024 + ko_);              \
    lb2 = *(const uint4*)(Bg + (size_t)64 * 1024 + ko_); lb3 = *(const uint4*)(Bg + (size_t)96 * 1024 + ko_); \
    nwa = *(const float4*)(nwp + ko_); nwb = *(const float4*)(nwp + ko_ + 4);                          \
    sca = *(const float4*)(md + 1024 + ko_); scb = *(const float4*)(md + 1024 + ko_ + 4);              \
    sha = *(const float4*)(md + ko_); shb = *(const float4*)(md + ko_ + 4);                            \
  }
#define L_ROW(xa_, xb_, rs_, i_, buf_)                                                                \
  {                                                                                                   \
    uint4 o_;                                                                                         \
    o_.x = pack2(xa_.x * rs_ * nwa.x * (1.f + sca.x) + sha.x, xa_.y * rs_ * nwa.y * (1.f + sca.y) + sha.y); \
    o_.y = pack2(xa_.z * rs_ * nwa.z * (1.f + sca.z) + sha.z, xa_.w * rs_ * nwa.w * (1.f + sca.w) + sha.w); \
    o_.z = pack2(xb_.x * rs_ * nwb.x * (1.f + scb.x) + shb.x, xb_.y * rs_ * nwb.y * (1.f + scb.y) + shb.y); \
    o_.w = pack2(xb_.z * rs_ * nwb.z * (1.f + scb.z) + shb.z, xb_.w * rs_ * nwb.w * (1.f + scb.w) + shb.w); \
    *(uint4*)(As + (buf_) * 128 * 72 + (lrow + 32 * (i_)) * 72 + lkc * 8) = o_;                       \
  }
#define L_STORE(buf_)                                                                                 \
  {                                                                                                   \
    L_ROW(xa0, xb0, rs0, 0, buf_) L_ROW(xa1, xb1, rs1, 1, buf_) L_ROW(xa2, xb2, rs2, 2, buf_) L_ROW(xa3, xb3, rs3, 3, buf_) \
    *(uint4*)(Bs + (buf_) * 128 * 72 + lrow * 72 + lkc * 8) = lb0;                                    \
    *(uint4*)(Bs + (buf_) * 128 * 72 + (lrow + 32) * 72 + lkc * 8) = lb1;                             \
    *(uint4*)(Bs + (buf_) * 128 * 72 + (lrow + 64) * 72 + lkc * 8) = lb2;                             \
    *(uint4*)(Bs + (buf_) * 128 * 72 + (lrow + 96) * 72 + lkc * 8) = lb3;                             \
  }
  L_LOAD(0);
  L_STORE(0);
  __syncthreads();
  for (int kt = 0; kt < 16; ++kt) {
    L_LOAD((kt + 1 < 16) ? kt + 1 : 15);
    G_COMPUTE(kt & 1);
    L_STORE((kt + 1) & 1);
    __syncthreads();
  }
  const int cbase = n0 + wc * 64;
    bf16_t* dst;
    int ld, coff;
    if (cbase < 1024) { dst = p.PA; ld = 1024; coff = cbase; }
    else if (cbase < 2048) { dst = p.PR; ld = 1024; coff = cbase - 1024; }
    else if (cbase < 2688) { dst = p.PG; ld = 640; coff = cbase - 2048; }
    else { dst = p.PS; ld = 912; coff = cbase - 2688; }
    bf16_t* wbuf = (bf16_t*)smem + w * (64 * 72);
#pragma unroll
    for (int i = 0; i < 4; ++i) {
#pragma unroll
      for (int j = 0; j < 4; ++j) {
        const int r = m0 + wr * 64 + i * 16 + fq * 4 + j;
        const int pp = r % TPB;
        float v0 = acc[i][0][j], v1 = acc[i][1][j], v2 = acc[i][2][j], v3 = acc[i][3][j];
        if (cbase < 512 && pp >= 256) {
          const int tt = pp - 256, rp = tt >> 6, cp = tt & 63;
          const float2 cs0 = *(const float2*)(p.rope + (rp * 16 + fr) * 2);
          const float2 cs1 = *(const float2*)(p.rope + (cp * 16 + fr) * 2);
          float n0_ = v0 * cs0.x - v1 * cs0.y, n1_ = v0 * cs0.y + v1 * cs0.x;
          float n2_ = v2 * cs1.x - v3 * cs1.y, n3_ = v2 * cs1.y + v3 * cs1.x;
          v0 = n0_; v1 = n1_; v2 = n2_; v3 = n3_;
        }
        if (cbase < 384) { v0 *= 0.125f; v1 *= 0.125f; v2 *= 0.125f; v3 *= 0.125f; }
        bf16_t* o = wbuf + (i * 16 + fq * 4 + j) * 72 + fr;
        o[0] = f2bf(v0); o[16] = f2bf(v1); o[32] = f2bf(v2); o[48] = f2bf(v3);
      }
    }
    __builtin_amdgcn_wave_barrier();
    {
      const int ch = lane & 7;
      const bool chv = (cbase + ch * 8) < 3600;
      const bool halo = (cbase >= 2688) && (cbase + 64 <= 3584);
#pragma unroll
      for (int t = 0; t < 8; ++t) {
        const int rl = (lane >> 3) + 8 * t;
        const uint4 v = *(const uint4*)(wbuf + rl * 72 + ch * 8);
        const int r = m0 + wr * 64 + rl;
        if (chv) *(uint4*)(dst + (size_t)r * ld + coff + ch * 8) = v;
        if (halo) {
          const int pp = r % TPB, q34 = pp % 34, t34 = pp / 34, bb = r / TPB;
          if (q34 == 33 && t34 + 1 < 128) *(uint4*)(p.HALO + ((size_t)(bb * 128 + t34 + 1) * 2 + 0) * 896 + coff + ch * 8) = v;
          if (q34 == 0 && t34 >= 1) *(uint4*)(p.HALO + ((size_t)(bb * 128 + t34 - 1) * 2 + 1) * 896 + coff + ch * 8) = v;
        }
      }
    }
  __syncthreads();
}

__device__ __forceinline__ void phase_inproj(const Params& p, int l, unsigned char* smem) {
  if ((gridDim.x & 7) == 0) {
    const int x = blockIdx.x & 7, slot = blockIdx.x >> 3, nslot = gridDim.x >> 3;
    for (int j = slot; j < 17 * 24; j += nslot) { const int ne = j % 24; gemm_tile<0>(p, l, (j / 24) * 8 + x, (ne < 16) ? ne : ne + 5, smem); }
  } else {
    for (int t = blockIdx.x; t < 136 * 24; t += gridDim.x) { const int ne = t % 24; gemm_tile<0>(p, l, t / 24, (ne < 16) ? ne : ne + 5, smem); }
  }
}
__device__ __forceinline__ void phase_outproj(const Params& p, int l, unsigned char* smem) {
  if ((gridDim.x & 7) == 0) {
    const int x = blockIdx.x & 7, slot = blockIdx.x >> 3, nslot = gridDim.x >> 3;
    for (int j = slot; j < 17 * 8; j += nslot) {
      const int mt = (j >> 3) * 8 + x, nt = j & 7;
      if (l == 1 && (mt % 34) < 2) continue;
      gemm_tile<1>(p, l, mt, nt, smem);
    }
  } else {
    for (int t = blockIdx.x; t < 136 * 8; t += gridDim.x) {
      int mt = t >> 3, nt = t & 7;
      if (l == 1 && (mt % 34) < 2) continue;
      gemm_tile<1>(p, l, mt, nt, smem);
    }
  }
}

#define PRE_ARR ((size_t)TOK * 512)
__device__ __forceinline__ void rwkv_prep_tile(const Params& p, int l, int tile, unsigned char* smem) {
  const int d = tile & 1, tb = (tile >> 1) % 136, b = tile / 272;
  bf16_t* raw = (bf16_t*)smem;
  bf16_t* Aw = raw + 34 * 384;
  bf16_t* Aa = Aw + 32 * 72;
  const int tid = launder(threadIdx.x), lane = tid & 63, w = tid >> 6, fr = lane & 15, fq = lane >> 4;
  const int p0 = tb * 32;
  const int slo = (p0 < 256) ? 0 : 256, shi = (p0 < 256) ? 255 : 4351;
  const size_t rowbase = (size_t)b * TPB;
  const int ld2 = l * 2 + d;
  for (int q = tid; q < 34 * 48; q += 256) {
    const int rr = q / 48, cc = q % 48;
    const int tr = p0 - 1 + rr;
    const int col = (cc < 32) ? (256 + cc * 8) : ((cc < 40) ? (768 + d * 64 + (cc - 32) * 8) : (896 + d * 64 + (cc - 40) * 8));
    uint4 v = make_uint4(0, 0, 0, 0);
    if (tr >= slo && tr <= shi) v = *(const uint4*)(p.PR + (rowbase + tr) * 1024 + col);
    *(uint4*)(raw + rr * 384 + cc * 8) = v;
  }
  __syncthreads();
  const float* mu0 = p.rwkv_mu + (size_t)(l * 2 + 0) * 1024;
  const float* mu1 = p.rwkv_mu + (size_t)(l * 2 + 1) * 1024;
  {
    const int ca = tid & 63;
    const float m0wd = mu0[768 + d * 64 + ca], m1wd = mu1[768 + d * 64 + ca];
    const float m0ad = mu0[896 + d * 64 + ca], m1ad = mu1[896 + d * 64 + ca];
#pragma unroll 2
    for (int it = 0; it < 8; ++it) {
      const int i = w + 4 * it;
      const bf16_t* r0 = raw + (i + 1) * 384 + ca;
      float u = bf2f(r0[256]), up = bf2f(r0[256 - 384]), un = bf2f(r0[256 + 384]);
      Aw[i * 72 + ca] = f2bf(tanhf_(u + m0wd * (up - u) + m1wd * (un - u)));
      u = bf2f(r0[320]); up = bf2f(r0[320 - 384]); un = bf2f(r0[320 + 384]);
      Aa[i * 72 + ca] = f2bf(u + m0ad * (up - u) + m1ad * (un - u));
    }
  }
  __syncthreads();
  bf16x8 aw[2][2], aa[2][2];
#pragma unroll
  for (int mt = 0; mt < 2; ++mt)
#pragma unroll
    for (int ks = 0; ks < 2; ++ks) {
      aw[mt][ks] = *(const bf16x8*)(Aw + (mt * 16 + fr) * 72 + ks * 32 + fq * 8);
      aa[mt][ks] = *(const bf16x8*)(Aa + (mt * 16 + fr) * 72 + ks * 32 + fq * 8);
    }
  float kkr[2][4][4];
  float ssq[2][4];
#pragma unroll
  for (int mt = 0; mt < 2; ++mt)
#pragma unroll
    for (int j = 0; j < 4; ++j) ssq[mt][j] = 0.f;
#pragma unroll
  for (int nt = 0; nt < 4; ++nt) {
    const int c = w * 64 + nt * 16 + fr;
    const float m0k = mu0[256 + c], m1k = mu1[256 + c], kkc = p.rwkv_k_k[ld2 * 256 + c];
#pragma unroll
    for (int mt = 0; mt < 2; ++mt)
#pragma unroll
      for (int j = 0; j < 4; ++j) {
        const int i = mt * 16 + fq * 4 + j;
        const bf16_t* r0 = raw + (i + 1) * 384 + c;
        const float u = bf2f(r0[0]), up = bf2f(r0[-384]), un = bf2f(r0[384]);
        const float kq = (u + m0k * (up - u) + m1k * (un - u)) * kkc;
        kkr[mt][nt][j] = kq;
        ssq[mt][j] += kq * kq;
      }
  }
  float inv[2][4];
#pragma unroll
  for (int mt = 0; mt < 2; ++mt)
#pragma unroll
    for (int j = 0; j < 4; ++j) {
      const float tot = sum16(ssq[mt][j]);
      inv[mt][j] = frcp(fmaxf(__builtin_amdgcn_sqrtf(tot), 1e-12f));
    }
  __syncthreads();
  bf16_t* stg = (bf16_t*)smem;
#pragma unroll
  for (int nt = 0; nt < 4; ++nt) {
    const int c = w * 64 + nt * 16 + fr;
    const bf16_t* wup = p.WupT + ((size_t)(ld2 * 256 + c)) * 64 + fq * 8;
    const bf16_t* aup = p.AupT + ((size_t)(ld2 * 256 + c)) * 64 + fq * 8;
    const bf16x8 bw0 = *(const bf16x8*)wup, bw1 = *(const bf16x8*)(wup + 32);
    const bf16x8 ba0 = *(const bf16x8*)aup, ba1 = *(const bf16x8*)(aup + 32);
    const float w0c = p.rwkv_w0[ld2 * 256 + c], a0c = p.rwkv_a0[ld2 * 256 + c];
#pragma unroll
    for (int mt = 0; mt < 2; ++mt) {
      f32x4 accw = (f32x4){0.f, 0.f, 0.f, 0.f}, acca = (f32x4){0.f, 0.f, 0.f, 0.f};
      accw = MFMA(aw[mt][0], bw0, accw);
      accw = MFMA(aw[mt][1], bw1, accw);
      acca = MFMA(aa[mt][0], ba0, acca);
      acca = MFMA(aa[mt][1], ba1, acca);
#pragma unroll
      for (int j = 0; j < 4; ++j) {
        const int i = mt * 16 + fq * 4 + j;
        const float ew = 0.6065306597f * sigmoidf_(w0c + accw[j]);
        const float a = sigmoidf_(a0c + acca[j]);
        const float kk = kkr[mt][nt][j] * inv[mt][j];
        bf16_t* o = stg + i * 264 + c;
        o[0] = f2bf(ew);
        o[32 * 264] = f2bf(a);
        o[2 * 32 * 264] = f2bf(kk);
      }
    }
  }
  __syncthreads();
#pragma unroll
  for (int t = 0; t < 12; ++t) {
    const int q = tid + 256 * t;
    const int arr = q >> 10, i = (q >> 5) & 31, ch = q & 31;
    const uint4 v = *(const uint4*)(stg + (arr * 32 + i) * 264 + ch * 8);
    *(uint4*)(p.PRE + (size_t)arr * PRE_ARR + ((rowbase + p0 + i) * 2 + d) * 256 + ch * 8) = v;
  }
  __syncthreads();
}
__device__ __forceinline__ void ssd_conv_tile(const Params& p, int l, int tile, unsigned char* smem);
__device__ __forceinline__ void ssd_dtcum_tile(const Params& p, int l, int tile, unsigned char* smem);
__device__ __forceinline__ void phase_rwkvprep(const Params& p, int l, unsigned char* smem) {
  for (int t = blockIdx.x; t < 1088 + 512 + 544; t += gridDim.x) {
    if (t < 1088) rwkv_prep_tile(p, l, t, smem);
    else if (t < 1600) ssd_conv_tile(p, l, t - 1088, smem);
    else ssd_dtcum_tile(p, l, t - 1600, smem);
  }
}

typedef float v2f __attribute__((ext_vector_type(2)));
template <bool DUAL>
__device__ __forceinline__ void rwkv_tile(const Params& p, int l, int tile, unsigned char* smem) {
  const int part = tile >> 7;
  const int rg = tile & 3, h = (tile >> 2) & 3, b = (tile >> 4) & 3, d = (tile >> 6) & 1;
  const int cbeg = (part == 0) ? 0 : CSPLIT, cend = (part == 0) ? CSPLIT : 136;
  bf16_t* raw = (bf16_t*)smem;
  bf16_t* pre = raw + 34 * 192;
  float* rec = (float*)(smem + 13056 + 12288);
  const int tid = launder(threadIdx.x), lane = tid & 63, w = tid >> 6, fr = lane & 15, fq = lane >> 4;
  const int row = rg * 16 + w * 4 + fq;
  const int c0 = fr * 4;
  const int ld2 = l * 2 + d;
  const size_t rowbase = (size_t)b * TPB;
  const int lc = (tid & 15) * 4;
  const float* mu0 = p.rwkv_mu + (size_t)(l * 2 + 0) * 1024 + h * 64 + lc;
  const float* mu1 = p.rwkv_mu + (size_t)(l * 2 + 1) * 1024 + h * 64 + lc;
  const float4 m0r = *(const float4*)mu0, m1r = *(const float4*)mu1;
  const float4 m0k = *(const float4*)(mu0 + 256), m1k = *(const float4*)(mu1 + 256);
  const float4 m0v = *(const float4*)(mu0 + 512), m1v = *(const float4*)(mu1 + 512);
  const float4 ka4 = *(const float4*)(p.rwkv_k_a + ld2 * 256 + h * 64 + lc);
  v2f sA = {0.f, 0.f}, sB = {0.f, 0.f};
  v2f iA = {(row == c0) ? 1.f : 0.f, (row == c0 + 1) ? 1.f : 0.f}, iB = {(row == c0 + 2) ? 1.f : 0.f, (row == c0 + 3) ? 1.f : 0.f};
  const int pcc = tid % 24, prow = tid / 24;
  const bool pact = tid < 240;
  const bf16_t* rbase_g = p.PR + rowbase * 1024 + (pcc >> 3) * 256 + h * 64 + (pcc & 7) * 8;
  const bf16_t* pbase_g = p.PRE + (size_t)(pcc >> 3) * PRE_ARR + (rowbase * 2 + d) * 256 + h * 64 + (pcc & 7) * 8;
  uint4 pf0, pf1, pf2, pf3, pg0, pg1, pg2, pg3;
#define RW_GEOM(cix_, plo_, slo_, shi_)                                                   \
  {                                                                                       \
    const int st0_ = (cix_) * 32;                                                         \
    if (st0_ < 256) { slo_ = 0; shi_ = 255; plo_ = (d == 0) ? st0_ : 224 - st0_; }         \
    else { slo_ = 256; shi_ = 4351; plo_ = (d == 0) ? st0_ : 4576 - st0_; }                \
  }
#define RW_PF1(dst_, rr_, plo_, slo_, shi_)                                                         \
  {                                                                                                 \
    const int tr_ = (plo_) - 1 + (rr_);                                                             \
    dst_ = make_uint4(0, 0, 0, 0);                                                                  \
    if (pact && (rr_) < 34 && tr_ >= (slo_) && tr_ <= (shi_)) dst_ = *(const uint4*)(rbase_g + (size_t)tr_ * 1024); \
  }
#define RW_PG1(dst_, rr_, plo_)                                                                     \
  {                                                                                                 \
    dst_ = make_uint4(0, 0, 0, 0);                                                                  \
    if (pact && (rr_) < 32) dst_ = *(const uint4*)(pbase_g + (size_t)((plo_) + (rr_)) * 512);       \
  }
#define RW_PREFETCH(cix_)                                                                 \
  {                                                                                       \
    int plo_, slo_, shi_;                                                                 \
    RW_GEOM(cix_, plo_, slo_, shi_);                                                      \
    RW_PF1(pf0, prow, plo_, slo_, shi_); RW_PF1(pf1, prow + 10, plo_, slo_, shi_);        \
    RW_PF1(pf2, prow + 20, plo_, slo_, shi_); RW_PF1(pf3, prow + 30, plo_, slo_, shi_);   \
    RW_PG1(pg0, prow, plo_); RW_PG1(pg1, prow + 10, plo_);                                \
    RW_PG1(pg2, prow + 20, plo_); RW_PG1(pg3, prow + 30, plo_);                           \
  }
#define RW_STASH()                                                                        \
  {                                                                                       \
    if (pact) {                                                                           \
      *(uint4*)(raw + prow * 192 + pcc * 8) = pf0;                                        \
      *(uint4*)(raw + (prow + 10) * 192 + pcc * 8) = pf1;                                 \
      *(uint4*)(raw + (prow + 20) * 192 + pcc * 8) = pf2;                                 \
      if (prow + 30 < 34) *(uint4*)(raw + (prow + 30) * 192 + pcc * 8) = pf3;             \
      *(uint4*)(pre + prow * 192 + pcc * 8) = pg0;                                        \
      *(uint4*)(pre + (prow + 10) * 192 + pcc * 8) = pg1;                                 \
      *(uint4*)(pre + (prow + 20) * 192 + pcc * 8) = pg2;                                 \
      if (prow + 30 < 32) *(uint4*)(pre + (prow + 30) * 192 + pcc * 8) = pg3;             \
    }                                                                                     \
  }
  RW_PREFETCH(cbeg);
  RW_STASH();
  __syncthreads();
  for (int cix = cbeg; cix < cend; ++cix) {
    int plo, slo, shi;
    RW_GEOM(cix, plo, slo, shi);
#pragma unroll
    for (int k = 0; k < 2; ++k) {
      const int i = (tid >> 4) + 16 * k;
      const int ri = (d == 0) ? i + 1 : 32 - i;
      const bf16_t* r0 = raw + ri * 192 + lc;
      const bf16_t* q0 = pre + (ri - 1) * 192 + lc;
      float rs[4], ksv[4], vs[4];
#pragma unroll
      for (int sl = 0; sl < 3; ++sl) {
        const uint2 uc = *(const uint2*)(r0 + sl * 64), up = *(const uint2*)(r0 + sl * 64 - 192), un = *(const uint2*)(r0 + sl * 64 + 192);
        const float4 m0 = (sl == 0) ? m0r : ((sl == 1) ? m0k : m0v);
        const float4 m1 = (sl == 0) ? m1r : ((sl == 1) ? m1k : m1v);
        float* dst = (sl == 0) ? rs : ((sl == 1) ? ksv : vs);
        float u, a, n;
        u = __uint_as_float(uc.x << 16); a = __uint_as_float(up.x << 16); n = __uint_as_float(un.x << 16);
        dst[0] = u + m0.x * (a - u) + m1.x * (n - u);
        u = __uint_as_float(uc.x & 0xffff0000u); a = __uint_as_float(up.x & 0xffff0000u); n = __uint_as_float(un.x & 0xffff0000u);
        dst[1] = u + m0.y * (a - u) + m1.y * (n - u);
        u = __uint_as_float(uc.y << 16); a = __uint_as_float(up.y << 16); n = __uint_as_float(un.y << 16);
        dst[2] = u + m0.z * (a - u) + m1.z * (n - u);
        u = __uint_as_float(uc.y & 0xffff0000u); a = __uint_as_float(up.y & 0xffff0000u); n = __uint_as_float(un.y & 0xffff0000u);
        dst[3] = u + m0.w * (a - u) + m1.w * (n - u);
      }
      const uint2 ue = *(const uint2*)(q0), ua = *(const uint2*)(q0 + 64), uk = *(const uint2*)(q0 + 128);
      const float ew[4] = {__uint_as_float(ue.x << 16), __uint_as_float(ue.x & 0xffff0000u), __uint_as_float(ue.y << 16), __uint_as_float(ue.y & 0xffff0000u)};
      const float av[4] = {__uint_as_float(ua.x << 16), __uint_as_float(ua.x & 0xffff0000u), __uint_as_float(ua.y << 16), __uint_as_float(ua.y & 0xffff0000u)};
      const float kk[4] = {__uint_as_float(uk.x << 16), __uint_as_float(uk.x & 0xffff0000u), __uint_as_float(uk.y << 16), __uint_as_float(uk.y & 0xffff0000u)};
      const float kav[4] = {ka4.x, ka4.y, ka4.z, ka4.w};
      float4 o0, o1, o2, o3, o4, o5;
      float* f0 = (float*)&o0; float* f1 = (float*)&o1; float* f2 = (float*)&o2; float* f3 = (float*)&o3; float* f4 = (float*)&o4; float* f5 = (float*)&o5;
#pragma unroll
      for (int e = 0; e < 4; ++e) {
        f0[e] = __expf(-ew[e]);
        f1[e] = kk[e];
        f2[e] = kk[e] * av[e];
        f3[e] = ksv[e] * (1.f + (av[e] - 1.f) * kav[e]);
        f4[e] = rs[e];
        f5[e] = vs[e];
      }
      float* rp = rec + i * 384 + lc;
      *(float4*)(rp) = o0; *(float4*)(rp + 64) = o1; *(float4*)(rp + 128) = o2;
      *(float4*)(rp + 192) = o3; *(float4*)(rp + 256) = o4; *(float4*)(rp + 320) = o5;
    }
    __syncthreads();
    if (cix + 1 < cend) RW_PREFETCH(cix + 1);
    {
      const float* rp = rec + c0;
      const float* vp = rec + 320 + row;
      float4 w4 = *(const float4*)(rp), kk4 = *(const float4*)(rp + 64), kb4 = *(const float4*)(rp + 128);
      float4 kd4 = *(const float4*)(rp + 192), r4 = *(const float4*)(rp + 256);
      float v = vp[0];
      float ykeep = 0.f, gkeep = 0.f;
#pragma unroll 2
      for (int i = 0; i < 32; ++i) {
        const int inx = (i + 1) & 31;
        const float4 nw4 = *(const float4*)(rp + inx * 384), nkk4 = *(const float4*)(rp + inx * 384 + 64), nkb4 = *(const float4*)(rp + inx * 384 + 128);
        const float4 nkd4 = *(const float4*)(rp + inx * 384 + 192), nr4 = *(const float4*)(rp + inx * 384 + 256);
        const float nv = vp[inx * 384];
        v2f t = sA * (v2f){kk4.x, kk4.y};
        t = sB * (v2f){kk4.z, kk4.w} + t;
        float sa = t.x + t.y, ia = 0.f;
        if (DUAL) {
          v2f ti = iA * (v2f){kk4.x, kk4.y};
          ti = iB * (v2f){kk4.z, kk4.w} + ti;
          ia = ti.x + ti.y;
          sa += dppf<0xB1>(sa); ia += dppf<0xB1>(ia);
          sa += dppf<0x4E>(sa); ia += dppf<0x4E>(ia);
          sa += dppf<0x141>(sa); ia += dppf<0x141>(ia);
          sa += dppf<0x140>(sa); ia += dppf<0x140>(ia);
        } else {
          sa = sum16(sa);
        }
        v2f cA = sA * (v2f){w4.x, w4.y} + (v2f){kd4.x, kd4.y} * v;
        v2f cB = sB * (v2f){w4.z, w4.w} + (v2f){kd4.z, kd4.w} * v;
        sA = cA - (v2f){kb4.x, kb4.y} * sa;
        sB = cB - (v2f){kb4.z, kb4.w} * sa;
        v2f u = sA * (v2f){r4.x, r4.y};
        u = sB * (v2f){r4.z, r4.w} + u;
        float y = u.x + u.y, g = 0.f;
        if (DUAL) {
          iA = iA * (v2f){w4.x, w4.y} - (v2f){kb4.x, kb4.y} * ia;
          iB = iB * (v2f){w4.z, w4.w} - (v2f){kb4.z, kb4.w} * ia;
          v2f ui = iA * (v2f){r4.x, r4.y};
          ui = iB * (v2f){r4.z, r4.w} + ui;
          g = ui.x + ui.y;
          y += dppf<0xB1>(y); g += dppf<0xB1>(g);
          y += dppf<0x4E>(y); g += dppf<0x4E>(g);
          y += dppf<0x141>(y); g += dppf<0x141>(g);
          y += dppf<0x140>(y); g += dppf<0x140>(g);
          if (fr == (i & 15)) gkeep = g;
        } else {
          y = sum16(y);
        }
        if (fr == (i & 15)) ykeep = y;
        if ((i & 15) == 15) {
          const int ii = (i & 16) + fr;
          const int ri = (d == 0) ? ii + 1 : 32 - ii;
          const int pi = plo - 1 + ri;
          p.yR[((size_t)d * TOK + rowbase + pi) * 256 + h * 64 + row] = f2bf(ykeep);
          if (DUAL) p.GID[((size_t)(d * 4 + b) * NSEG1 + (cix - CSPLIT) * 32 + ii) * 256 + h * 64 + row] = f2bf(gkeep);
        }
        w4 = nw4; kk4 = nkk4; kb4 = nkb4; kd4 = nkd4; r4 = nr4; v = nv;
      }
    }
    if (cix + 1 < cend) RW_STASH();
    __syncthreads();
  }
  if (part == 0) *(float4*)(p.SMID + ((size_t)(((d * 4 + b) * 4 + h) * 64 + row)) * 64 + c0) = make_float4(sA.x, sA.y, sB.x, sB.y);
}

__device__ __forceinline__ void rwkv_fix_tile(const Params& p, int tile) {
  const int mb = tile % (NSEG1 / 64), dbh = tile / (NSEG1 / 64), h = dbh & 3, b = (dbh >> 2) & 3, d = dbh >> 4;
  const int tid = launder(threadIdx.x), lane = tid & 63, w = tid >> 6, fr = lane & 15, fq = lane >> 4;
  const size_t rowbase = (size_t)b * TPB;
  const int s0 = mb * 64 + 16 * w;
  const bf16_t* gp = p.GID + ((size_t)(d * 4 + b) * NSEG1 + s0 + fr) * 256 + h * 64 + fq * 8;
  const bf16x8 a0 = *(const bf16x8*)gp, a1 = *(const bf16x8*)(gp + 32);
#pragma unroll
  for (int nt = 0; nt < 4; ++nt) {
    const float* sp = p.SMID + ((size_t)(dbh * 64 + nt * 16 + fr)) * 64 + fq * 8;
    const float4 f0 = *(const float4*)sp, f1 = *(const float4*)(sp + 4), f2 = *(const float4*)(sp + 32), f3 = *(const float4*)(sp + 36);
    union { unsigned u[4]; bf16x8 v; } b0, b1;
    b0.u[0] = pack2(f0.x, f0.y); b0.u[1] = pack2(f0.z, f0.w); b0.u[2] = pack2(f1.x, f1.y); b0.u[3] = pack2(f1.z, f1.w);
    b1.u[0] = pack2(f2.x, f2.y); b1.u[1] = pack2(f2.z, f2.w); b1.u[2] = pack2(f3.x, f3.y); b1.u[3] = pack2(f3.z, f3.w);
    f32x4 acc = (f32x4){0.f, 0.f, 0.f, 0.f};
    acc = MFMA(a0, b0.v, acc);
    acc = MFMA(a1, b1.v, acc);
#pragma unroll
    for (int j = 0; j < 4; ++j) {
      const int st = CSPLIT * 32 + s0 + fq * 4 + j;
      const int pp = (d == 0) ? st : ((st < 256) ? 255 - st : 4607 - st);
      bf16_t* yp = p.yR + ((size_t)d * TOK + rowbase + pp) * 256 + h * 64 + nt * 16 + fr;
      *yp = f2bf(bf2f(*yp) + acc[j]);
    }
  }
}
__device__ __forceinline__ void phase_rwkvfix(const Params& p) {
  for (int t = blockIdx.x; t < 32 * (NSEG1 / 64); t += gridDim.x) rwkv_fix_tile(p, t);
}

__device__ __forceinline__ void ssd_conv_tile(const Params& p, int l, int tile, unsigned char* smem) {
  const int b = tile >> 7, t34 = tile & 127, pp0 = t34 * 34;
  const size_t r0 = (size_t)b * TPB + pp0;
  bf16_t* T = (bf16_t*)smem;
  const int tid = launder(threadIdx.x);
  for (int q = tid; q < 34 * 112; q += 256) {
    const int rr = q / 112, cc = q % 112;
    *(uint4*)(T + (rr + 1) * 896 + cc * 8) = *(const uint4*)(p.PS + (r0 + rr) * 912 + cc * 8);
  }
  if (tid < 224) {
    const int which = tid / 112, cc = tid % 112;
    const bool ex = (which == 0) ? (t34 >= 1) : (t34 + 1 < 128);
    uint4 v = make_uint4(0, 0, 0, 0);
    if (ex) v = *(const uint4*)(p.HALO + ((size_t)(b * 128 + t34) * 2 + which) * 896 + cc * 8);
    *(uint4*)(T + (which ? 35 : 0) * 896 + cc * 8) = v;
  }
  __syncthreads();
  const float* cw = p.ssm_conv_w + (size_t)l * 3 * 896;
  const float* cb = p.ssm_conv_b + (size_t)l * 896;
  if (tid < 224) {
    const int g8 = tid % 112, rpar = tid / 112, c0 = g8 * 8;
    float w0[8], w1[8], w2[8], bs[8];
#pragma unroll
    for (int e = 0; e < 8; ++e) { w0[e] = cw[c0 + e]; w1[e] = cw[896 + c0 + e]; w2[e] = cw[1792 + c0 + e]; bs[e] = cb[c0 + e]; }
#pragma unroll 1
    for (int rr = rpar; rr < 34; rr += 2) {
      const uint4 um = *(const uint4*)(T + rr * 896 + c0), u0 = *(const uint4*)(T + (rr + 1) * 896 + c0), up = *(const uint4*)(T + (rr + 2) * 896 + c0);
      const int pp = pp0 + rr;
      const float pv = ((pp != 0) && (pp != 256)) ? 1.f : 0.f, nv = ((pp != 255) && (pp != 4351)) ? 1.f : 0.f;
      const unsigned am[4] = {um.x, um.y, um.z, um.w}, a0[4] = {u0.x, u0.y, u0.z, u0.w}, ap[4] = {up.x, up.y, up.z, up.w};
      unsigned o[4];
#pragma unroll
      for (int e = 0; e < 4; ++e) {
        const float va = w0[2 * e] * (pv * blo(am[e])) + w1[2 * e] * blo(a0[e]) + w2[2 * e] * (nv * blo(ap[e])) + bs[2 * e];
        const float vb = w0[2 * e + 1] * (pv * bhi(am[e])) + w1[2 * e + 1] * bhi(a0[e]) + w2[2 * e + 1] * (nv * bhi(ap[e])) + bs[2 * e + 1];
        o[e] = pack2(siluf_(va), siluf_(vb));
      }
      *(uint4*)(p.PS + (r0 + rr) * 912 + c0) = make_uint4(o[0], o[1], o[2], o[3]);
    }
  }
  __syncthreads();
}
__device__ __forceinline__ void ssd_dtcum_tile(const Params& p, int l, int tile, unsigned char* smem) {
  const int b = tile / 136, c32 = tile % 136, p0 = c32 * 32;
  float* draw = (float*)smem;
  const int tid = launder(threadIdx.x);
  for (int q = tid; q < 384; q += 256) {
    const int i = q / 12, dh = q % 12;
    draw[q] = bf2f(p.PS[((size_t)b * TPB + p0 + i) * 912 + 896 + dh]);
  }
  __syncthreads();
  if (tid < 12) {
    const int dh = tid, d = dh / 6, h = dh % 6;
    const float a_neg = -__expf(p.ssm_a_log[(l * 2 + d) * 6 + h]);
    const float bias = p.ssm_dt_bias[(l * 2 + d) * 6 + h];
    float cum = 0.f;
    for (int k = 0; k < 32; ++k) {
      const int it = (d == 0) ? k : 31 - k;
      const float dt = softplusf_(draw[it * 12 + dh] + bias);
      cum += dt * a_neg;
      p.DTC[(size_t)dh * TOK + (size_t)b * TPB + p0 + it] = make_float2(dt, cum);
    }
  }
  __syncthreads();
}

__device__ __forceinline__ void ssd_tile(const Params& p, int l, int tile, unsigned char* smem) {
  const int h = tile % 6, b = (tile / 6) & 3, d = tile / 24, g = h / 3;
  bf16_t* Cs0 = (bf16_t*)smem;
  bf16_t* Bs = Cs0 + 2 * 32 * 136;
  bf16_t* Xs = Bs + 32 * 136;
  bf16_t* BtT = Xs + 32 * 72;
  bf16_t* XdT = BtT + 128 * 40;
  bf16_t* Ms = XdT + 64 * 40;
  bf16_t* Sb = Ms + 32 * 40;
  float* dc = (float*)(Sb + 64 * 136);
  const int tid = launder(threadIdx.x), lane = tid & 63, w = tid >> 6, fr = lane & 15, fq = lane >> 4;
  const size_t rowbase = (size_t)b * TPB;
  f32x4 S[4][2];
#pragma unroll
  for (int i = 0; i < 4; ++i)
#pragma unroll
    for (int j = 0; j < 2; ++j) S[i][j] = (f32x4){0.f, 0.f, 0.f, 0.f};
  const int pcc = tid % 40, prow = tid / 40;
  const bool pact = tid < 240;
  const int pcol = (pcc < 16) ? (640 + g * 128 + pcc * 8) : ((pcc < 32) ? (384 + g * 128 + (pcc - 16) * 8) : (h * 64 + (pcc - 32) * 8));
  const bf16_t* pbase = p.PS + rowbase * 912 + pcol;
  const float2* dbase = p.DTC + (size_t)(d * 6 + h) * TOK + rowbase;
  const int drow_stride = (pcc < 32) ? 136 : 72;
  uint4 pf0, pf1, pf2, pf3, pf4, pf5;
  float2 dtc = make_float2(0.f, 0.f);
#define SD_GEOM(cix_, plo_)                                                \
  {                                                                        \
    const int st0_ = (cix_) * 32;                                          \
    if (st0_ < 256) plo_ = (d == 0) ? st0_ : 224 - st0_;                   \
    else plo_ = (d == 0) ? st0_ : 4576 - st0_;                             \
  }
#define SD_PF1(dst_, rr_, plo_)                                                                   \
  {                                                                                               \
    dst_ = make_uint4(0, 0, 0, 0);                                                                \
    if (pact && (rr_) < 32) dst_ = *(const uint4*)(pbase + (size_t)((plo_) + (rr_)) * 912);       \
  }
#define SD_PREFETCH(cix_)                                                          \
  {                                                                                \
    int plo_;                                                                      \
    SD_GEOM(cix_, plo_);                                                           \
    SD_PF1(pf0, prow, plo_); SD_PF1(pf1, prow + 6, plo_); SD_PF1(pf2, prow + 12, plo_); \
    SD_PF1(pf3, prow + 18, plo_); SD_PF1(pf4, prow + 24, plo_); SD_PF1(pf5, prow + 30, plo_); \
    if (tid < 32) dtc = dbase[plo_ + tid];                                         \
  }
#define SD_ST1(src_, rr_, cbuf_)                                                                  \
  {                                                                                               \
    if (pact && (rr_) < 32) {                                                                     \
      const int i_ = (d == 0) ? (rr_) : 31 - (rr_);                                               \
      bf16_t* dst_ = (pcc < 16) ? ((cbuf_) + i_ * 136 + pcc * 8) : ((pcc < 32) ? (Bs + i_ * 136 + (pcc - 16) * 8) : (Xs + i_ * 72 + (pcc - 32) * 8)); \
      *(uint4*)dst_ = src_;                                                                       \
    }                                                                                             \
  }
#define SD_STASH(buf_)                                                              \
  {                                                                                 \
    bf16_t* cbuf_ = Cs0 + (buf_) * 32 * 136;                                        \
    SD_ST1(pf0, prow, cbuf_); SD_ST1(pf1, prow + 6, cbuf_); SD_ST1(pf2, prow + 12, cbuf_); \
    SD_ST1(pf3, prow + 18, cbuf_); SD_ST1(pf4, prow + 24, cbuf_); SD_ST1(pf5, prow + 30, cbuf_); \
    if (tid < 32) {                                                                 \
      const int i_ = (d == 0) ? tid : 31 - tid;                                     \
      dc[(buf_) * 64 + i_] = dtc.x;                                                 \
      dc[(buf_) * 64 + 32 + i_] = dtc.y;                                            \
    }                                                                               \
  }
  (void)drow_stride;
  SD_PREFETCH(0);
  SD_STASH(0);
  __syncthreads();
  for (int cix = 0; cix < 136; ++cix) {
    int plo;
    SD_GEOM(cix, plo);
    const int buf = cix & 1;
    const bf16_t* Cs = Cs0 + buf * 32 * 136;
    const float* dts = dc + buf * 64;
    const float* cums = dts + 32;
    {
      const int j = tid & 31, ng = tid >> 5;
      const float tail = __expf(cums[31] - cums[j]);
      const float dtj = dts[j];
      const uint4 b0 = *(const uint4*)(Bs + j * 136 + ng * 16), b1 = *(const uint4*)(Bs + j * 136 + ng * 16 + 8);
      const uint4 x0 = *(const uint4*)(Xs + j * 72 + ng * 8);
      const unsigned bw[8] = {b0.x, b0.y, b0.z, b0.w, b1.x, b1.y, b1.z, b1.w};
      const unsigned xw[4] = {x0.x, x0.y, x0.z, x0.w};
#pragma unroll
      for (int e = 0; e < 8; ++e) {
        const unsigned pk = pack2(__uint_as_float(bw[e] << 16) * tail, __uint_as_float(bw[e] & 0xffff0000u) * tail);
        BtT[(ng * 16 + 2 * e) * 40 + j] = (bf16_t)(pk & 0xffffu);
        BtT[(ng * 16 + 2 * e + 1) * 40 + j] = (bf16_t)(pk >> 16);
      }
#pragma unroll
      for (int e = 0; e < 4; ++e) {
        const unsigned pk = pack2(__uint_as_float(xw[e] << 16) * dtj, __uint_as_float(xw[e] & 0xffff0000u) * dtj);
        XdT[(ng * 8 + 2 * e) * 40 + j] = (bf16_t)(pk & 0xffffu);
        XdT[(ng * 8 + 2 * e + 1) * 40 + j] = (bf16_t)(pk >> 16);
      }
#pragma unroll
      for (int mt = 0; mt < 4; ++mt)
#pragma unroll
        for (int t = 0; t < 2; ++t)
#pragma unroll
          for (int jj = 0; jj < 4; ++jj) Sb[(mt * 16 + fq * 4 + jj) * 136 + (2 * w + t) * 16 + fr] = f2bf(S[mt][t][jj]);
      const int mi = w >> 1, nj = w & 1;
      f32x4 acc = (f32x4){0.f, 0.f, 0.f, 0.f};
#pragma unroll
      for (int ks = 0; ks < 4; ++ks) {
        bf16x8 a = *(const bf16x8*)(Cs + (mi * 16 + fr) * 136 + ks * 32 + fq * 8);
        bf16x8 bb = *(const bf16x8*)(Bs + (nj * 16 + fr) * 136 + ks * 32 + fq * 8);
        acc = MFMA(a, bb, acc);
      }
      const int jc = nj * 16 + fr;
      const float cj = cums[jc];
#pragma unroll
      for (int jj = 0; jj < 4; ++jj) {
        const int i = mi * 16 + fq * 4 + jj;
        const float v = (jc <= i) ? acc[jj] * __expf(cums[i] - cj) : 0.f;
        Ms[i * 40 + jc] = f2bf(v);
      }
    }
    __syncthreads();
    if (cix + 1 < 136) SD_PREFETCH(cix + 1);
    {
      const int mi = w >> 1;
      bf16x8 am = *(const bf16x8*)(Ms + (mi * 16 + fr) * 40 + fq * 8);
      bf16x8 ac[4];
#pragma unroll
      for (int ks = 0; ks < 4; ++ks) ac[ks] = *(const bf16x8*)(Cs + (mi * 16 + fr) * 136 + ks * 32 + fq * 8);
#pragma unroll
      for (int t = 0; t < 2; ++t) {
        const int pt = 2 * (w & 1) + t;
        f32x4 y1 = (f32x4){0.f, 0.f, 0.f, 0.f}, y2 = (f32x4){0.f, 0.f, 0.f, 0.f};
        bf16x8 bx = *(const bf16x8*)(XdT + (pt * 16 + fr) * 40 + fq * 8);
        y1 = MFMA(am, bx, y1);
#pragma unroll
        for (int ks = 0; ks < 4; ++ks) {
          bf16x8 bs = *(const bf16x8*)(Sb + (pt * 16 + fr) * 136 + ks * 32 + fq * 8);
          y2 = MFMA(ac[ks], bs, y2);
        }
#pragma unroll
        for (int jj = 0; jj < 4; ++jj) {
          const int i = mi * 16 + fq * 4 + jj;
          const int pi = plo + ((d == 0) ? i : 31 - i);
          const float y = y1[jj] + __expf(cums[i]) * y2[jj];
          p.yS[((size_t)d * TOK + rowbase + pi) * 384 + h * 64 + pt * 16 + fr] = f2bf(y);
        }
      }
      const float dec = __expf(cums[31]);
      bf16x8 bt[2];
#pragma unroll
      for (int t = 0; t < 2; ++t) bt[t] = *(const bf16x8*)(BtT + ((2 * w + t) * 16 + fr) * 40 + fq * 8);
#pragma unroll
      for (int mt = 0; mt < 4; ++mt) {
        bf16x8 ax = *(const bf16x8*)(XdT + (mt * 16 + fr) * 40 + fq * 8);
#pragma unroll
        for (int t = 0; t < 2; ++t) {
          S[mt][t] *= dec;
          S[mt][t] = MFMA(ax, bt[t], S[mt][t]);
        }
      }
    }
    if (cix + 1 < 136) SD_STASH(buf ^ 1);
    __syncthreads();
  }
}

__device__ __forceinline__ void attn_tile(const Params& p, int l, int tile, unsigned char* smem) {
  const bool isctx = tile >= 768;
  int qt, head, b;
  if (!isctx) { qt = tile & 31; head = (tile >> 5) % 6; b = tile / 192; }
  else { int tt = tile - 768; qt = tt & 1; head = (tt >> 1) % 6; b = tt / 12; }
  const int hkv = head / 3;
  const int tid = launder(threadIdx.x), lane = tid & 63, w = tid >> 6, fr = lane & 15, fq = lane >> 4;
  bf16_t* Ks = (bf16_t*)smem;
  bf16_t* Vt = Ks + 64 * 72;
  bf16_t* Ps = Vt + 64 * 72 + w * 32 * 72;
  const int q0 = qt * 128;
  const size_t rowb = (size_t)b * TPB;
  const size_t rowq0 = rowb + (isctx ? q0 : 256 + q0);
  bf16x8 qf[2][2];
  float m[2][4], ls[2][4];
  f32x4 o[2][4];
  const float sk = p.attn_sink[l * 6 + head];
#pragma unroll
  for (int mt = 0; mt < 2; ++mt) {
    const int qi0 = (2 * w + mt) * 16;
#pragma unroll
    for (int ks = 0; ks < 2; ++ks) qf[mt][ks] = *(const bf16x8*)(p.PA + (rowq0 + qi0 + fr) * 1024 + head * 64 + ks * 32 + fq * 8);
#pragma unroll
    for (int j = 0; j < 4; ++j) { m[mt][j] = sk; ls[mt][j] = 1.f; }
#pragma unroll
    for (int nt = 0; nt < 4; ++nt) o[mt][nt] = (f32x4){0.f, 0.f, 0.f, 0.f};
  }
  int klo = 0, nb = 0;
  if (!isctx) {
    klo = max(0, q0 - 128);
    const int khi = min(4096, q0 + 256);
    nb = (khi - klo) >> 6;
  }
  const int ntile = nb + 4;
  const int lr = tid >> 3, lc = tid & 7;
  uint4 kr0, kr1, vr0, vr1;
#define KVLOAD(kt_)                                                                              \
  {                                                                                              \
    const size_t kr0_ = ((kt_) < nb) ? rowb + 256 + klo + (kt_) * 64 : rowb + ((kt_) - nb) * 64; \
    const bf16_t* src0 = p.PA + (kr0_ + lr) * 1024 + 384 + hkv * 64 + lc * 8;                    \
    const bf16_t* src1 = src0 + 32 * 1024;                                                       \
    kr0 = *(const uint4*)src0;                                                                   \
    vr0 = *(const uint4*)(src0 + 128);                                                           \
    kr1 = *(const uint4*)src1;                                                                   \
    vr1 = *(const uint4*)(src1 + 128);                                                           \
  }
#define VTSTORE(vr_, rr_)                                                 \
  {                                                                       \
    Vt[(lc * 8 + 0) * 72 + (rr_)] = (bf16_t)((vr_).x & 0xffffu);          \
    Vt[(lc * 8 + 1) * 72 + (rr_)] = (bf16_t)((vr_).x >> 16);              \
    Vt[(lc * 8 + 2) * 72 + (rr_)] = (bf16_t)((vr_).y & 0xffffu);          \
    Vt[(lc * 8 + 3) * 72 + (rr_)] = (bf16_t)((vr_).y >> 16);              \
    Vt[(lc * 8 + 4) * 72 + (rr_)] = (bf16_t)((vr_).z & 0xffffu);          \
    Vt[(lc * 8 + 5) * 72 + (rr_)] = (bf16_t)((vr_).z >> 16);              \
    Vt[(lc * 8 + 6) * 72 + (rr_)] = (bf16_t)((vr_).w & 0xffffu);          \
    Vt[(lc * 8 + 7) * 72 + (rr_)] = (bf16_t)((vr_).w >> 16);              \
  }
  KVLOAD(0);
  for (int kt = 0; kt < ntile; ++kt) {
    __syncthreads();
    *(uint4*)(Ks + lr * 72 + lc * 8) = kr0;
    *(uint4*)(Ks + (lr + 32) * 72 + lc * 8) = kr1;
    VTSTORE(vr0, lr);
    VTSTORE(vr1, lr + 32);
    __syncthreads();
    if (kt + 1 < ntile) KVLOAD(kt + 1);
    f32x4 s[2][4];
#pragma unroll
    for (int mt = 0; mt < 2; ++mt)
#pragma unroll
      for (int nt = 0; nt < 4; ++nt) s[mt][nt] = (f32x4){0.f, 0.f, 0.f, 0.f};
#pragma unroll
    for (int ks = 0; ks < 2; ++ks) {
#pragma unroll
      for (int nt = 0; nt < 4; ++nt) {
        bf16x8 kb = *(const bf16x8*)(Ks + (nt * 16 + fr) * 72 + ks * 32 + fq * 8);
#pragma unroll
        for (int mt = 0; mt < 2; ++mt) s[mt][nt] = MFMA(qf[mt][ks], kb, s[mt][nt]);
      }
    }
    const bool band = kt < nb;
    const int kp0 = klo + kt * 64 + fr;
#pragma unroll
    for (int mt = 0; mt < 2; ++mt) {
      const int qi0 = (2 * w + mt) * 16;
#pragma unroll
      for (int j = 0; j < 4; ++j) {
        const int qp = q0 + qi0 + fq * 4 + j;
        float sv0 = s[mt][0][j], sv1 = s[mt][1][j], sv2 = s[mt][2][j], sv3 = s[mt][3][j];
        if (band) {
          const int dlt = qp - kp0;
          if (dlt > 128 || dlt < -128) sv0 = -INFINITY;
          if (dlt - 16 > 128 || dlt - 16 < -128) sv1 = -INFINITY;
          if (dlt - 32 > 128 || dlt - 32 < -128) sv2 = -INFINITY;
          if (dlt - 48 > 128 || dlt - 48 < -128) sv3 = -INFINITY;
        }
        float mx = fmaxf(fmaxf(sv0, sv1), fmaxf(sv2, sv3));
        mx = max16(mx);
        const float mn = fmaxf(m[mt][j], mx);
        const float alpha = __expf(m[mt][j] - mn);
        const float p0 = __expf(sv0 - mn), p1 = __expf(sv1 - mn), p2 = __expf(sv2 - mn), p3 = __expf(sv3 - mn);
        bf16_t* pr = Ps + (mt * 16 + fq * 4 + j) * 72 + fr;
        pr[0] = f2bf(p0); pr[16] = f2bf(p1); pr[32] = f2bf(p2); pr[48] = f2bf(p3);
        const float rsum = sum16(p0 + p1 + p2 + p3);
        ls[mt][j] = ls[mt][j] * alpha + rsum;
        m[mt][j] = mn;
#pragma unroll
        for (int nt = 0; nt < 4; ++nt) o[mt][nt][j] *= alpha;
      }
    }
    __builtin_amdgcn_wave_barrier();
#pragma unroll
    for (int ks = 0; ks < 2; ++ks) {
      bf16x8 pa[2];
#pragma unroll
      for (int mt = 0; mt < 2; ++mt) pa[mt] = *(const bf16x8*)(Ps + (mt * 16 + fr) * 72 + ks * 32 + fq * 8);
#pragma unroll
      for (int nt = 0; nt < 4; ++nt) {
        bf16x8 vb = *(const bf16x8*)(Vt + (nt * 16 + fr) * 72 + ks * 32 + fq * 8);
#pragma unroll
        for (int mt = 0; mt < 2; ++mt) o[mt][nt] = MFMA(pa[mt], vb, o[mt][nt]);
      }
    }
    __builtin_amdgcn_wave_barrier();
  }
#pragma unroll
  for (int mt = 0; mt < 2; ++mt) {
    const int qi0 = (2 * w + mt) * 16;
#pragma unroll
    for (int j = 0; j < 4; ++j) {
      const size_t r = rowq0 + qi0 + fq * 4 + j;
      const float inv = frcp(ls[mt][j]);
#pragma unroll
      for (int nt = 0; nt < 4; ++nt) {
        const int dc = nt * 16 + fr;
        const float gt = bf2f(p.PA[r * 1024 + 640 + head * 64 + dc]);
        p.PA[r * 1024 + head * 64 + dc] = f2bf(o[mt][nt][j] * inv * siluf_(gt));
      }
    }
  }
  __syncthreads();
}

#ifndef PROBE_DUP
#define PROBE_DUP 0
#endif
__device__ __forceinline__ void phase_probe(const Params& p, int l, unsigned char* smem) {
  if (PROBE_DUP == 1) { for (int t = blockIdx.x; t < 256; t += gridDim.x) { if (t < 128) rwkv_tile<false>(p, l, t, smem); else rwkv_tile<true>(p, l, t, smem); } }
  if (PROBE_DUP == 2) { for (int t = blockIdx.x; t < 48; t += gridDim.x) ssd_tile(p, l, t, smem); }
}
__device__ __forceinline__ void phase_mixers(const Params& p, int l, unsigned char* smem) {
  const int natt = (l == 0) ? 816 : 768;
  const int bid = blockIdx.x, G = gridDim.x;
  if (G == 512) {
    if (bid < 128) {
      __builtin_amdgcn_s_setprio(3);
      rwkv_tile<false>(p, l, bid, smem);
      __builtin_amdgcn_s_setprio(0);
    } else if (bid < 256) {
      __builtin_amdgcn_s_setprio(3);
      rwkv_tile<true>(p, l, bid, smem);
      __builtin_amdgcn_s_setprio(0);
    } else if (bid < 304) {
      __builtin_amdgcn_s_setprio(2);
      ssd_tile(p, l, bid - 256, smem);
      __builtin_amdgcn_s_setprio(0);
    }
    int* tsl = (int*)(smem + 73728);
    const int tid = launder(threadIdx.x);
    if (l == 0) {
      for (;;) {
        __syncthreads();
        if (tid == 0) *tsl = (int)atomicAdd(&p.ctrs[2], 1u);
        __syncthreads();
        const int t = *tsl;
        if (t >= 1440) break;
        deferred_transpose(p, t, smem);
      }
    }
    for (;;) {
      __syncthreads();
      if (tid == 0) *tsl = (int)atomicAdd(&p.ctrs[l], 1u);
      __syncthreads();
      const int t = *tsl;
      if (t >= natt) break;
      attn_tile(p, l, t, smem);
    }
    for (;;) {
      __syncthreads();
      if (tid == 0) *tsl = (int)atomicAdd(&p.ctrs[4 + l], 1u);
      __syncthreads();
      const int j = *tsl;
      if (j >= 136 * 5) break;
      gemm_late_tile(p, l, j / 5, 16 + j % 5, smem);
    }
  } else {
    if (l == 0) for (int t = bid; t < 1440; t += G) deferred_transpose(p, t, smem);
    for (int t = bid; t < 136 * 5; t += G) gemm_late_tile(p, l, t / 5, 16 + t % 5, smem);
    const int total = 304 + natt;
    for (int t = bid; t < total; t += G) {
      if (t < 128) rwkv_tile<false>(p, l, t, smem);
      else if (t < 256) rwkv_tile<true>(p, l, t, smem);
      else if (t < 304) ssd_tile(p, l, t - 256, smem);
      else attn_tile(p, l, t - 304, smem);
    }
  }
}

__device__ __forceinline__ void phase_finish(const Params& p, int l) {
  const int tid = launder(threadIdx.x), lane = tid & 63, w = tid >> 6;
  bf16_t* mix = p.hbuf;
  const int cg_ = lane * 4, hh4 = lane >> 4;
  const float* mu0 = p.rwkv_mu + (size_t)(l * 2) * 1024 + cg_;
  const float* mu1 = mu0 + 1024;
  const float4 m0r = *(const float4*)mu0, m1r = *(const float4*)mu1;
  const float4 m0k = *(const float4*)(mu0 + 256), m1k = *(const float4*)(mu1 + 256);
  const float4 m0v = *(const float4*)(mu0 + 512), m1v = *(const float4*)(mu1 + 512);
  const float4 rk4 = *(const float4*)(p.rwkv_r_k + l * 256 + hh4 * 64 + (cg_ & 63));
  const float4 lw4 = *(const float4*)(p.rwkv_ln_w + l * 256 + cg_), lb4 = *(const float4*)(p.rwkv_ln_b + l * 256 + cg_);
  const int cs_ = lane * 6;
  const float2 nw0 = *(const float2*)(p.ssm_norm_w + l * 384 + cs_), nw1 = *(const float2*)(p.ssm_norm_w + l * 384 + cs_ + 2), nw2 = *(const float2*)(p.ssm_norm_w + l * 384 + cs_ + 4);
  const float dsk0 = p.ssm_d[l * 6 + (cs_ >> 6)], dsk1 = p.ssm_d[l * 6 + ((cs_ + 2) >> 6)], dsk2 = p.ssm_d[l * 6 + ((cs_ + 4) >> 6)];
  for (int t = blockIdx.x; t < TOK / 4; t += gridDim.x) {
    const int r = t * 4 + w, pp = r % TPB;
    if (l == 1 && pp < 256) continue;
    const bool isc = pp < 256;
    const int slo = isc ? 0 : 256, shi = isc ? 255 : 4351;
    const bool hp = pp > slo, hn = pp < shi;
    const unsigned* a32 = (const unsigned*)(p.PA + (size_t)r * 1024 + lane * 6);
    const unsigned at0 = a32[0], at1 = a32[1], at2 = a32[2];
    const uint2 ya = *(const uint2*)(p.yR + (size_t)r * 256 + cg_);
    const uint2 yb = *(const uint2*)(p.yR + ((size_t)TOK + r) * 256 + cg_);
    const bf16_t* pr = p.PR + (size_t)r * 1024 + cg_;
    const uint2 z2 = make_uint2(0u, 0u);
    const uint2 rc = *(const uint2*)pr, kc = *(const uint2*)(pr + 256), vc = *(const uint2*)(pr + 512);
    const uint2 rp = hp ? *(const uint2*)(pr - 1024) : z2, kp = hp ? *(const uint2*)(pr + 256 - 1024) : z2, vp = hp ? *(const uint2*)(pr + 512 - 1024) : z2;
    const uint2 rn = hn ? *(const uint2*)(pr + 1024) : z2, kn = hn ? *(const uint2*)(pr + 256 + 1024) : z2, vn = hn ? *(const uint2*)(pr + 512 + 1024) : z2;
    const uint2 g2 = *(const uint2*)(p.PG + (size_t)r * 640 + cg_);
    const unsigned* s0 = (const unsigned*)(p.yS + (size_t)r * 384 + cs_);
    const unsigned* s1 = (const unsigned*)(p.yS + ((size_t)TOK + r) * 384 + cs_);
    const unsigned* xs32 = (const unsigned*)(p.PS + (size_t)r * 912 + cs_);
    const unsigned* z32 = (const unsigned*)(p.PG + (size_t)r * 640 + 256 + cs_);
    const unsigned sa0 = s0[0], sa1 = s0[1], sa2 = s0[2], sb0 = s1[0], sb1 = s1[1], sb2 = s1[2];
    const unsigned xa0 = xs32[0], xa1 = xs32[1], xa2 = xs32[2], za0 = z32[0], za1 = z32[1], za2 = z32[2];
    {
      unsigned* d32 = (unsigned*)(mix + (size_t)r * 1024 + lane * 6);
      d32[0] = at0; d32[1] = at1; d32[2] = at2;
    }
    {
      float y[4] = {blo(ya.x) + blo(yb.x), bhi(ya.x) + bhi(yb.x), blo(ya.y) + blo(yb.y), bhi(ya.y) + bhi(yb.y)};
      const float sm = sum16(y[0] + y[1] + y[2] + y[3]);
      const float mean = sm * (1.f / 64.f);
      float vq = 0.f;
#pragma unroll
      for (int e = 0; e < 4; ++e) { y[e] -= mean; vq += y[e] * y[e]; }
      vq = sum16(vq);
      const float rstd = rsqrtf(vq * (1.f / 64.f) + 64e-5f);
      const float rs0 = blo(rc.x) + m0r.x * (blo(rp.x) - blo(rc.x)) + m1r.x * (blo(rn.x) - blo(rc.x));
      const float rs1 = bhi(rc.x) + m0r.y * (bhi(rp.x) - bhi(rc.x)) + m1r.y * (bhi(rn.x) - bhi(rc.x));
      const float rs2 = blo(rc.y) + m0r.z * (blo(rp.y) - blo(rc.y)) + m1r.z * (blo(rn.y) - blo(rc.y));
      const float rs3 = bhi(rc.y) + m0r.w * (bhi(rp.y) - bhi(rc.y)) + m1r.w * (bhi(rn.y) - bhi(rc.y));
      const float ks0 = blo(kc.x) + m0k.x * (blo(kp.x) - blo(kc.x)) + m1k.x * (blo(kn.x) - blo(kc.x));
      const float ks1 = bhi(kc.x) + m0k.y * (bhi(kp.x) - bhi(kc.x)) + m1k.y * (bhi(kn.x) - bhi(kc.x));
      const float ks2 = blo(kc.y) + m0k.z * (blo(kp.y) - blo(kc.y)) + m1k.z * (blo(kn.y) - blo(kc.y));
      const float ks3 = bhi(kc.y) + m0k.w * (bhi(kp.y) - bhi(kc.y)) + m1k.w * (bhi(kn.y) - bhi(kc.y));
      const float vs0 = blo(vc.x) + m0v.x * (blo(vp.x) - blo(vc.x)) + m1v.x * (blo(vn.x) - blo(vc.x));
      const float vs1 = bhi(vc.x) + m0v.y * (bhi(vp.x) - bhi(vc.x)) + m1v.y * (bhi(vn.x) - bhi(vc.x));
      const float vs2 = blo(vc.y) + m0v.z * (blo(vp.y) - blo(vc.y)) + m1v.z * (blo(vn.y) - blo(vc.y));
      const float vs3 = bhi(vc.y) + m0v.w * (bhi(vp.y) - bhi(vc.y)) + m1v.w * (bhi(vn.y) - bhi(vc.y));
      const float dot = sum16(rs0 * ks0 * rk4.x + rs1 * ks1 * rk4.y + rs2 * ks2 * rk4.z + rs3 * ks3 * rk4.w);
      const float o0 = (y[0] * rstd * lw4.x + lb4.x + dot * vs0) * siluf_(blo(g2.x));
      const float o1 = (y[1] * rstd * lw4.y + lb4.y + dot * vs1) * siluf_(bhi(g2.x));
      const float o2 = (y[2] * rstd * lw4.z + lb4.z + dot * vs2) * siluf_(blo(g2.y));
      const float o3 = (y[3] * rstd * lw4.w + lb4.w + dot * vs3) * siluf_(bhi(g2.y));
      uint2 ov;
      ov.x = pack2(o0, o1);
      ov.y = pack2(o2, o3);
      *(uint2*)(mix + (size_t)r * 1024 + 384 + cg_) = ov;
    }
    {
      const float y0 = (blo(sa0) + blo(sb0) + dsk0 * blo(xa0)) * siluf_(blo(za0));
      const float y1 = (bhi(sa0) + bhi(sb0) + dsk0 * bhi(xa0)) * siluf_(bhi(za0));
      const float y2 = (blo(sa1) + blo(sb1) + dsk1 * blo(xa1)) * siluf_(blo(za1));
      const float y3 = (bhi(sa1) + bhi(sb1) + dsk1 * bhi(xa1)) * siluf_(bhi(za1));
      const float y4 = (blo(sa2) + blo(sb2) + dsk2 * blo(xa2)) * siluf_(blo(za2));
      const float y5 = (bhi(sa2) + bhi(sb2) + dsk2 * bhi(xa2)) * siluf_(bhi(za2));
      float sq = sum16(y0 * y0 + y1 * y1 + y2 * y2 + y3 * y3 + y4 * y4 + y5 * y5);
      sq += __shfl_xor(sq, 16);
      const float rstd = rsqrtf(sq * (1.f / 192.f) + 1e-5f);
      unsigned* dd = (unsigned*)(mix + (size_t)r * 1024 + 640 + cs_);
      dd[0] = pack2(y0 * rstd * nw0.x, y1 * rstd * nw0.y);
      dd[1] = pack2(y2 * rstd * nw1.x, y3 * rstd * nw1.y);
      dd[2] = pack2(y4 * rstd * nw2.x, y5 * rstd * nw2.y);
    }
  }
}

#define XB_TMO      128
#define XB_XCNT(j)  (256  + 64 * (j))
#define XB_XSUB(j)  (1280 + 64 * (j))
#define XB_XGEN(j)  (2304 + 64 * (j))
#define XB_TOP      3328
#define XB_TOPGEN   3392
#define XCD_BAR_WORDS 3456
#define XB_SPIN_CAP (1u << 18)
#define LAS __attribute__((address_space(3)))

__device__ __forceinline__ unsigned xb_ld(unsigned* p)              { return __hip_atomic_load(p, __ATOMIC_RELAXED, __HIP_MEMORY_SCOPE_AGENT); }
__device__ __forceinline__ unsigned xb_add(unsigned* p, unsigned v) { return __hip_atomic_fetch_add(p, v, __ATOMIC_RELAXED, __HIP_MEMORY_SCOPE_AGENT); }
__device__ __forceinline__ unsigned xb_xcc_id() { return (unsigned)__builtin_amdgcn_s_getreg((3 << 11) | 20) & 0xFu; }
#define XB_SPIN(cond, bar) do { unsigned _sp = 0; while (cond) { __builtin_amdgcn_s_sleep(1); \
    if ((++_sp & 255u) == 0u) { if (xb_ld(&(bar)[XB_TMO])) break; if (_sp > XB_SPIN_CAP) { atomicAdd(&(bar)[XB_TMO], 1u); break; } } } } while (0)

struct XcdBarrier {
    unsigned* bar; unsigned x;
    volatile LAS unsigned* st;
};

__device__ __forceinline__ XcdBarrier xcd_barrier_post(unsigned* bar, volatile LAS unsigned* st) {
    XcdBarrier b; b.bar = bar; b.x = xb_xcc_id(); b.st = st;
    if (threadIdx.x == 0) (void)xb_add(&bar[XB_XCNT(b.x)], 1u);
    return b;
}
__device__ __forceinline__ void xcd_barrier_complete(unsigned* bar, unsigned x, unsigned& nloc, unsigned& nx) {
    const unsigned G = gridDim.x * gridDim.y * gridDim.z;
    unsigned sum, cnt, mine, sp = 0u;
    for (;;) {
        sum = 0u; cnt = 0u; mine = 0u;
#pragma unroll
        for (unsigned j = 0; j < 16; ++j) { const unsigned c = xb_ld(&bar[XB_XCNT(j)]); sum += c; cnt += (c > 0u) ? 1u : 0u; mine = (j == x) ? c : mine; }
        if (sum == G) break;
        __builtin_amdgcn_s_sleep(1);
        if ((++sp & 255u) == 0u) { if (xb_ld(&bar[XB_TMO])) break; if (sp > XB_SPIN_CAP) { atomicAdd(&bar[XB_TMO], 1u); break; } }
    }
    nloc = mine > 0u ? mine : 1u; nx = cnt > 0u ? cnt : 1u;
}

__device__ __forceinline__ void xcd_barrier(const XcdBarrier& b) {
    asm volatile("s_waitcnt vmcnt(0)" ::: "memory");
    __syncthreads();
    if (threadIdx.x == 0) {
        unsigned* bar = b.bar;
        __builtin_amdgcn_s_waitcnt(0);
        unsigned nloc = b.st[0], nx = b.st[1];
        if (nloc == 0u) { xcd_barrier_complete(bar, b.x, nloc, nx); b.st[0] = nloc; b.st[1] = nx; }
        const unsigned old = xb_add(&bar[XB_XSUB(b.x)], 1u);
        const unsigned gen = old / nloc;
        if (old + 1u == (gen + 1u) * nloc) {
            __builtin_amdgcn_fence(__ATOMIC_RELEASE, "agent");
            asm volatile("s_waitcnt vmcnt(0)" ::: "memory");
            const unsigned og = xb_add(&bar[XB_TOP], 1u);
            const unsigned tg = og / nx;
            if (og + 1u == (tg + 1u) * nx) xb_add(&bar[XB_TOPGEN], 1u);
            else XB_SPIN(xb_ld(&bar[XB_TOPGEN]) == tg, bar);
            __builtin_amdgcn_fence(__ATOMIC_ACQUIRE, "agent");
            xb_add(&bar[XB_XGEN(b.x)], 1u);
            asm volatile("s_waitcnt vmcnt(0)" ::: "memory");
        } else {
            XB_SPIN(xb_ld(&bar[XB_XGEN(b.x)]) == gen, bar);
            __builtin_amdgcn_fence(__ATOMIC_ACQUIRE, "agent");
            asm volatile("s_waitcnt vmcnt(0)" ::: "memory");
        }
    }
    __syncthreads();
}


__global__ void __launch_bounds__(NTHREADS, LBW) mega(Params p, int ph_lo, int ph_hi) {
  extern __shared__ __attribute__((aligned(16))) unsigned char smem[];
  volatile LAS unsigned* xst = (volatile LAS unsigned*)(smem + LDS_BYTES - 16);
  XcdBarrier xb;
  xb.bar = p.bar; xb.x = 0; xb.st = xst;
  if (ph_hi - ph_lo > 1) {
    if (threadIdx.x == 0) { xst[0] = 0u; xst[1] = 0u; }
    __syncthreads();
    xb = xcd_barrier_post(p.bar, xst);
  }
  for (int ph = ph_lo; ph < ph_hi; ++ph) {
    if (ph > ph_lo) {
      if (ph_hi > 1000) cg::this_grid().sync();
      xcd_barrier(xb);
    }
#ifndef TEST_PH
#define TEST_PH -1
#endif
    if (ph == 0) {
      if (PROBE_DUP == 4) { phase_setup(p, smem); cg::this_grid().sync(); }
      if (TEST_PH < 0 || TEST_PH == 0) phase_setup(p, smem);
    }
    else if (ph == NPHASES - 1) { if (TEST_PH < 0 || TEST_PH == 6) phase_final(p); }
    else {
      const int l = (ph - 1) / 7, s = (ph - 1) % 7;
      if (s == 0) { if (TEST_PH < 0 || TEST_PH == 1) phase_norm(p, l); }
      else if (s == 1) {
        if (PROBE_DUP == 3) { phase_inproj(p, l, smem); cg::this_grid().sync(); }
        if (TEST_PH < 0 || TEST_PH == 2) phase_inproj(p, l, smem);
      }
      else if (s == 2) {
        if (PROBE_DUP == 5) { phase_rwkvprep(p, l, smem); cg::this_grid().sync(); }
        if (TEST_PH < 0 || TEST_PH == 10) phase_rwkvprep(p, l, smem);
      }
      else if (s == 3) {
        if (PROBE_DUP == 1 || PROBE_DUP == 2) { phase_probe(p, l, smem); cg::this_grid().sync(); }
        if (TEST_PH < 0 || TEST_PH == 3 || (TEST_PH >= 7 && TEST_PH <= 9)) phase_mixers(p, l, smem);
      }
      else if (s == 4) { phase_rwkvfix(p); }
      else if (s == 5) { if (TEST_PH < 0 || TEST_PH == 4) phase_finish(p, l); }
      else { if (TEST_PH < 0 || TEST_PH == 5) phase_outproj(p, l, smem); }
    }
  }
}

extern "C" void kernel_launch(void* const* d_in, const int* in_sizes, int n_in, void* d_out, int out_size, void* d_ws,
                              size_t ws_size, hipStream_t stream) {
  static int grid_blocks = 0;
  if (!grid_blocks) {
    int dev = 0, cus = 0, per_cu = 0;
    hipGetDevice(&dev);
    hipDeviceGetAttribute(&cus, hipDeviceAttributeMultiprocessorCount, dev);
    hipFuncSetAttribute((const void*)mega, hipFuncAttributeMaxDynamicSharedMemorySize, LDS_BYTES);
    hipOccupancyMaxActiveBlocksPerMultiprocessor(&per_cu, (const void*)mega, NTHREADS, LDS_BYTES);
    if (per_cu < 1) per_cu = 1;
    if (per_cu > 2) per_cu = 2;
    grid_blocks = cus * per_cu;
  }
  Params p{};
  const float** fp = (const float**)&p;
  for (int i = 0; i < 27; ++i) fp[i] = (const float*)d_in[i];
  p.out = (float*)d_out;
  unsigned char* ws = (unsigned char*)d_ws;
  size_t off = 0;
  auto take = [&](size_t bytes) { unsigned char* r = ws + off; off += (bytes + 255) & ~(size_t)255; return r; };
  p.WtIn = (bf16_t*)take((size_t)2 * 3712 * 1024 * 2);
  p.WtOut = (bf16_t*)take((size_t)2 * 1024 * 1024 * 2);
  p.WupT = (bf16_t*)take((size_t)65536 * 2);
  p.AupT = (bf16_t*)take((size_t)65536 * 2);
  p.rope = (float*)take(1024 * 2 * 4);
  p.mod = (float*)take((size_t)2 * 5 * 3072 * 4);
  p.ctxcur = (float*)take((size_t)4 * 256 * 1024 * 4);
  p.PRE = (bf16_t*)take((size_t)3 * TOK * 512 * 2);
  p.hbuf = p.PRE;
  p.PA = (bf16_t*)take((size_t)TOK * 1024 * 2);
  p.PR = (bf16_t*)take((size_t)TOK * 1024 * 2);
  p.PG = (bf16_t*)take((size_t)TOK * 640 * 2);
  p.PS = (bf16_t*)take((size_t)TOK * 912 * 2);
  p.yR = (bf16_t*)take((size_t)2 * TOK * 256 * 2);
  p.HALO = (bf16_t*)take((size_t)512 * 2 * 896 * 2);
  p.DTC = (float2*)take((size_t)12 * TOK * 8);
  p.GID = (bf16_t*)take((size_t)8 * NSEG1 * 256 * 2);
  p.SMID = (float*)take((size_t)32 * 64 * 64 * 4);
  p.ctrs = (unsigned*)take(256);
  p.bar = (unsigned*)take((size_t)XCD_BAR_WORDS * 4);
  p.rstd = (float*)take((size_t)TOK * 4);
  p.yS = (bf16_t*)take((size_t)2 * TOK * 384 * 2);
  if (off > ws_size) { fprintf(stderr, "workspace too small: need %zu have %zu\n", off, ws_size); return; }
#if ONE_LAUNCH
  hipMemsetAsync(p.bar, 0, (size_t)XCD_BAR_WORDS * 4, stream);
  int lo = 0, hi = NPHASES;
  void* args[] = {&p, &lo, &hi};
  hipError_t e = hipLaunchCooperativeKernel((const void*)mega, dim3(grid_blocks), dim3(NTHREADS), args, LDS_BYTES, stream);
  if (e != hipSuccess) fprintf(stderr, "cooperative launch failed: %s (grid %d)\n", hipGetErrorString(e), grid_blocks);
#else
  for (int ph = 0; ph < NPHASES; ++ph)
    hipLaunchKernelGGL(mega, dim3(grid_blocks), dim3(NTHREADS), LDS_BYTES, stream, p, ph, ph + 1);
#endif
}
```

```cpp
#include <hip/hip_runtime.h>
#include <hip/hip_bf16.h>
#include <hip/hip_cooperative_groups.h>
#include <cstdio>
namespace cg = cooperative_groups;

#ifndef TEST_PH
#define TEST_PH -1
#endif
#ifndef ONE_LAUNCH
#define ONE_LAUNCH 1
#endif

typedef unsigned short bf16_t;
#define GLAS __attribute__((address_space(3)))
using bf16x8 = __attribute__((ext_vector_type(8))) short;
using f32x4 = __attribute__((ext_vector_type(4))) float;

#define TOK 17408
#define TPB 4352
#define NTHREADS 256
#define LDS_BYTES 76800
#define NPHASES 16
#define CSPLIT 78
#define NSEG1 ((136 - CSPLIT) * 32)
#ifndef LBW
#define LBW 2
#endif

struct Params {
  const float *x, *c, *ctx, *c_ctx, *ada_w, *ada_b, *norm_w, *w_in, *w_out, *attn_sink, *rwkv_mu, *rwkv_w0,
      *rwkv_w_up, *rwkv_a0, *rwkv_a_up, *rwkv_k_k, *rwkv_k_a, *rwkv_r_k, *rwkv_ln_w, *rwkv_ln_b, *ssm_conv_w,
      *ssm_conv_b, *ssm_a_log, *ssm_dt_bias, *ssm_d, *ssm_norm_w, *final_norm_w;
  float* out;
  bf16_t *WtIn, *WtOut, *WupT, *AupT;
  float *rope, *mod, *ctxcur;
  bf16_t *hbuf, *PA, *PR, *PG, *PS;
  bf16_t* yR;
  bf16_t* yS;
  bf16_t* PRE;
  bf16_t* HALO;
  float2* DTC;
  bf16_t* GID;
  float* SMID;
  unsigned* ctrs;
  unsigned* bar;
  float* rstd;
};

__device__ __forceinline__ float bf2f(bf16_t v) { return __uint_as_float(((unsigned)v) << 16); }
typedef __bf16 hbf2 __attribute__((ext_vector_type(2)));
typedef float hf2 __attribute__((ext_vector_type(2)));
__device__ __forceinline__ unsigned pack2(float a, float b) {
  hf2 v = {a, b};
  hbf2 r = __builtin_convertvector(v, hbf2);
  return *(unsigned*)&r;
}
__device__ __forceinline__ bf16_t f2bf(float f) { return (bf16_t)(pack2(f, 0.f) & 0xffffu); }
__device__ __forceinline__ float blo(unsigned u) { return __uint_as_float(u << 16); }
__device__ __forceinline__ float bhi(unsigned u) { return __uint_as_float(u & 0xffff0000u); }
__device__ __forceinline__ float frcp(float x) { return __builtin_amdgcn_rcpf(x); }
__device__ __forceinline__ float sigmoidf_(float x) { return frcp(1.f + __expf(-x)); }
__device__ __forceinline__ float siluf_(float x) { return x * frcp(1.f + __expf(-x)); }
__device__ __forceinline__ float softplusf_(float x) {
  if (x > 15.f) return x;
  float e = __expf(x);
  return (e < 0.01f) ? e * (1.f - e * (0.5f - e * 0.33333333f)) : __logf(1.f + e);
}
__device__ __forceinline__ float tanhf_(float x) {
  float e = __expf(2.f * x);
  return 1.f - 2.f * frcp(e + 1.f);
}

template <int CTRL>
__device__ __forceinline__ float dppf(float x) {
  return __int_as_float(__builtin_amdgcn_update_dpp(0, __float_as_int(x), CTRL, 0xF, 0xF, true));
}
__device__ __forceinline__ float sum16(float x) {
  x += dppf<0xB1>(x);
  x += dppf<0x4E>(x);
  x += dppf<0x141>(x);
  x += dppf<0x140>(x);
  return x;
}
__device__ __forceinline__ float max16(float x) {
  x = fmaxf(x, dppf<0xB1>(x));
  x = fmaxf(x, dppf<0x4E>(x));
  x = fmaxf(x, dppf<0x141>(x));
  x = fmaxf(x, dppf<0x140>(x));
  return x;
}
__device__ __forceinline__ float sum64(float x) {
#pragma unroll
  for (int o = 32; o >= 1; o >>= 1) x += __shfl_xor(x, o);
  return x;
}
__device__ __forceinline__ float sum32(float x) {
#pragma unroll
  for (int o = 16; o >= 1; o >>= 1) x += __shfl_xor(x, o);
  return x;
}
__device__ __forceinline__ int launder(int x) { asm volatile("" : "+v"(x)); return x; }
#define MFMA(a, b, c) __builtin_amdgcn_mfma_f32_16x16x32_bf16(a, b, c, 0, 0, 0)

__device__ __forceinline__ void transpose_tile(const float* __restrict__ W, int N, int Kdim, bf16_t* __restrict__ Wt, int k0, int n0,
                               unsigned char* smem) {
  float* T = (float*)smem;
  const int tid = launder(threadIdx.x);
#pragma unroll 4
  for (int it = 0; it < 16; ++it) {
    int kk = (tid >> 6) + 4 * it, nn = tid & 63, n = n0 + nn;
    T[kk * 65 + nn] = (n < N) ? W[(size_t)(k0 + kk) * N + n] : 0.f;
  }
  __syncthreads();
#pragma unroll
  for (int it = 0; it < 2; ++it) {
    int nn = (tid >> 3) + 32 * it, kc = tid & 7;
    uint4 o;
    o.x = pack2(T[(kc * 8 + 0) * 65 + nn], T[(kc * 8 + 1) * 65 + nn]);
    o.y = pack2(T[(kc * 8 + 2) * 65 + nn], T[(kc * 8 + 3) * 65 + nn]);
    o.z = pack2(T[(kc * 8 + 4) * 65 + nn], T[(kc * 8 + 5) * 65 + nn]);
    o.w = pack2(T[(kc * 8 + 6) * 65 + nn], T[(kc * 8 + 7) * 65 + nn]);
    *(uint4*)(Wt + (size_t)(n0 + nn) * Kdim + k0 + kc * 8) = o;
  }
  __syncthreads();
}

__device__ void sincos_d(double x, float& c, float& s) {
  double n = rint(x * 0.63661977236758134308);
  double r = x - n * 1.57079632679489661923;
  double r2 = r * r;
  double sn = r * (1.0 + r2 * (-1.0 / 6 + r2 * (1.0 / 120 + r2 * (-1.0 / 5040 + r2 * (1.0 / 362880 + r2 * (-1.0 / 39916800 + r2 * (1.0 / 6227020800.0)))))));
  double cs = 1.0 + r2 * (-0.5 + r2 * (1.0 / 24 + r2 * (-1.0 / 720 + r2 * (1.0 / 40320 + r2 * (-1.0 / 3628800 + r2 * (1.0 / 479001600.0 + r2 * (-1.0 / 87178291200.0)))))));
  int q = ((int)n) & 3;
  double co, so;
  if (q == 0) { co = cs; so = sn; }
  else if (q == 1) { co = -sn; so = cs; }
  else if (q == 2) { co = -cs; so = -sn; }
  else { co = sn; so = -cs; }
  c = (float)co;
  s = (float)so;
}

__device__ __forceinline__ void deferred_transpose(const Params& p, int t, unsigned char* smem) {
  if (t < 928) {
    const int kt = t / 58, nt = t % 58;
    transpose_tile(p.w_in + (size_t)1024 * 3596, 3596, 1024, p.WtIn + (size_t)3712 * 1024, kt * 64, nt * 64, smem);
  } else {
    const int tt = t - 928, l = tt >> 8, r = tt & 255, kt = r >> 4, nt = r & 15;
    transpose_tile(p.w_out + (size_t)l * 1024 * 1024, 1024, 1024, p.WtOut + (size_t)l * 1024 * 1024, kt * 64, nt * 64, smem);
  }
}
__device__ __forceinline__ void phase_setup(const Params& p, unsigned char* smem) {
  const int T_WIN = 16 * 58, T_WOUT = 0, T_ADA = 2 * 96, T_MISC = 17;
  const int total = T_WIN + T_WOUT + T_ADA + T_MISC;
  const int tid = launder(threadIdx.x);
  if (blockIdx.x == 0 && tid < 8) p.ctrs[tid] = 0u;
  for (int t = blockIdx.x; t < total; t += gridDim.x) {
    if (t < T_WIN) {
      int kt = t / 58, nt = t % 58;
      transpose_tile(p.w_in, 3596, 1024, p.WtIn, kt * 64, nt * 64, smem);
    } else if (t < T_WIN + T_WOUT + T_ADA) {
      int tt = t - T_WIN - T_WOUT, l = tt / 96, n0 = (tt % 96) * 32;
      float* cact = (float*)smem;
      for (int i = tid; i < 5120; i += 256) {
        int j = i >> 10, k = i & 1023;
        float v = (j < 4) ? p.c[j * 1024 + k] : p.c_ctx[k];
        cact[i] = siluf_(v);
      }
      __syncthreads();
      int col = tid & 31, kg = tid >> 5;
      float a0 = 0, a1 = 0, a2 = 0, a3 = 0, a4 = 0;
      const float* wp = p.ada_w + ((size_t)l * 1024 + kg * 128) * 3072 + n0 + col;
#pragma unroll 8
      for (int k = 0; k < 128; ++k) {
        float w = wp[(size_t)k * 3072];
        int kk = kg * 128 + k;
        a0 += cact[kk] * w; a1 += cact[1024 + kk] * w; a2 += cact[2048 + kk] * w; a3 += cact[3072 + kk] * w; a4 += cact[4096 + kk] * w;
      }
      float* red = cact + 5120;
      red[(kg * 5 + 0) * 32 + col] = a0; red[(kg * 5 + 1) * 32 + col] = a1; red[(kg * 5 + 2) * 32 + col] = a2;
      red[(kg * 5 + 3) * 32 + col] = a3; red[(kg * 5 + 4) * 32 + col] = a4;
      __syncthreads();
      if (tid < 160) {
        int j = tid >> 5, cc = tid & 31;
        float s = 0;
#pragma unroll
        for (int g = 0; g < 8; ++g) s += red[(g * 5 + j) * 32 + cc];
        p.mod[(size_t)(l * 5 + j) * 3072 + n0 + cc] = s + p.ada_b[l * 3072 + n0 + cc];
      }
      __syncthreads();
    } else {
      int tt = t - T_WIN - T_WOUT - T_ADA;
      if (tt < 16) {
        for (int i = tid; i < 8192; i += 256) {
          int idx = tt * 8192 + i;
          int arr = idx >> 16, e = idx & 65535;
          int ld = e >> 14, rem = e & 16383, n = rem >> 6, k = rem & 63;
          const float* src = arr ? p.rwkv_a_up : p.rwkv_w_up;
          bf16_t* dst = arr ? p.AupT : p.WupT;
          dst[e] = f2bf(src[((size_t)ld * 64 + k) * 256 + n]);
        }
      } else {
        for (int i = tid; i < 1024; i += 256) {
          int pos = i >> 4, f = i & 15;
          float inv32 = exp2f(-(float)f * 0.83048202372184058f);
          float c, s;
          sincos_d((double)((float)pos * inv32), c, s);
          p.rope[i * 2] = c;
          p.rope[i * 2 + 1] = s;
        }
      }
    }
  }
}

__device__ __forceinline__ void phase_norm(const Params& p, int l) {
  const int tid = launder(threadIdx.x), lane = tid & 63, w = tid >> 6;
  for (int t = blockIdx.x; t < TOK / 4; t += gridDim.x) {
    int r = t * 4 + w, b = r / TPB, pp = r % TPB;
    const float* src;
    if (l == 0) src = (pp < 256) ? p.ctx + ((size_t)b * 256 + pp) * 1024 : p.x + ((size_t)b * 4096 + pp - 256) * 1024;
    else src = (pp < 256) ? p.ctxcur + ((size_t)b * 256 + pp) * 1024 : p.out + ((size_t)b * 4096 + pp - 256) * 1024;
    const float* md = p.mod + (size_t)(l * 5 + ((pp < 256) ? 4 : b)) * 3072;
    const float* nw = p.norm_w + l * 1024;
    float4 v[4];
    float ss = 0;
#pragma unroll
    for (int i = 0; i < 4; ++i) {
      v[i] = *(const float4*)(src + lane * 4 + 256 * i);
      ss += v[i].x * v[i].x + v[i].y * v[i].y + v[i].z * v[i].z + v[i].w * v[i].w;
    }
    ss = sum64(ss);
    float rstd = rsqrtf(ss * (1.f / 1024.f) + 1e-6f);
    if (lane == 0) p.rstd[r] = rstd;
#pragma unroll
    for (int i = 0; i < 4; ++i) {
      int k = lane * 4 + 256 * i;
      float4 n4 = *(const float4*)(nw + k), sc = *(const float4*)(md + 1024 + k), sh = *(const float4*)(md + k);
      float h0 = v[i].x * rstd * n4.x * (1.f + sc.x) + sh.x;
      float h1 = v[i].y * rstd * n4.y * (1.f + sc.y) + sh.y;
      float h2 = v[i].z * rstd * n4.z * (1.f + sc.z) + sh.z;
      float h3 = v[i].w * rstd * n4.w * (1.f + sc.w) + sh.w;
      uint2 o;
      o.x = pack2(h0, h1);
      o.y = pack2(h2, h3);
      *(uint2*)(p.hbuf + (size_t)r * 1024 + k) = o;
    }
  }
}

__device__ __forceinline__ void phase_final(const Params& p) {
  const int tid = launder(threadIdx.x), lane = tid & 63, w = tid >> 6;
  for (int t = blockIdx.x; t < 16384 / 4; t += gridDim.x) {
    int r = t * 4 + w;
    float* src = p.out + (size_t)r * 1024;
    float4 v[4];
    float ss = 0;
#pragma unroll
    for (int i = 0; i < 4; ++i) {
      v[i] = *(const float4*)(src + lane * 4 + 256 * i);
      ss += v[i].x * v[i].x + v[i].y * v[i].y + v[i].z * v[i].z + v[i].w * v[i].w;
    }
    ss = sum64(ss);
    float rstd = rsqrtf(ss * (1.f / 1024.f) + 1e-6f);
#pragma unroll
    for (int i = 0; i < 4; ++i) {
      int k = lane * 4 + 256 * i;
      float4 n4 = *(const float4*)(p.final_norm_w + k);
      float4 o;
      o.x = v[i].x * rstd * n4.x; o.y = v[i].y * rstd * n4.y; o.z = v[i].z * rstd * n4.z; o.w = v[i].w * rstd * n4.w;
      *(float4*)(src + k) = o;
    }
  }
}

template <int MODE>
__device__ __forceinline__ void gemm_tile(const Params& p, int l, int mt_, int nt_, unsigned char* smem) {
  const bf16_t* A = p.hbuf;
  const bf16_t* Bt = (MODE == 0) ? p.WtIn + (size_t)l * 3712 * 1024 : p.WtOut + (size_t)l * 1024 * 1024;
  const int m0 = mt_ * 128, n0 = nt_ * 128;
  bf16_t* As = (bf16_t*)smem;
  bf16_t* Bs = As + 2 * 128 * 72;
  const int tid = launder(threadIdx.x), lane = tid & 63, w = tid >> 6, wr = w >> 1, wc = w & 1, fr = lane & 15, fq = lane >> 4;
  f32x4 acc[4][4];
#pragma unroll
  for (int i = 0; i < 4; ++i)
#pragma unroll
    for (int j = 0; j < 4; ++j) acc[i][j] = (f32x4){0.f, 0.f, 0.f, 0.f};
  unsigned char* lds = smem;
  int sR[4], sC[4];
#pragma unroll
  for (int i = 0; i < 4; ++i) {
    const int bo = tid * 16 + i * 4096;
    const int st = bo >> 10, sb = bo & 1023, swz = sb ^ (((sb >> 9) & 1) << 5);
    sR[i] = (st >> 1) * 16 + (swz >> 6);
    sC[i] = (st & 1) * 32 + ((swz & 63) >> 1);
  }
  const bf16_t* Ag0 = A + (size_t)(m0 + sR[0]) * 1024 + sC[0];
  const bf16_t* Ag1 = A + (size_t)(m0 + sR[1]) * 1024 + sC[1];
  const bf16_t* Ag2 = A + (size_t)(m0 + sR[2]) * 1024 + sC[2];
  const bf16_t* Ag3 = A + (size_t)(m0 + sR[3]) * 1024 + sC[3];
  const bf16_t* Bg0 = Bt + (size_t)(n0 + sR[0]) * 1024 + sC[0];
  const bf16_t* Bg1 = Bt + (size_t)(n0 + sR[1]) * 1024 + sC[1];
  const bf16_t* Bg2 = Bt + (size_t)(n0 + sR[2]) * 1024 + sC[2];
  const bf16_t* Bg3 = Bt + (size_t)(n0 + sR[3]) * 1024 + sC[3];
#define GL_STAGE(q_, kt_)                                                                                                              \
  {                                                                                                                                    \
    unsigned char* base_ = lds + (q_) * 32768 + tid * 16;                                                                              \
    __builtin_amdgcn_global_load_lds((const unsigned*)(Ag0 + (kt_) * 64), (GLAS unsigned*)(base_), 16, 0, 0);                          \
    __builtin_amdgcn_global_load_lds((const unsigned*)(Ag1 + (kt_) * 64), (GLAS unsigned*)(base_ + 4096), 16, 0, 0);                   \
    __builtin_amdgcn_global_load_lds((const unsigned*)(Ag2 + (kt_) * 64), (GLAS unsigned*)(base_ + 8192), 16, 0, 0);                   \
    __builtin_amdgcn_global_load_lds((const unsigned*)(Ag3 + (kt_) * 64), (GLAS unsigned*)(base_ + 12288), 16, 0, 0);                  \
    __builtin_amdgcn_global_load_lds((const unsigned*)(Bg0 + (kt_) * 64), (GLAS unsigned*)(base_ + 16384), 16, 0, 0);                  \
    __builtin_amdgcn_global_load_lds((const unsigned*)(Bg1 + (kt_) * 64), (GLAS unsigned*)(base_ + 16384 + 4096), 16, 0, 0);           \
    __builtin_amdgcn_global_load_lds((const unsigned*)(Bg2 + (kt_) * 64), (GLAS unsigned*)(base_ + 16384 + 8192), 16, 0, 0);           \
    __builtin_amdgcn_global_load_lds((const unsigned*)(Bg3 + (kt_) * 64), (GLAS unsigned*)(base_ + 16384 + 12288), 16, 0, 0);          \
  }
  const int lo = (fr * 64 + fq * 16) ^ ((fr >> 3) << 5);
#define GL_COMPUTE(q_)                                                                                 \
  {                                                                                                    \
    const unsigned char* Ab = lds + (q_) * 32768 + (wr * 4) * 2048 + lo;                               \
    const unsigned char* Bb = lds + (q_) * 32768 + 16384 + (wc * 4) * 2048 + lo;                       \
    _Pragma("unroll") for (int ks = 0; ks < 2; ++ks) {                                                 \
      bf16x8 a[4], b[4];                                                                               \
      _Pragma("unroll") for (int i = 0; i < 4; ++i) {                                                  \
        a[i] = *(const bf16x8*)(Ab + i * 2048 + ks * 1024);                                            \
        b[i] = *(const bf16x8*)(Bb + i * 2048 + ks * 1024);                                            \
      }                                                                                                \
      _Pragma("unroll") for (int i = 0; i < 4; ++i)                                                    \
        _Pragma("unroll") for (int j = 0; j < 4; ++j) acc[i][j] = MFMA(a[i], b[j], acc[i][j]);         \
    }                                                                                                  \
  }
  GL_STAGE(0, 0);
  asm volatile("s_waitcnt vmcnt(0)" ::: "memory");
  __builtin_amdgcn_s_barrier();
  for (int kt = 0; kt < 16; ++kt) {
    const int q = kt & 1;
    if (kt + 1 < 16) GL_STAGE(q ^ 1, kt + 1);
    GL_COMPUTE(q);
    asm volatile("s_waitcnt vmcnt(0) lgkmcnt(0)" ::: "memory");
    __builtin_amdgcn_s_barrier();
  }
  const int cbase = n0 + wc * 64;
  if (MODE == 0) {
    bf16_t* dst;
    int ld, coff;
    if (cbase < 1024) { dst = p.PA; ld = 1024; coff = cbase; }
    else if (cbase < 2048) { dst = p.PR; ld = 1024; coff = cbase - 1024; }
    else if (cbase < 2688) { dst = p.PG; ld = 640; coff = cbase - 2048; }
    else { dst = p.PS; ld = 912; coff = cbase - 2688; }
    bf16_t* wbuf = (bf16_t*)smem + w * (64 * 72);
#pragma unroll
    for (int i = 0; i < 4; ++i) {
#pragma unroll
      for (int j = 0; j < 4; ++j) {
        const int r = m0 + wr * 64 + i * 16 + fq * 4 + j;
        const int pp = r % TPB;
        float v0 = acc[i][0][j], v1 = acc[i][1][j], v2 = acc[i][2][j], v3 = acc[i][3][j];
        if (cbase < 512 && pp >= 256) {
          const int tt = pp - 256, rp = tt >> 6, cp = tt & 63;
          const float2 cs0 = *(const float2*)(p.rope + (rp * 16 + fr) * 2);
          const float2 cs1 = *(const float2*)(p.rope + (cp * 16 + fr) * 2);
          float n0_ = v0 * cs0.x - v1 * cs0.y, n1_ = v0 * cs0.y + v1 * cs0.x;
          float n2_ = v2 * cs1.x - v3 * cs1.y, n3_ = v2 * cs1.y + v3 * cs1.x;
          v0 = n0_; v1 = n1_; v2 = n2_; v3 = n3_;
        }
        if (cbase < 384) { v0 *= 0.125f; v1 *= 0.125f; v2 *= 0.125f; v3 *= 0.125f; }
        bf16_t* o = wbuf + (i * 16 + fq * 4 + j) * 72 + fr;
        o[0] = f2bf(v0); o[16] = f2bf(v1); o[32] = f2bf(v2); o[48] = f2bf(v3);
      }
    }
    __builtin_amdgcn_wave_barrier();
    {
      const int ch = lane & 7;
      const bool chv = (cbase + ch * 8) < 3600;
      const bool halo = (cbase >= 2688) && (cbase + 64 <= 3584);
#pragma unroll
      for (int t = 0; t < 8; ++t) {
        const int rl = (lane >> 3) + 8 * t;
        const uint4 v = *(const uint4*)(wbuf + rl * 72 + ch * 8);
        const int r = m0 + wr * 64 + rl;
        if (chv) *(uint4*)(dst + (size_t)r * ld + coff + ch * 8) = v;
        if (halo) {
          const int pp = r % TPB, q34 = pp % 34, t34 = pp / 34, bb = r / TPB;
          if (q34 == 33 && t34 + 1 < 128) *(uint4*)(p.HALO + ((size_t)(bb * 128 + t34 + 1) * 2 + 0) * 896 + coff + ch * 8) = v;
          if (q34 == 0 && t34 >= 1) *(uint4*)(p.HALO + ((size_t)(bb * 128 + t34 - 1) * 2 + 1) * 896 + coff + ch * 8) = v;
        }
      }
    }
  } else {
    float* wbuf = (float*)smem + w * (64 * 68);
#pragma unroll
    for (int i = 0; i < 4; ++i)
#pragma unroll
      for (int j = 0; j < 4; ++j) {
        float* o = wbuf + (i * 16 + fq * 4 + j) * 68 + fr;
        o[0] = acc[i][0][j]; o[16] = acc[i][1][j]; o[32] = acc[i][2][j]; o[48] = acc[i][3][j];
      }
    __builtin_amdgcn_wave_barrier();
    {
      const int ch = lane & 15;
      const int b = m0 / TPB, pp0 = (m0 % TPB) + wr * 64;
      const bool isc = pp0 < 256;
      const float4 g4 = *(const float4*)(p.mod + (size_t)(l * 5 + (isc ? 4 : b)) * 3072 + 2048 + cbase + ch * 4);
      const float* resb;
      float* dstb;
      if (l == 0) {
        resb = isc ? p.ctx + ((size_t)b * 256 + pp0) * 1024 : p.x + ((size_t)b * 4096 + pp0 - 256) * 1024;
        dstb = isc ? p.ctxcur + ((size_t)b * 256 + pp0) * 1024 : p.out + ((size_t)b * 4096 + pp0 - 256) * 1024;
      } else {
        resb = p.out + ((size_t)b * 4096 + pp0 - 256) * 1024;
        dstb = p.out + ((size_t)b * 4096 + pp0 - 256) * 1024;
      }
#pragma unroll
      for (int t = 0; t < 16; ++t) {
        const int rl = (lane >> 4) + 4 * t;
        const float4 a4 = *(const float4*)(wbuf + rl * 68 + ch * 4);
        const float4 r4 = *(const float4*)(resb + (size_t)rl * 1024 + cbase + ch * 4);
        float4 o4;
        o4.x = r4.x + g4.x * a4.x; o4.y = r4.y + g4.y * a4.y; o4.z = r4.z + g4.z * a4.z; o4.w = r4.w + g4.w * a4.w;
        *(float4*)(dstb + (size_t)rl * 1024 + cbase + ch * 4) = o4;
      }
    }
  }
  __syncthreads();
}

__device__ __forceinline__ void gemm_tile256(const Params& p, int l, int mt_, int nt_, unsigned char* smem) {
  const bf16_t* A = p.hbuf;
  const bf16_t* Bt = p.WtIn + (size_t)l * 3712 * 1024;
  const int m0 = mt_ * 256, n0 = nt_ * 128;
  const int tid = launder(threadIdx.x), lane = tid & 63, w = tid >> 6, fr = lane & 15, fq = lane >> 4;
  f32x4 acc[4][8];
#pragma unroll
  for (int i = 0; i < 4; ++i)
#pragma unroll
    for (int j = 0; j < 8; ++j) acc[i][j] = (f32x4){0.f, 0.f, 0.f, 0.f};
  unsigned char* lds = smem;
  int sR[4], sC[4];
#pragma unroll
  for (int i = 0; i < 4; ++i) {
    const int bo = tid * 16 + i * 4096;
    const int st = bo >> 10, sb = bo & 1023, swz = sb ^ (((sb >> 9) & 1) << 5);
    sR[i] = st * 16 + (swz >> 6);
    sC[i] = (swz & 63) >> 1;
  }
  const bf16_t* Ag0 = A + (size_t)(m0 + sR[0]) * 1024 + sC[0];
  const bf16_t* Ag1 = A + (size_t)(m0 + sR[1]) * 1024 + sC[1];
  const bf16_t* Ag2 = A + (size_t)(m0 + sR[2]) * 1024 + sC[2];
  const bf16_t* Ag3 = A + (size_t)(m0 + sR[3]) * 1024 + sC[3];
  const bf16_t* Bg0 = Bt + (size_t)(n0 + sR[0]) * 1024 + sC[0];
  const bf16_t* Bg1 = Bt + (size_t)(n0 + sR[1]) * 1024 + sC[1];
#define GQ_STAGE(q_, kt_)                                                                                                              \
  {                                                                                                                                    \
    unsigned char* base_ = lds + (q_) * 24576 + tid * 16;                                                                              \
    __builtin_amdgcn_global_load_lds((const unsigned*)(Ag0 + (kt_) * 32), (GLAS unsigned*)(base_), 16, 0, 0);                          \
    __builtin_amdgcn_global_load_lds((const unsigned*)(Ag1 + (kt_) * 32), (GLAS unsigned*)(base_ + 4096), 16, 0, 0);                   \
    __builtin_amdgcn_global_load_lds((const unsigned*)(Ag2 + (kt_) * 32), (GLAS unsigned*)(base_ + 8192), 16, 0, 0);                   \
    __builtin_amdgcn_global_load_lds((const unsigned*)(Ag3 + (kt_) * 32), (GLAS unsigned*)(base_ + 12288), 16, 0, 0);                  \
    __builtin_amdgcn_global_load_lds((const unsigned*)(Bg0 + (kt_) * 32), (GLAS unsigned*)(base_ + 16384), 16, 0, 0);                  \
    __builtin_amdgcn_global_load_lds((const unsigned*)(Bg1 + (kt_) * 32), (GLAS unsigned*)(base_ + 16384 + 4096), 16, 0, 0);           \
  }
  const int lo = (fr * 64 + fq * 16) ^ ((fr >> 3) << 5);
  GQ_STAGE(0, 0);
  asm volatile("s_waitcnt vmcnt(0)" ::: "memory");
  __builtin_amdgcn_s_barrier();
  for (int kt = 0; kt < 32; ++kt) {
    const int q = kt & 1;
    if (kt + 1 < 32) GQ_STAGE(q ^ 1, kt + 1);
    {
      const unsigned char* Ab = lds + q * 24576 + (w * 4) * 1024 + lo;
      const unsigned char* Bb = lds + q * 24576 + 16384 + lo;
      bf16x8 a[4];
#pragma unroll
      for (int i = 0; i < 4; ++i) a[i] = *(const bf16x8*)(Ab + i * 1024);
#pragma unroll
      for (int jh = 0; jh < 2; ++jh) {
        bf16x8 b[4];
#pragma unroll
        for (int j = 0; j < 4; ++j) b[j] = *(const bf16x8*)(Bb + (jh * 4 + j) * 1024);
#pragma unroll
        for (int i = 0; i < 4; ++i)
#pragma unroll
          for (int j = 0; j < 4; ++j) acc[i][jh * 4 + j] = MFMA(a[i], b[j], acc[i][jh * 4 + j]);
      }
    }
    asm volatile("s_waitcnt vmcnt(0) lgkmcnt(0)" ::: "memory");
    __builtin_amdgcn_s_barrier();
  }
#pragma unroll
  for (int hc = 0; hc < 2; ++hc) {
    const int cbase = n0 + hc * 64;
    bf16_t* dst;
    int ld, coff;
    if (cbase < 1024) { dst = p.PA; ld = 1024; coff = cbase; }
    else if (cbase < 2048) { dst = p.PR; ld = 1024; coff = cbase - 1024; }
    else if (cbase < 2688) { dst = p.PG; ld = 640; coff = cbase - 2048; }
    else { dst = p.PS; ld = 912; coff = cbase - 2688; }
    bf16_t* wbuf = (bf16_t*)smem + w * (64 * 72);
#pragma unroll
    for (int i = 0; i < 4; ++i) {
#pragma unroll
      for (int j = 0; j < 4; ++j) {
        const int r = m0 + w * 64 + i * 16 + fq * 4 + j;
        const int pp = r % TPB;
        float v0 = acc[i][hc * 4 + 0][j], v1 = acc[i][hc * 4 + 1][j], v2 = acc[i][hc * 4 + 2][j], v3 = acc[i][hc * 4 + 3][j];
        if (cbase < 512 && pp >= 256) {
          const int tt = pp - 256, rp = tt >> 6, cp = tt & 63;
          const float2 cs0 = *(const float2*)(p.rope + (rp * 16 + fr) * 2);
          const float2 cs1 = *(const float2*)(p.rope + (cp * 16 + fr) * 2);
          float n0_ = v0 * cs0.x - v1 * cs0.y, n1_ = v0 * cs0.y + v1 * cs0.x;
          float n2_ = v2 * cs1.x - v3 * cs1.y, n3_ = v2 * cs1.y + v3 * cs1.x;
          v0 = n0_; v1 = n1_; v2 = n2_; v3 = n3_;
        }
        if (cbase < 384) { v0 *= 0.125f; v1 *= 0.125f; v2 *= 0.125f; v3 *= 0.125f; }
        bf16_t* o = wbuf + (i * 16 + fq * 4 + j) * 72 + fr;
        o[0] = f2bf(v0); o[16] = f2bf(v1); o[32] = f2bf(v2); o[48] = f2bf(v3);
      }
    }
    __builtin_amdgcn_wave_barrier();
    {
      const int ch = lane & 7;
      const bool chv = (cbase + ch * 8) < 3600;
      const bool halo = (cbase >= 2688) && (cbase + 64 <= 3584);
#pragma unroll
      for (int t = 0; t < 8; ++t) {
        const int rl = (lane >> 3) + 8 * t;
        const uint4 v = *(const uint4*)(wbuf + rl * 72 + ch * 8);
        const int r = m0 + w * 64 + rl;
        if (chv) *(uint4*)(dst + (size_t)r * ld + coff + ch * 8) = v;
        if (halo) {
          const int pp = r % TPB, q34 = pp % 34, t34 = pp / 34, bb = r / TPB;
          if (q34 == 33 && t34 + 1 < 128) *(uint4*)(p.HALO + ((size_t)(bb * 128 + t34 + 1) * 2 + 0) * 896 + coff + ch * 8) = v;
          if (q34 == 0 && t34 >= 1) *(uint4*)(p.HALO + ((size_t)(bb * 128 + t34 - 1) * 2 + 1) * 896 + coff + ch * 8) = v;
        }
      }
    }
    __builtin_amdgcn_wave_barrier();
  }
  __syncthreads();
}

#define G_COMPUTE(buf_)                                                                 \
  {                                                                                     \
    const bf16_t* Ac = As + (buf_) * 128 * 72 + (wr * 64 + fr) * 72 + fq * 8;           \
    const bf16_t* Bc = Bs + (buf_) * 128 * 72 + (wc * 64 + fr) * 72 + fq * 8;           \
    _Pragma("unroll") for (int ks = 0; ks < 2; ++ks) {                                  \
      bf16x8 a[4], b[4];                                                                \
      _Pragma("unroll") for (int i = 0; i < 4; ++i) {                                   \
        a[i] = *(const bf16x8*)(Ac + i * 16 * 72 + ks * 32);                            \
        b[i] = *(const bf16x8*)(Bc + i * 16 * 72 + ks * 32);                            \
      }                                                                                 \
      _Pragma("unroll") for (int i = 0; i < 4; ++i)                                     \
        _Pragma("unroll") for (int j = 0; j < 4; ++j) acc[i][j] = MFMA(a[i], b[j], acc[i][j]); \
    }                                                                                   \
  }
__device__ __forceinline__ void gemm_late_tile(const Params& p, int l, int mt_, int nt_, unsigned char* smem) {
  const bf16_t* Bt = p.WtIn + (size_t)l * 3712 * 1024;
  const int m0 = mt_ * 128, n0 = nt_ * 128;
  bf16_t* As = (bf16_t*)smem;
  bf16_t* Bs = As + 2 * 128 * 72;
  const int tid = launder(threadIdx.x), lane = tid & 63, w = tid >> 6, wr = w >> 1, wc = w & 1, fr = lane & 15, fq = lane >> 4;
  f32x4 acc[4][4];
#pragma unroll
  for (int i = 0; i < 4; ++i)
#pragma unroll
    for (int j = 0; j < 4; ++j) acc[i][j] = (f32x4){0.f, 0.f, 0.f, 0.f};
  const int lrow = tid >> 3, lkc = tid & 7;
  const int bb = m0 / TPB, pp0 = m0 % TPB;
  const bool isc0 = pp0 < 256;
  const float* xbase;
  if (l == 0) xbase = isc0 ? p.ctx + ((size_t)bb * 256 + pp0) * 1024 : p.x + ((size_t)bb * 4096 + pp0 - 256) * 1024;
  else xbase = isc0 ? p.ctxcur + ((size_t)bb * 256 + pp0) * 1024 : p.out + ((size_t)bb * 4096 + pp0 - 256) * 1024;
  const float* xr = xbase + (size_t)lrow * 1024 + lkc * 8;
  const float* md = p.mod + (size_t)(l * 5 + (isc0 ? 4 : bb)) * 3072 + lkc * 8;
  const float* nwp = p.norm_w + l * 1024 + lkc * 8;
  const float rs0 = p.rstd[m0 + lrow], rs1 = p.rstd[m0 + lrow + 32], rs2 = p.rstd[m0 + lrow + 64], rs3 = p.rstd[m0 + lrow + 96];
  const bf16_t* Bg = Bt + (size_t)(n0 + lrow) * 1024 + lkc * 8;
  float4 xa0, xb0, xa1, xb1, xa2, xb2, xa3, xb3, nwa, nwb, sca, scb, sha, shb;
  uint4 lb0, lb1, lb2, lb3;
#define L_LOAD(kt_)                                                                                   \
  {                                                                                                   \
    const int ko_ = (kt_) * 64;                                                                       \
    xa0 = *(const float4*)(xr + ko_); xb0 = *(const float4*)(xr + ko_ + 4);                            \
    xa1 = *(const float4*)(xr + 32 * 1024 + ko_); xb1 = *(const float4*)(xr + 32 * 1024 + ko_ + 4);    \
    xa2 = *(const float4*)(xr + 64 * 1024 + ko_); xb2 = *(const float4*)(xr + 64 * 1024 + ko_ + 4);    \
    xa3 = *(const float4*)(xr + 96 * 1024 + ko_); xb3 = *(const float4*)(xr + 96 * 1024 + ko_ + 4);    \
    lb0 = *(const uint4*)(Bg + ko_); lb1 = *(const uint4*)(Bg + (size_t)32 * 1024 + ko_);              \
    lb2 = *(const uint4*)(Bg + (size_t)64 * 1024 + ko_); lb3 = *(const uint4*)(Bg + (size_t)96 * 1024 + ko_); \
    nwa = *(const float4*)(nwp + ko_); nwb = *(const float4*)(nwp + ko_ + 4);                          \
    sca = *(const float4*)(md + 1024 + ko_); scb = *(const float4*)(md + 1024 + ko_ + 4);              \
    sha = *(const float4*)(md + ko_); shb = *(const float4*)(md + ko_ + 4);                            \
  }
#define L_ROW(xa_, xb_, rs_, i_, buf_)                                                                \
  {                                                                                                   \
    uint4 o_;                                                                                         \
    o_.x = pack2(xa_.x * rs_ * nwa.x * (1.f + sca.x) + sha.x, xa_.y * rs_ * nwa.y * (1.f + sca.y) + sha.y); \
    o_.y = pack2(xa_.z * rs_ * nwa.z * (1.f + sca.z) + sha.z, xa_.w * rs_ * nwa.w * (1.f + sca.w) + sha.w); \
    o_.z = pack2(xb_.x * rs_ * nwb.x * (1.f + scb.x) + shb.x, xb_.y * rs_ * nwb.y * (1.f + scb.y) + shb.y); \
    o_.w = pack2(xb_.z * rs_ * nwb.z * (1.f + scb.z) + shb.z, xb_.w * rs_ * nwb.w * (1.f + scb.w) + shb.w); \
    *(uint4*)(As + (buf_) * 128 * 72 + (lrow + 32 * (i_)) * 72 + lkc * 8) = o_;                       \
  }
#define L_STORE(buf_)                                                                                 \
  {                                                                                                   \
    L_ROW(xa0, xb0, rs0, 0, buf_) L_ROW(xa1, xb1, rs1, 1, buf_) L_ROW(xa2, xb2, rs2, 2, buf_) L_ROW(xa3, xb3, rs3, 3, buf_) \
    *(uint4*)(Bs + (buf_) * 128 * 72 + lrow * 72 + lkc * 8) = lb0;                                    \
    *(uint4*)(Bs + (buf_) * 128 * 72 + (lrow + 32) * 72 + lkc * 8) = lb1;                             \
    *(uint4*)(Bs + (buf_) * 128 * 72 + (lrow + 64) * 72 + lkc * 8) = lb2;                             \
    *(uint4*)(Bs + (buf_) * 128 * 72 + (lrow + 96) * 72 + lkc * 8) = lb3;                             \
  }
  L_LOAD(0);
  L_STORE(0);
  __syncthreads();
  for (int kt = 0; kt < 16; ++kt) {
    L_LOAD((kt + 1 < 16) ? kt + 1 : 15);
    G_COMPUTE(kt & 1);
    L_STORE((kt + 1) & 1);
    __syncthreads();
  }
  const int cbase = n0 + wc * 64;
    bf16_t* dst;
    int ld, coff;
    if (cbase < 1024) { dst = p.PA; ld = 1024; coff = cbase; }
    else if (cbase < 2048) { dst = p.PR; ld = 1024; coff = cbase - 1024; }
    else if (cbase < 2688) { dst = p.PG; ld = 640; coff = cbase - 2048; }
    else { dst = p.PS; ld = 912; coff = cbase - 2688; }
    bf16_t* wbuf = (bf16_t*)smem + w * (64 * 72);
#pragma unroll
    for (int i = 0; i < 4; ++i) {
#pragma unroll
      for (int j = 0; j < 4; ++j) {
        const int r = m0 + wr * 64 + i * 16 + fq * 4 + j;
        const int pp = r % TPB;
        float v0 = acc[i][0][j], v1 = acc[i][1][j], v2 = acc[i][2][j], v3 = acc[i][3][j];
        if (cbase < 512 && pp >= 256) {
          const int tt = pp - 256, rp = tt >> 6, cp = tt & 63;
          const float2 cs0 = *(const float2*)(p.rope + (rp * 16 + fr) * 2);
          const float2 cs1 = *(const float2*)(p.rope + (cp * 16 + fr) * 2);
          float n0_ = v0 * cs0.x - v1 * cs0.y, n1_ = v0 * cs0.y + v1 * cs0.x;
          float n2_ = v2 * cs1.x - v3 * cs1.y, n3_ = v2 * cs1.y + v3 * cs1.x;
          v0 = n0_; v1 = n1_; v2 = n2_; v3 = n3_;
        }
        if (cbase < 384) { v0 *= 0.125f; v1 *= 0.125f; v2 *= 0.125f; v3 *= 0.125f; }
        bf16_t* o = wbuf + (i * 16 + fq * 4 + j) * 72 + fr;
        o[0] = f2bf(v0); o[16] = f2bf(v1); o[32] = f2bf(v2); o[48] = f2bf(v3);
      }
    }
    __builtin_amdgcn_wave_barrier();
    {
      const int ch = lane & 7;
      const bool chv = (cbase + ch * 8) < 3600;
      const bool halo = (cbase >= 2688) && (cbase + 64 <= 3584);
#pragma unroll
      for (int t = 0; t < 8; ++t) {
        const int rl = (lane >> 3) + 8 * t;
        const uint4 v = *(const uint4*)(wbuf + rl * 72 + ch * 8);
        const int r = m0 + wr * 64 + rl;
        if (chv) *(uint4*)(dst + (size_t)r * ld + coff + ch * 8) = v;
        if (halo) {
          const int pp = r % TPB, q34 = pp % 34, t34 = pp / 34, bb = r / TPB;
          if (q34 == 33 && t34 + 1 < 128) *(uint4*)(p.HALO + ((size_t)(bb * 128 + t34 + 1) * 2 + 0) * 896 + coff + ch * 8) = v;
          if (q34 == 0 && t34 >= 1) *(uint4*)(p.HALO + ((size_t)(bb * 128 + t34 - 1) * 2 + 1) * 896 + coff + ch * 8) = v;
        }
      }
    }
  __syncthreads();
}

__device__ __forceinline__ void phase_inproj(const Params& p, int l, unsigned char* smem) {
  if ((gridDim.x & 7) == 0) {
    const int x = blockIdx.x & 7, slot = blockIdx.x >> 3, nslot = gridDim.x >> 3;
    (void)x; (void)slot; (void)nslot;
    for (int t = blockIdx.x; t < 64 * 24; t += gridDim.x) { const int ne = t % 24; gemm_tile256(p, l, t / 24, (ne < 16) ? ne : ne + 5, smem); }
    for (int t = blockIdx.x; t < 8 * 24; t += gridDim.x) { const int ne = t % 24; gemm_tile<0>(p, l, 128 + t / 24, (ne < 16) ? ne : ne + 5, smem); }
  } else {
    for (int t = blockIdx.x; t < 136 * 24; t += gridDim.x) { const int ne = t % 24; gemm_tile<0>(p, l, t / 24, (ne < 16) ? ne : ne + 5, smem); }
  }
}
__device__ __forceinline__ void phase_outproj(const Params& p, int l, unsigned char* smem) {
  if ((gridDim.x & 7) == 0) {
    const int x = blockIdx.x & 7, slot = blockIdx.x >> 3, nslot = gridDim.x >> 3;
    for (int j = slot; j < 17 * 8; j += nslot) {
      const int mt = (j >> 3) * 8 + x, nt = j & 7;
      if (l == 1 && (mt % 34) < 2) continue;
      gemm_tile<1>(p, l, mt, nt, smem);
    }
  } else {
    for (int t = blockIdx.x; t < 136 * 8; t += gridDim.x) {
      int mt = t >> 3, nt = t & 7;
      if (l == 1 && (mt % 34) < 2) continue;
      gemm_tile<1>(p, l, mt, nt, smem);
    }
  }
}

#define PRE_ARR ((size_t)TOK * 512)
__device__ __forceinline__ void rwkv_prep_tile(const Params& p, int l, int tile, unsigned char* smem) {
  const int d = tile & 1, tb = (tile >> 1) % 136, b = tile / 272;
  bf16_t* raw = (bf16_t*)smem;
  bf16_t* Aw = raw + 34 * 384;
  bf16_t* Aa = Aw + 32 * 72;
  const int tid = launder(threadIdx.x), lane = tid & 63, w = tid >> 6, fr = lane & 15, fq = lane >> 4;
  const int p0 = tb * 32;
  const int slo = (p0 < 256) ? 0 : 256, shi = (p0 < 256) ? 255 : 4351;
  const size_t rowbase = (size_t)b * TPB;
  const int ld2 = l * 2 + d;
  for (int q = tid; q < 34 * 48; q += 256) {
    const int rr = q / 48, cc = q % 48;
    const int tr = p0 - 1 + rr;
    const int col = (cc < 32) ? (256 + cc * 8) : ((cc < 40) ? (768 + d * 64 + (cc - 32) * 8) : (896 + d * 64 + (cc - 40) * 8));
    uint4 v = make_uint4(0, 0, 0, 0);
    if (tr >= slo && tr <= shi) v = *(const uint4*)(p.PR + (rowbase + tr) * 1024 + col);
    *(uint4*)(raw + rr * 384 + cc * 8) = v;
  }
  __syncthreads();
  const float* mu0 = p.rwkv_mu + (size_t)(l * 2 + 0) * 1024;
  const float* mu1 = p.rwkv_mu + (size_t)(l * 2 + 1) * 1024;
  {
    const int ca = tid & 63;
    const float m0wd = mu0[768 + d * 64 + ca], m1wd = mu1[768 + d * 64 + ca];
    const float m0ad = mu0[896 + d * 64 + ca], m1ad = mu1[896 + d * 64 + ca];
#pragma unroll 2
    for (int it = 0; it < 8; ++it) {
      const int i = w + 4 * it;
      const bf16_t* r0 = raw + (i + 1) * 384 + ca;
      float u = bf2f(r0[256]), up = bf2f(r0[256 - 384]), un = bf2f(r0[256 + 384]);
      Aw[i * 72 + ca] = f2bf(tanhf_(u + m0wd * (up - u) + m1wd * (un - u)));
      u = bf2f(r0[320]); up = bf2f(r0[320 - 384]); un = bf2f(r0[320 + 384]);
      Aa[i * 72 + ca] = f2bf(u + m0ad * (up - u) + m1ad * (un - u));
    }
  }
  __syncthreads();
  bf16x8 aw[2][2], aa[2][2];
#pragma unroll
  for (int mt = 0; mt < 2; ++mt)
#pragma unroll
    for (int ks = 0; ks < 2; ++ks) {
      aw[mt][ks] = *(const bf16x8*)(Aw + (mt * 16 + fr) * 72 + ks * 32 + fq * 8);
      aa[mt][ks] = *(const bf16x8*)(Aa + (mt * 16 + fr) * 72 + ks * 32 + fq * 8);
    }
  float kkr[2][4][4];
  float ssq[2][4];
#pragma unroll
  for (int mt = 0; mt < 2; ++mt)
#pragma unroll
    for (int j = 0; j < 4; ++j) ssq[mt][j] = 0.f;
#pragma unroll
  for (int nt = 0; nt < 4; ++nt) {
    const int c = w * 64 + nt * 16 + fr;
    const float m0k = mu0[256 + c], m1k = mu1[256 + c], kkc = p.rwkv_k_k[ld2 * 256 + c];
#pragma unroll
    for (int mt = 0; mt < 2; ++mt)
#pragma unroll
      for (int j = 0; j < 4; ++j) {
        const int i = mt * 16 + fq * 4 + j;
        const bf16_t* r0 = raw + (i + 1) * 384 + c;
        const float u = bf2f(r0[0]), up = bf2f(r0[-384]), un = bf2f(r0[384]);
        const float kq = (u + m0k * (up - u) + m1k * (un - u)) * kkc;
        kkr[mt][nt][j] = kq;
        ssq[mt][j] += kq * kq;
      }
  }
  float inv[2][4];
#pragma unroll
  for (int mt = 0; mt < 2; ++mt)
#pragma unroll
    for (int j = 0; j < 4; ++j) {
      const float tot = sum16(ssq[mt][j]);
      inv[mt][j] = frcp(fmaxf(__builtin_amdgcn_sqrtf(tot), 1e-12f));
    }
  __syncthreads();
  bf16_t* stg = (bf16_t*)smem;
#pragma unroll
  for (int nt = 0; nt < 4; ++nt) {
    const int c = w * 64 + nt * 16 + fr;
    const bf16_t* wup = p.WupT + ((size_t)(ld2 * 256 + c)) * 64 + fq * 8;
    const bf16_t* aup = p.AupT + ((size_t)(ld2 * 256 + c)) * 64 + fq * 8;
    const bf16x8 bw0 = *(const bf16x8*)wup, bw1 = *(const bf16x8*)(wup + 32);
    const bf16x8 ba0 = *(const bf16x8*)aup, ba1 = *(const bf16x8*)(aup + 32);
    const float w0c = p.rwkv_w0[ld2 * 256 + c], a0c = p.rwkv_a0[ld2 * 256 + c];
#pragma unroll
    for (int mt = 0; mt < 2; ++mt) {
      f32x4 accw = (f32x4){0.f, 0.f, 0.f, 0.f}, acca = (f32x4){0.f, 0.f, 0.f, 0.f};
      accw = MFMA(aw[mt][0], bw0, accw);
      accw = MFMA(aw[mt][1], bw1, accw);
      acca = MFMA(aa[mt][0], ba0, acca);
      acca = MFMA(aa[mt][1], ba1, acca);
#pragma unroll
      for (int j = 0; j < 4; ++j) {
        const int i = mt * 16 + fq * 4 + j;
        const float ew = 0.6065306597f * sigmoidf_(w0c + accw[j]);
        const float a = sigmoidf_(a0c + acca[j]);
        const float kk = kkr[mt][nt][j] * inv[mt][j];
        bf16_t* o = stg + i * 264 + c;
        o[0] = f2bf(ew);
        o[32 * 264] = f2bf(a);
        o[2 * 32 * 264] = f2bf(kk);
      }
    }
  }
  __syncthreads();
#pragma unroll
  for (int t = 0; t < 12; ++t) {
    const int q = tid + 256 * t;
    const int arr = q >> 10, i = (q >> 5) & 31, ch = q & 31;
    const uint4 v = *(const uint4*)(stg + (arr * 32 + i) * 264 + ch * 8);
    *(uint4*)(p.PRE + (size_t)arr * PRE_ARR + ((rowbase + p0 + i) * 2 + d) * 256 + ch * 8) = v;
  }
  __syncthreads();
}
__device__ __forceinline__ void ssd_conv_tile(const Params& p, int l, int tile, unsigned char* smem);
__device__ __forceinline__ void ssd_dtcum_tile(const Params& p, int l, int tile, unsigned char* smem);
__device__ __forceinline__ void phase_rwkvprep(const Params& p, int l, unsigned char* smem) {
  for (int t = blockIdx.x; t < 1088 + 512 + 544; t += gridDim.x) {
    if (t < 1088) rwkv_prep_tile(p, l, t, smem);
    else if (t < 1600) ssd_conv_tile(p, l, t - 1088, smem);
    else ssd_dtcum_tile(p, l, t - 1600, smem);
  }
}

typedef float v2f __attribute__((ext_vector_type(2)));
template <bool DUAL>
__device__ __forceinline__ void rwkv_tile(const Params& p, int l, int tile, unsigned char* smem) {
  const int part = tile >> 7;
  const int rg = tile & 3, h = (tile >> 2) & 3, b = (tile >> 4) & 3, d = (tile >> 6) & 1;
  const int cbeg = (part == 0) ? 0 : CSPLIT, cend = (part == 0) ? CSPLIT : 136;
  bf16_t* raw = (bf16_t*)smem;
  bf16_t* pre = raw + 34 * 192;
  float* rec = (float*)(smem + 13056 + 12288);
  const int tid = launder(threadIdx.x), lane = tid & 63, w = tid >> 6, fr = lane & 15, fq = lane >> 4;
  const int row = rg * 16 + w * 4 + fq;
  const int c0 = fr * 4;
  const int ld2 = l * 2 + d;
  const size_t rowbase = (size_t)b * TPB;
  const int lc = (tid & 15) * 4;
  const float* mu0 = p.rwkv_mu + (size_t)(l * 2 + 0) * 1024 + h * 64 + lc;
  const float* mu1 = p.rwkv_mu + (size_t)(l * 2 + 1) * 1024 + h * 64 + lc;
  const float4 m0r = *(const float4*)mu0, m1r = *(const float4*)mu1;
  const float4 m0k = *(const float4*)(mu0 + 256), m1k = *(const float4*)(mu1 + 256);
  const float4 m0v = *(const float4*)(mu0 + 512), m1v = *(const float4*)(mu1 + 512);
  const float4 ka4 = *(const float4*)(p.rwkv_k_a + ld2 * 256 + h * 64 + lc);
  v2f sA = {0.f, 0.f}, sB = {0.f, 0.f};
  v2f iA = {(row == c0) ? 1.f : 0.f, (row == c0 + 1) ? 1.f : 0.f}, iB = {(row == c0 + 2) ? 1.f : 0.f, (row == c0 + 3) ? 1.f : 0.f};
  const int pcc = tid % 24, prow = tid / 24;
  const bool pact = tid < 240;
  const bf16_t* rbase_g = p.PR + rowbase * 1024 + (pcc >> 3) * 256 + h * 64 + (pcc & 7) * 8;
  const bf16_t* pbase_g = p.PRE + (size_t)(pcc >> 3) * PRE_ARR + (rowbase * 2 + d) * 256 + h * 64 + (pcc & 7) * 8;
  uint4 pf0, pf1, pf2, pf3, pg0, pg1, pg2, pg3;
#define RW_GEOM(cix_, plo_, slo_, shi_)                                                   \
  {                                                                                       \
    const int st0_ = (cix_) * 32;                                                         \
    if (st0_ < 256) { slo_ = 0; shi_ = 255; plo_ = (d == 0) ? st0_ : 224 - st0_; }         \
    else { slo_ = 256; shi_ = 4351; plo_ = (d == 0) ? st0_ : 4576 - st0_; }                \
  }
#define RW_PF1(dst_, rr_, plo_, slo_, shi_)                                                         \
  {                                                                                                 \
    const int tr_ = (plo_) - 1 + (rr_);                                                             \
    dst_ = make_uint4(0, 0, 0, 0);                                                                  \
    if (pact && (rr_) < 34 && tr_ >= (slo_) && tr_ <= (shi_)) dst_ = *(const uint4*)(rbase_g + (size_t)tr_ * 1024); \
  }
#define RW_PG1(dst_, rr_, plo_)                                                                     \
  {                                                                                                 \
    dst_ = make_uint4(0, 0, 0, 0);                                                                  \
    if (pact && (rr_) < 32) dst_ = *(const uint4*)(pbase_g + (size_t)((plo_) + (rr_)) * 512);       \
  }
#define RW_PREFETCH(cix_)                                                                 \
  {                                                                                       \
    int plo_, slo_, shi_;                                                                 \
    RW_GEOM(cix_, plo_, slo_, shi_);                                                      \
    RW_PF1(pf0, prow, plo_, slo_, shi_); RW_PF1(pf1, prow + 10, plo_, slo_, shi_);        \
    RW_PF1(pf2, prow + 20, plo_, slo_, shi_); RW_PF1(pf3, prow + 30, plo_, slo_, shi_);   \
    RW_PG1(pg0, prow, plo_); RW_PG1(pg1, prow + 10, plo_);                                \
    RW_PG1(pg2, prow + 20, plo_); RW_PG1(pg3, prow + 30, plo_);                           \
  }
#define RW_STASH()                                                                        \
  {                                                                                       \
    if (pact) {                                                                           \
      *(uint4*)(raw + prow * 192 + pcc * 8) = pf0;                                        \
      *(uint4*)(raw + (prow + 10) * 192 + pcc * 8) = pf1;                                 \
      *(uint4*)(raw + (prow + 20) * 192 + pcc * 8) = pf2;                                 \
      if (prow + 30 < 34) *(uint4*)(raw + (prow + 30) * 192 + pcc * 8) = pf3;             \
      *(uint4*)(pre + prow * 192 + pcc * 8) = pg0;                                        \
      *(uint4*)(pre + (prow + 10) * 192 + pcc * 8) = pg1;                                 \
      *(uint4*)(pre + (prow + 20) * 192 + pcc * 8) = pg2;                                 \
      if (prow + 30 < 32) *(uint4*)(pre + (prow + 30) * 192 + pcc * 8) = pg3;             \
    }                                                                                     \
  }
  RW_PREFETCH(cbeg);
  RW_STASH();
  __syncthreads();
  for (int cix = cbeg; cix < cend; ++cix) {
    int plo, slo, shi;
    RW_GEOM(cix, plo, slo, shi);
#pragma unroll
    for (int k = 0; k < 2; ++k) {
      const int i = (tid >> 4) + 16 * k;
      const int ri = (d == 0) ? i + 1 : 32 - i;
      const bf16_t* r0 = raw + ri * 192 + lc;
      const bf16_t* q0 = pre + (ri - 1) * 192 + lc;
      float rs[4], ksv[4], vs[4];
#pragma unroll
      for (int sl = 0; sl < 3; ++sl) {
        const uint2 uc = *(const uint2*)(r0 + sl * 64), up = *(const uint2*)(r0 + sl * 64 - 192), un = *(const uint2*)(r0 + sl * 64 + 192);
        const float4 m0 = (sl == 0) ? m0r : ((sl == 1) ? m0k : m0v);
        const float4 m1 = (sl == 0) ? m1r : ((sl == 1) ? m1k : m1v);
        float* dst = (sl == 0) ? rs : ((sl == 1) ? ksv : vs);
        float u, a, n;
        u = __uint_as_float(uc.x << 16); a = __uint_as_float(up.x << 16); n = __uint_as_float(un.x << 16);
        dst[0] = u + m0.x * (a - u) + m1.x * (n - u);
        u = __uint_as_float(uc.x & 0xffff0000u); a = __uint_as_float(up.x & 0xffff0000u); n = __uint_as_float(un.x & 0xffff0000u);
        dst[1] = u + m0.y * (a - u) + m1.y * (n - u);
        u = __uint_as_float(uc.y << 16); a = __uint_as_float(up.y << 16); n = __uint_as_float(un.y << 16);
        dst[2] = u + m0.z * (a - u) + m1.z * (n - u);
        u = __uint_as_float(uc.y & 0xffff0000u); a = __uint_as_float(up.y & 0xffff0000u); n = __uint_as_float(un.y & 0xffff0000u);
        dst[3] = u + m0.w * (a - u) + m1.w * (n - u);
      }
      const uint2 ue = *(const uint2*)(q0), ua = *(const uint2*)(q0 + 64), uk = *(const uint2*)(q0 + 128);
      const float ew[4] = {__uint_as_float(ue.x << 16), __uint_as_float(ue.x & 0xffff0000u), __uint_as_float(ue.y << 16), __uint_as_float(ue.y & 0xffff0000u)};
      const float av[4] = {__uint_as_float(ua.x << 16), __uint_as_float(ua.x & 0xffff0000u), __uint_as_float(ua.y << 16), __uint_as_float(ua.y & 0xffff0000u)};
      const float kk[4] = {__uint_as_float(uk.x << 16), __uint_as_float(uk.x & 0xffff0000u), __uint_as_float(uk.y << 16), __uint_as_float(uk.y & 0xffff0000u)};
      const float kav[4] = {ka4.x, ka4.y, ka4.z, ka4.w};
      float4 o0, o1, o2, o3, o4, o5;
      float* f0 = (float*)&o0; float* f1 = (float*)&o1; float* f2 = (float*)&o2; float* f3 = (float*)&o3; float* f4 = (float*)&o4; float* f5 = (float*)&o5;
#pragma unroll
      for (int e = 0; e < 4; ++e) {
        f0[e] = __expf(-ew[e]);
        f1[e] = kk[e];
        f2[e] = kk[e] * av[e];
        f3[e] = ksv[e] * (1.f + (av[e] - 1.f) * kav[e]);
        f4[e] = rs[e];
        f5[e] = vs[e];
      }
      float* rp = rec + i * 384 + lc;
      *(float4*)(rp) = o0; *(float4*)(rp + 64) = o1; *(float4*)(rp + 128) = o2;
      *(float4*)(rp + 192) = o3; *(float4*)(rp + 256) = o4; *(float4*)(rp + 320) = o5;
    }
    __syncthreads();
    if (cix + 1 < cend) RW_PREFETCH(cix + 1);
    {
      const float* rp = rec + c0;
      const float* vp = rec + 320 + row;
      float4 w4 = *(const float4*)(rp), kk4 = *(const float4*)(rp + 64), kb4 = *(const float4*)(rp + 128);
      float4 kd4 = *(const float4*)(rp + 192), r4 = *(const float4*)(rp + 256);
      float v = vp[0];
      float ykeep = 0.f, gkeep = 0.f;
#pragma unroll 2
      for (int i = 0; i < 32; ++i) {
        const int inx = (i + 1) & 31;
        const float4 nw4 = *(const float4*)(rp + inx * 384), nkk4 = *(const float4*)(rp + inx * 384 + 64), nkb4 = *(const float4*)(rp + inx * 384 + 128);
        const float4 nkd4 = *(const float4*)(rp + inx * 384 + 192), nr4 = *(const float4*)(rp + inx * 384 + 256);
        const float nv = vp[inx * 384];
        v2f t = sA * (v2f){kk4.x, kk4.y};
        t = sB * (v2f){kk4.z, kk4.w} + t;
        float sa = t.x + t.y, ia = 0.f;
        if (DUAL) {
          v2f ti = iA * (v2f){kk4.x, kk4.y};
          ti = iB * (v2f){kk4.z, kk4.w} + ti;
          ia = ti.x + ti.y;
          sa += dppf<0xB1>(sa); ia += dppf<0xB1>(ia);
          sa += dppf<0x4E>(sa); ia += dppf<0x4E>(ia);
          sa += dppf<0x141>(sa); ia += dppf<0x141>(ia);
          sa += dppf<0x140>(sa); ia += dppf<0x140>(ia);
        } else {
          sa = sum16(sa);
        }
        v2f cA = sA * (v2f){w4.x, w4.y} + (v2f){kd4.x, kd4.y} * v;
        v2f cB = sB * (v2f){w4.z, w4.w} + (v2f){kd4.z, kd4.w} * v;
        sA = cA - (v2f){kb4.x, kb4.y} * sa;
        sB = cB - (v2f){kb4.z, kb4.w} * sa;
        v2f u = sA * (v2f){r4.x, r4.y};
        u = sB * (v2f){r4.z, r4.w} + u;
        float y = u.x + u.y, g = 0.f;
        if (DUAL) {
          iA = iA * (v2f){w4.x, w4.y} - (v2f){kb4.x, kb4.y} * ia;
          iB = iB * (v2f){w4.z, w4.w} - (v2f){kb4.z, kb4.w} * ia;
          v2f ui = iA * (v2f){r4.x, r4.y};
          ui = iB * (v2f){r4.z, r4.w} + ui;
          g = ui.x + ui.y;
          y += dppf<0xB1>(y); g += dppf<0xB1>(g);
          y += dppf<0x4E>(y); g += dppf<0x4E>(g);
          y += dppf<0x141>(y); g += dppf<0x141>(g);
          y += dppf<0x140>(y); g += dppf<0x140>(g);
          if (fr == (i & 15)) gkeep = g;
        } else {
          y = sum16(y);
        }
        if (fr == (i & 15)) ykeep = y;
        if ((i & 15) == 15) {
          const int ii = (i & 16) + fr;
          const int ri = (d == 0) ? ii + 1 : 32 - ii;
          const int pi = plo - 1 + ri;
          p.yR[((size_t)d * TOK + rowbase + pi) * 256 + h * 64 + row] = f2bf(ykeep);
          if (DUAL) p.GID[((size_t)(d * 4 + b) * NSEG1 + (cix - CSPLIT) * 32 + ii) * 256 + h * 64 + row] = f2bf(gkeep);
        }
        w4 = nw4; kk4 = nkk4; kb4 = nkb4; kd4 = nkd4; r4 = nr4; v = nv;
      }
    }
    if (cix + 1 < cend) RW_STASH();
    __syncthreads();
  }
  if (part == 0) *(float4*)(p.SMID + ((size_t)(((d * 4 + b) * 4 + h) * 64 + row)) * 64 + c0) = make_float4(sA.x, sA.y, sB.x, sB.y);
}

__device__ __forceinline__ void rwkv_fix_tile(const Params& p, int tile) {
  const int mb = tile % (NSEG1 / 64), dbh = tile / (NSEG1 / 64), h = dbh & 3, b = (dbh >> 2) & 3, d = dbh >> 4;
  const int tid = launder(threadIdx.x), lane = tid & 63, w = tid >> 6, fr = lane & 15, fq = lane >> 4;
  const size_t rowbase = (size_t)b * TPB;
  const int s0 = mb * 64 + 16 * w;
  const bf16_t* gp = p.GID + ((size_t)(d * 4 + b) * NSEG1 + s0 + fr) * 256 + h * 64 + fq * 8;
  const bf16x8 a0 = *(const bf16x8*)gp, a1 = *(const bf16x8*)(gp + 32);
#pragma unroll
  for (int nt = 0; nt < 4; ++nt) {
    const float* sp = p.SMID + ((size_t)(dbh * 64 + nt * 16 + fr)) * 64 + fq * 8;
    const float4 f0 = *(const float4*)sp, f1 = *(const float4*)(sp + 4), f2 = *(const float4*)(sp + 32), f3 = *(const float4*)(sp + 36);
    union { unsigned u[4]; bf16x8 v; } b0, b1;
    b0.u[0] = pack2(f0.x, f0.y); b0.u[1] = pack2(f0.z, f0.w); b0.u[2] = pack2(f1.x, f1.y); b0.u[3] = pack2(f1.z, f1.w);
    b1.u[0] = pack2(f2.x, f2.y); b1.u[1] = pack2(f2.z, f2.w); b1.u[2] = pack2(f3.x, f3.y); b1.u[3] = pack2(f3.z, f3.w);
    f32x4 acc = (f32x4){0.f, 0.f, 0.f, 0.f};
    acc = MFMA(a0, b0.v, acc);
    acc = MFMA(a1, b1.v, acc);
#pragma unroll
    for (int j = 0; j < 4; ++j) {
      const int st = CSPLIT * 32 + s0 + fq * 4 + j;
      const int pp = (d == 0) ? st : ((st < 256) ? 255 - st : 4607 - st);
      bf16_t* yp = p.yR + ((size_t)d * TOK + rowbase + pp) * 256 + h * 64 + nt * 16 + fr;
      *yp = f2bf(bf2f(*yp) + acc[j]);
    }
  }
}
__device__ __forceinline__ void phase_rwkvfix(const Params& p) {
  for (int t = blockIdx.x; t < 32 * (NSEG1 / 64); t += gridDim.x) rwkv_fix_tile(p, t);
}

__device__ __forceinline__ void ssd_conv_tile(const Params& p, int l, int tile, unsigned char* smem) {
  const int b = tile >> 7, t34 = tile & 127, pp0 = t34 * 34;
  const size_t r0 = (size_t)b * TPB + pp0;
  bf16_t* T = (bf16_t*)smem;
  const int tid = launder(threadIdx.x);
  for (int q = tid; q < 34 * 112; q += 256) {
    const int rr = q / 112, cc = q % 112;
    *(uint4*)(T + (rr + 1) * 896 + cc * 8) = *(const uint4*)(p.PS + (r0 + rr) * 912 + cc * 8);
  }
  if (tid < 224) {
    const int which = tid / 112, cc = tid % 112;
    const bool ex = (which == 0) ? (t34 >= 1) : (t34 + 1 < 128);
    uint4 v = make_uint4(0, 0, 0, 0);
    if (ex) v = *(const uint4*)(p.HALO + ((size_t)(b * 128 + t34) * 2 + which) * 896 + cc * 8);
    *(uint4*)(T + (which ? 35 : 0) * 896 + cc * 8) = v;
  }
  __syncthreads();
  const float* cw = p.ssm_conv_w + (size_t)l * 3 * 896;
  const float* cb = p.ssm_conv_b + (size_t)l * 896;
  if (tid < 224) {
    const int g8 = tid % 112, rpar = tid / 112, c0 = g8 * 8;
    float w0[8], w1[8], w2[8], bs[8];
#pragma unroll
    for (int e = 0; e < 8; ++e) { w0[e] = cw[c0 + e]; w1[e] = cw[896 + c0 + e]; w2[e] = cw[1792 + c0 + e]; bs[e] = cb[c0 + e]; }
#pragma unroll 1
    for (int rr = rpar; rr < 34; rr += 2) {
      const uint4 um = *(const uint4*)(T + rr * 896 + c0), u0 = *(const uint4*)(T + (rr + 1) * 896 + c0), up = *(const uint4*)(T + (rr + 2) * 896 + c0);
      const int pp = pp0 + rr;
      const float pv = ((pp != 0) && (pp != 256)) ? 1.f : 0.f, nv = ((pp != 255) && (pp != 4351)) ? 1.f : 0.f;
      const unsigned am[4] = {um.x, um.y, um.z, um.w}, a0[4] = {u0.x, u0.y, u0.z, u0.w}, ap[4] = {up.x, up.y, up.z, up.w};
      unsigned o[4];
#pragma unroll
      for (int e = 0; e < 4; ++e) {
        const float va = w0[2 * e] * (pv * blo(am[e])) + w1[2 * e] * blo(a0[e]) + w2[2 * e] * (nv * blo(ap[e])) + bs[2 * e];
        const float vb = w0[2 * e + 1] * (pv * bhi(am[e])) + w1[2 * e + 1] * bhi(a0[e]) + w2[2 * e + 1] * (nv * bhi(ap[e])) + bs[2 * e + 1];
        o[e] = pack2(siluf_(va), siluf_(vb));
      }
      *(uint4*)(p.PS + (r0 + rr) * 912 + c0) = make_uint4(o[0], o[1], o[2], o[3]);
    }
  }
  __syncthreads();
}
__device__ __forceinline__ void ssd_dtcum_tile(const Params& p, int l, int tile, unsigned char* smem) {
  const int b = tile / 136, c32 = tile % 136, p0 = c32 * 32;
  float* draw = (float*)smem;
  const int tid = launder(threadIdx.x);
  for (int q = tid; q < 384; q += 256) {
    const int i = q / 12, dh = q % 12;
    draw[q] = bf2f(p.PS[((size_t)b * TPB + p0 + i) * 912 + 896 + dh]);
  }
  __syncthreads();
  if (tid < 12) {
    const int dh = tid, d = dh / 6, h = dh % 6;
    const float a_neg = -__expf(p.ssm_a_log[(l * 2 + d) * 6 + h]);
    const float bias = p.ssm_dt_bias[(l * 2 + d) * 6 + h];
    float cum = 0.f;
    for (int k = 0; k < 32; ++k) {
      const int it = (d == 0) ? k : 31 - k;
      const float dt = softplusf_(draw[it * 12 + dh] + bias);
      cum += dt * a_neg;
      p.DTC[(size_t)dh * TOK + (size_t)b * TPB + p0 + it] = make_float2(dt, cum);
    }
  }
  __syncthreads();
}

__device__ __forceinline__ void ssd_tile(const Params& p, int l, int tile, unsigned char* smem) {
  const int h = tile % 6, b = (tile / 6) & 3, d = tile / 24, g = h / 3;
  bf16_t* Cs0 = (bf16_t*)smem;
  bf16_t* Bs = Cs0 + 2 * 32 * 136;
  bf16_t* Xs = Bs + 32 * 136;
  bf16_t* BtT = Xs + 32 * 72;
  bf16_t* XdT = BtT + 128 * 40;
  bf16_t* Ms = XdT + 64 * 40;
  bf16_t* Sb = Ms + 32 * 40;
  float* dc = (float*)(Sb + 64 * 136);
  const int tid = launder(threadIdx.x), lane = tid & 63, w = tid >> 6, fr = lane & 15, fq = lane >> 4;
  const size_t rowbase = (size_t)b * TPB;
  f32x4 S[4][2];
#pragma unroll
  for (int i = 0; i < 4; ++i)
#pragma unroll
    for (int j = 0; j < 2; ++j) S[i][j] = (f32x4){0.f, 0.f, 0.f, 0.f};
  const int pcc = tid % 40, prow = tid / 40;
  const bool pact = tid < 240;
  const int pcol = (pcc < 16) ? (640 + g * 128 + pcc * 8) : ((pcc < 32) ? (384 + g * 128 + (pcc - 16) * 8) : (h * 64 + (pcc - 32) * 8));
  const bf16_t* pbase = p.PS + rowbase * 912 + pcol;
  const float2* dbase = p.DTC + (size_t)(d * 6 + h) * TOK + rowbase;
  const int drow_stride = (pcc < 32) ? 136 : 72;
  uint4 pf0, pf1, pf2, pf3, pf4, pf5;
  float2 dtc = make_float2(0.f, 0.f);
#define SD_GEOM(cix_, plo_)                                                \
  {                                                                        \
    const int st0_ = (cix_) * 32;                                          \
    if (st0_ < 256) plo_ = (d == 0) ? st0_ : 224 - st0_;                   \
    else plo_ = (d == 0) ? st0_ : 4576 - st0_;                             \
  }
#define SD_PF1(dst_, rr_, plo_)                                                                   \
  {                                                                                               \
    dst_ = make_uint4(0, 0, 0, 0);                                                                \
    if (pact && (rr_) < 32) dst_ = *(const uint4*)(pbase + (size_t)((plo_) + (rr_)) * 912);       \
  }
#define SD_PREFETCH(cix_)                                                          \
  {                                                                                \
    int plo_;                                                                      \
    SD_GEOM(cix_, plo_);                                                           \
    SD_PF1(pf0, prow, plo_); SD_PF1(pf1, prow + 6, plo_); SD_PF1(pf2, prow + 12, plo_); \
    SD_PF1(pf3, prow + 18, plo_); SD_PF1(pf4, prow + 24, plo_); SD_PF1(pf5, prow + 30, plo_); \
    if (tid < 32) dtc = dbase[plo_ + tid];                                         \
  }
#define SD_ST1(src_, rr_, cbuf_)                                                                  \
  {                                                                                               \
    if (pact && (rr_) < 32) {                                                                     \
      const int i_ = (d == 0) ? (rr_) : 31 - (rr_);                                               \
      bf16_t* dst_ = (pcc < 16) ? ((cbuf_) + i_ * 136 + pcc * 8) : ((pcc < 32) ? (Bs + i_ * 136 + (pcc - 16) * 8) : (Xs + i_ * 72 + (pcc - 32) * 8)); \
      *(uint4*)dst_ = src_;                                                                       \
    }                                                                                             \
  }
#define SD_STASH(buf_)                                                              \
  {                                                                                 \
    bf16_t* cbuf_ = Cs0 + (buf_) * 32 * 136;                                        \
    SD_ST1(pf0, prow, cbuf_); SD_ST1(pf1, prow + 6, cbuf_); SD_ST1(pf2, prow + 12, cbuf_); \
    SD_ST1(pf3, prow + 18, cbuf_); SD_ST1(pf4, prow + 24, cbuf_); SD_ST1(pf5, prow + 30, cbuf_); \
    if (tid < 32) {                                                                 \
      const int i_ = (d == 0) ? tid : 31 - tid;                                     \
      dc[(buf_) * 64 + i_] = dtc.x;                                                 \
      dc[(buf_) * 64 + 32 + i_] = dtc.y;                                            \
    }                                                                               \
  }
  (void)drow_stride;
  SD_PREFETCH(0);
  SD_STASH(0);
  __syncthreads();
  for (int cix = 0; cix < 136; ++cix) {
    int plo;
    SD_GEOM(cix, plo);
    const int buf = cix & 1;
    const bf16_t* Cs = Cs0 + buf * 32 * 136;
    const float* dts = dc + buf * 64;
    const float* cums = dts + 32;
    {
      const int j = tid & 31, ng = tid >> 5;
      const float tail = __expf(cums[31] - cums[j]);
      const float dtj = dts[j];
      const uint4 b0 = *(const uint4*)(Bs + j * 136 + ng * 16), b1 = *(const uint4*)(Bs + j * 136 + ng * 16 + 8);
      const uint4 x0 = *(const uint4*)(Xs + j * 72 + ng * 8);
      const unsigned bw[8] = {b0.x, b0.y, b0.z, b0.w, b1.x, b1.y, b1.z, b1.w};
      const unsigned xw[4] = {x0.x, x0.y, x0.z, x0.w};
#pragma unroll
      for (int e = 0; e < 8; ++e) {
        const unsigned pk = pack2(__uint_as_float(bw[e] << 16) * tail, __uint_as_float(bw[e] & 0xffff0000u) * tail);
        BtT[(ng * 16 + 2 * e) * 40 + j] = (bf16_t)(pk & 0xffffu);
        BtT[(ng * 16 + 2 * e + 1) * 40 + j] = (bf16_t)(pk >> 16);
      }
#pragma unroll
      for (int e = 0; e < 4; ++e) {
        const unsigned pk = pack2(__uint_as_float(xw[e] << 16) * dtj, __uint_as_float(xw[e] & 0xffff0000u) * dtj);
        XdT[(ng * 8 + 2 * e) * 40 + j] = (bf16_t)(pk & 0xffffu);
        XdT[(ng * 8 + 2 * e + 1) * 40 + j] = (bf16_t)(pk >> 16);
      }
#pragma unroll
      for (int mt = 0; mt < 4; ++mt)
#pragma unroll
        for (int t = 0; t < 2; ++t)
#pragma unroll
          for (int jj = 0; jj < 4; ++jj) Sb[(mt * 16 + fq * 4 + jj) * 136 + (2 * w + t) * 16 + fr] = f2bf(S[mt][t][jj]);
      const int mi = w >> 1, nj = w & 1;
      f32x4 acc = (f32x4){0.f, 0.f, 0.f, 0.f};
#pragma unroll
      for (int ks = 0; ks < 4; ++ks) {
        bf16x8 a = *(const bf16x8*)(Cs + (mi * 16 + fr) * 136 + ks * 32 + fq * 8);
        bf16x8 bb = *(const bf16x8*)(Bs + (nj * 16 + fr) * 136 + ks * 32 + fq * 8);
        acc = MFMA(a, bb, acc);
      }
      const int jc = nj * 16 + fr;
      const float cj = cums[jc];
#pragma unroll
      for (int jj = 0; jj < 4; ++jj) {
        const int i = mi * 16 + fq * 4 + jj;
        const float v = (jc <= i) ? acc[jj] * __expf(cums[i] - cj) : 0.f;
        Ms[i * 40 + jc] = f2bf(v);
      }
    }
    __syncthreads();
    if (cix + 1 < 136) SD_PREFETCH(cix + 1);
    {
      const int mi = w >> 1;
      bf16x8 am = *(const bf16x8*)(Ms + (mi * 16 + fr) * 40 + fq * 8);
      bf16x8 ac[4];
#pragma unroll
      for (int ks = 0; ks < 4; ++ks) ac[ks] = *(const bf16x8*)(Cs + (mi * 16 + fr) * 136 + ks * 32 + fq * 8);
#pragma unroll
      for (int t = 0; t < 2; ++t) {
        const int pt = 2 * (w & 1) + t;
        f32x4 y1 = (f32x4){0.f, 0.f, 0.f, 0.f}, y2 = (f32x4){0.f, 0.f, 0.f, 0.f};
        bf16x8 bx = *(const bf16x8*)(XdT + (pt * 16 + fr) * 40 + fq * 8);
        y1 = MFMA(am, bx, y1);
#pragma unroll
        for (int ks = 0; ks < 4; ++ks) {
          bf16x8 bs = *(const bf16x8*)(Sb + (pt * 16 + fr) * 136 + ks * 32 + fq * 8);
          y2 = MFMA(ac[ks], bs, y2);
        }
#pragma unroll
        for (int jj = 0; jj < 4; ++jj) {
          const int i = mi * 16 + fq * 4 + jj;
          const int pi = plo + ((d == 0) ? i : 31 - i);
          const float y = y1[jj] + __expf(cums[i]) * y2[jj];
          p.yS[((size_t)d * TOK + rowbase + pi) * 384 + h * 64 + pt * 16 + fr] = f2bf(y);
        }
      }
      const float dec = __expf(cums[31]);
      bf16x8 bt[2];
#pragma unroll
      for (int t = 0; t < 2; ++t) bt[t] = *(const bf16x8*)(BtT + ((2 * w + t) * 16 + fr) * 40 + fq * 8);
#pragma unroll
      for (int mt = 0; mt < 4; ++mt) {
        bf16x8 ax = *(const bf16x8*)(XdT + (mt * 16 + fr) * 40 + fq * 8);
#pragma unroll
        for (int t = 0; t < 2; ++t) {
          S[mt][t] *= dec;
          S[mt][t] = MFMA(ax, bt[t], S[mt][t]);
        }
      }
    }
    if (cix + 1 < 136) SD_STASH(buf ^ 1);
    __syncthreads();
  }
}

__device__ __forceinline__ void attn_tile(const Params& p, int l, int tile, unsigned char* smem) {
  const bool isctx = tile >= 768;
  int qt, head, b;
  if (!isctx) { qt = tile & 31; head = (tile >> 5) % 6; b = tile / 192; }
  else { int tt = tile - 768; qt = tt & 1; head = (tt >> 1) % 6; b = tt / 12; }
  const int hkv = head / 3;
  const int tid = launder(threadIdx.x), lane = tid & 63, w = tid >> 6, fr = lane & 15, fq = lane >> 4;
  bf16_t* Ks = (bf16_t*)smem;
  bf16_t* Vt = Ks + 64 * 72;
  bf16_t* Ps = Vt + 64 * 72 + w * 32 * 72;
  const int q0 = qt * 128;
  const size_t rowb = (size_t)b * TPB;
  const size_t rowq0 = rowb + (isctx ? q0 : 256 + q0);
  bf16x8 qf[2][2];
  float m[2][4], ls[2][4];
  f32x4 o[2][4];
  const float sk = p.attn_sink[l * 6 + head];
#pragma unroll
  for (int mt = 0; mt < 2; ++mt) {
    const int qi0 = (2 * w + mt) * 16;
#pragma unroll
    for (int ks = 0; ks < 2; ++ks) qf[mt][ks] = *(const bf16x8*)(p.PA + (rowq0 + qi0 + fr) * 1024 + head * 64 + ks * 32 + fq * 8);
#pragma unroll
    for (int j = 0; j < 4; ++j) { m[mt][j] = sk; ls[mt][j] = 1.f; }
#pragma unroll
    for (int nt = 0; nt < 4; ++nt) o[mt][nt] = (f32x4){0.f, 0.f, 0.f, 0.f};
  }
  int klo = 0, nb = 0;
  if (!isctx) {
    klo = max(0, q0 - 128);
    const int khi = min(4096, q0 + 256);
    nb = (khi - klo) >> 6;
  }
  const int ntile = nb + 4;
  const int lr = tid >> 3, lc = tid & 7;
  uint4 kr0, kr1, vr0, vr1;
#define KVLOAD(kt_)                                                                              \
  {                                                                                              \
    const size_t kr0_ = ((kt_) < nb) ? rowb + 256 + klo + (kt_) * 64 : rowb + ((kt_) - nb) * 64; \
    const bf16_t* src0 = p.PA + (kr0_ + lr) * 1024 + 384 + hkv * 64 + lc * 8;                    \
    const bf16_t* src1 = src0 + 32 * 1024;                                                       \
    kr0 = *(const uint4*)src0;                                                                   \
    vr0 = *(const uint4*)(src0 + 128);                                                           \
    kr1 = *(const uint4*)src1;                                                                   \
    vr1 = *(const uint4*)(src1 + 128);                                                           \
  }
#define VTSTORE(vr_, rr_)                                                 \
  {                                                                       \
    Vt[(lc * 8 + 0) * 72 + (rr_)] = (bf16_t)((vr_).x & 0xffffu);          \
    Vt[(lc * 8 + 1) * 72 + (rr_)] = (bf16_t)((vr_).x >> 16);              \
    Vt[(lc * 8 + 2) * 72 + (rr_)] = (bf16_t)((vr_).y & 0xffffu);          \
    Vt[(lc * 8 + 3) * 72 + (rr_)] = (bf16_t)((vr_).y >> 16);              \
    Vt[(lc * 8 + 4) * 72 + (rr_)] = (bf16_t)((vr_).z & 0xffffu);          \
    Vt[(lc * 8 + 5) * 72 + (rr_)] = (bf16_t)((vr_).z >> 16);              \
    Vt[(lc * 8 + 6) * 72 + (rr_)] = (bf16_t)((vr_).w & 0xffffu);          \
    Vt[(lc * 8 + 7) * 72 + (rr_)] = (bf16_t)((vr_).w >> 16);              \
  }
  KVLOAD(0);
  for (int kt = 0; kt < ntile; ++kt) {
    __syncthreads();
    *(uint4*)(Ks + lr * 72 + lc * 8) = kr0;
    *(uint4*)(Ks + (lr + 32) * 72 + lc * 8) = kr1;
    VTSTORE(vr0, lr);
    VTSTORE(vr1, lr + 32);
    __syncthreads();
    if (kt + 1 < ntile) KVLOAD(kt + 1);
    f32x4 s[2][4];
#pragma unroll
    for (int mt = 0; mt < 2; ++mt)
#pragma unroll
      for (int nt = 0; nt < 4; ++nt) s[mt][nt] = (f32x4){0.f, 0.f, 0.f, 0.f};
#pragma unroll
    for (int ks = 0; ks < 2; ++ks) {
#pragma unroll
      for (int nt = 0; nt < 4; ++nt) {
        bf16x8 kb = *(const bf16x8*)(Ks + (nt * 16 + fr) * 72 + ks * 32 + fq * 8);
#pragma unroll
        for (int mt = 0; mt < 2; ++mt) s[mt][nt] = MFMA(qf[mt][ks], kb, s[mt][nt]);
      }
    }
    const bool band = kt < nb;
    const int kp0 = klo + kt * 64 + fr;
#pragma unroll
    for (int mt = 0; mt < 2; ++mt) {
      const int qi0 = (2 * w + mt) * 16;
#pragma unroll
      for (int j = 0; j < 4; ++j) {
        const int qp = q0 + qi0 + fq * 4 + j;
        float sv0 = s[mt][0][j], sv1 = s[mt][1][j], sv2 = s[mt][2][j], sv3 = s[mt][3][j];
        if (band) {
          const int dlt = qp - kp0;
          if (dlt > 128 || dlt < -128) sv0 = -INFINITY;
          if (dlt - 16 > 128 || dlt - 16 < -128) sv1 = -INFINITY;
          if (dlt - 32 > 128 || dlt - 32 < -128) sv2 = -INFINITY;
          if (dlt - 48 > 128 || dlt - 48 < -128) sv3 = -INFINITY;
        }
        float mx = fmaxf(fmaxf(sv0, sv1), fmaxf(sv2, sv3));
        mx = max16(mx);
        const float mn = fmaxf(m[mt][j], mx);
        const float alpha = __expf(m[mt][j] - mn);
        const float p0 = __expf(sv0 - mn), p1 = __expf(sv1 - mn), p2 = __expf(sv2 - mn), p3 = __expf(sv3 - mn);
        bf16_t* pr = Ps + (mt * 16 + fq * 4 + j) * 72 + fr;
        pr[0] = f2bf(p0); pr[16] = f2bf(p1); pr[32] = f2bf(p2); pr[48] = f2bf(p3);
        const float rsum = sum16(p0 + p1 + p2 + p3);
        ls[mt][j] = ls[mt][j] * alpha + rsum;
        m[mt][j] = mn;
#pragma unroll
        for (int nt = 0; nt < 4; ++nt) o[mt][nt][j] *= alpha;
      }
    }
    __builtin_amdgcn_wave_barrier();
#pragma unroll
    for (int ks = 0; ks < 2; ++ks) {
      bf16x8 pa[2];
#pragma unroll
      for (int mt = 0; mt < 2; ++mt) pa[mt] = *(const bf16x8*)(Ps + (mt * 16 + fr) * 72 + ks * 32 + fq * 8);
#pragma unroll
      for (int nt = 0; nt < 4; ++nt) {
        bf16x8 vb = *(const bf16x8*)(Vt + (nt * 16 + fr) * 72 + ks * 32 + fq * 8);
#pragma unroll
        for (int mt = 0; mt < 2; ++mt) o[mt][nt] = MFMA(pa[mt], vb, o[mt][nt]);
      }
    }
    __builtin_amdgcn_wave_barrier();
  }
#pragma unroll
  for (int mt = 0; mt < 2; ++mt) {
    const int qi0 = (2 * w + mt) * 16;
#pragma unroll
    for (int j = 0; j < 4; ++j) {
      const size_t r = rowq0 + qi0 + fq * 4 + j;
      const float inv = frcp(ls[mt][j]);
#pragma unroll
      for (int nt = 0; nt < 4; ++nt) {
        const int dc = nt * 16 + fr;
        const float gt = bf2f(p.PA[r * 1024 + 640 + head * 64 + dc]);
        p.PA[r * 1024 + head * 64 + dc] = f2bf(o[mt][nt][j] * inv * siluf_(gt));
      }
    }
  }
  __syncthreads();
}

#ifndef PROBE_DUP
#define PROBE_DUP 0
#endif
__device__ __forceinline__ void phase_probe(const Params& p, int l, unsigned char* smem) {
  if (PROBE_DUP == 1) { for (int t = blockIdx.x; t < 256; t += gridDim.x) { if (t < 128) rwkv_tile<false>(p, l, t, smem); else rwkv_tile<true>(p, l, t, smem); } }
  if (PROBE_DUP == 2) { for (int t = blockIdx.x; t < 48; t += gridDim.x) ssd_tile(p, l, t, smem); }
}
__device__ __forceinline__ void phase_mixers(const Params& p, int l, unsigned char* smem) {
  const int natt = (l == 0) ? 816 : 768;
  const int bid = blockIdx.x, G = gridDim.x;
  if (G == 512) {
    if (bid < 128) {
      __builtin_amdgcn_s_setprio(3);
      rwkv_tile<false>(p, l, bid, smem);
      __builtin_amdgcn_s_setprio(0);
    } else if (bid < 256) {
      __builtin_amdgcn_s_setprio(3);
      rwkv_tile<true>(p, l, bid, smem);
      __builtin_amdgcn_s_setprio(0);
    } else if (bid < 304) {
      __builtin_amdgcn_s_setprio(2);
      ssd_tile(p, l, bid - 256, smem);
      __builtin_amdgcn_s_setprio(0);
    }
    int* tsl = (int*)(smem + 73728);
    const int tid = launder(threadIdx.x);
    if (l == 0) {
      for (;;) {
        __syncthreads();
        if (tid == 0) *tsl = (int)atomicAdd(&p.ctrs[2], 1u);
        __syncthreads();
        const int t = *tsl;
        if (t >= 1440) break;
        deferred_transpose(p, t, smem);
      }
    }
    for (;;) {
      __syncthreads();
      if (tid == 0) *tsl = (int)atomicAdd(&p.ctrs[l], 1u);
      __syncthreads();
      const int t = *tsl;
      if (t >= natt) break;
      attn_tile(p, l, t, smem);
    }
    for (;;) {
      __syncthreads();
      if (tid == 0) *tsl = (int)atomicAdd(&p.ctrs[4 + l], 1u);
      __syncthreads();
      const int j = *tsl;
      if (j >= 136 * 5) break;
      gemm_late_tile(p, l, j / 5, 16 + j % 5, smem);
    }
  } else {
    if (l == 0) for (int t = bid; t < 1440; t += G) deferred_transpose(p, t, smem);
    for (int t = bid; t < 136 * 5; t += G) gemm_late_tile(p, l, t / 5, 16 + t % 5, smem);
    const int total = 304 + natt;
    for (int t = bid; t < total; t += G) {
      if (t < 128) rwkv_tile<false>(p, l, t, smem);
      else if (t < 256) rwkv_tile<true>(p, l, t, smem);
      else if (t < 304) ssd_tile(p, l, t - 256, smem);
      else attn_tile(p, l, t - 304, smem);
    }
  }
}

__device__ __forceinline__ void phase_finish(const Params& p, int l) {
  const int tid = launder(threadIdx.x), lane = tid & 63, w = tid >> 6;
  bf16_t* mix = p.hbuf;
  const int cg_ = lane * 4, hh4 = lane >> 4;
  const float* mu0 = p.rwkv_mu + (size_t)(l * 2) * 1024 + cg_;
  const float* mu1 = mu0 + 1024;
  const float4 m0r = *(const float4*)mu0, m1r = *(const float4*)mu1;
  const float4 m0k = *(const float4*)(mu0 + 256), m1k = *(const float4*)(mu1 + 256);
  const float4 m0v = *(const float4*)(mu0 + 512), m1v = *(const float4*)(mu1 + 512);
  const float4 rk4 = *(const float4*)(p.rwkv_r_k + l * 256 + hh4 * 64 + (cg_ & 63));
  const float4 lw4 = *(const float4*)(p.rwkv_ln_w + l * 256 + cg_), lb4 = *(const float4*)(p.rwkv_ln_b + l * 256 + cg_);
  const int cs_ = lane * 6;
  const float2 nw0 = *(const float2*)(p.ssm_norm_w + l * 384 + cs_), nw1 = *(const float2*)(p.ssm_norm_w + l * 384 + cs_ + 2), nw2 = *(const float2*)(p.ssm_norm_w + l * 384 + cs_ + 4);
  const float dsk0 = p.ssm_d[l * 6 + (cs_ >> 6)], dsk1 = p.ssm_d[l * 6 + ((cs_ + 2) >> 6)], dsk2 = p.ssm_d[l * 6 + ((cs_ + 4) >> 6)];
  for (int t = blockIdx.x; t < TOK / 4; t += gridDim.x) {
    const int r = t * 4 + w, pp = r % TPB;
    if (l == 1 && pp < 256) continue;
    const bool isc = pp < 256;
    const int slo = isc ? 0 : 256, shi = isc ? 255 : 4351;
    const bool hp = pp > slo, hn = pp < shi;
    const unsigned* a32 = (const unsigned*)(p.PA + (size_t)r * 1024 + lane * 6);
    const unsigned at0 = a32[0], at1 = a32[1], at2 = a32[2];
    const uint2 ya = *(const uint2*)(p.yR + (size_t)r * 256 + cg_);
    const uint2 yb = *(const uint2*)(p.yR + ((size_t)TOK + r) * 256 + cg_);
    const bf16_t* pr = p.PR + (size_t)r * 1024 + cg_;
    const uint2 z2 = make_uint2(0u, 0u);
    const uint2 rc = *(const uint2*)pr, kc = *(const uint2*)(pr + 256), vc = *(const uint2*)(pr + 512);
    const uint2 rp = hp ? *(const uint2*)(pr - 1024) : z2, kp = hp ? *(const uint2*)(pr + 256 - 1024) : z2, vp = hp ? *(const uint2*)(pr + 512 - 1024) : z2;
    const uint2 rn = hn ? *(const uint2*)(pr + 1024) : z2, kn = hn ? *(const uint2*)(pr + 256 + 1024) : z2, vn = hn ? *(const uint2*)(pr + 512 + 1024) : z2;
    const uint2 g2 = *(const uint2*)(p.PG + (size_t)r * 640 + cg_);
    const unsigned* s0 = (const unsigned*)(p.yS + (size_t)r * 384 + cs_);
    const unsigned* s1 = (const unsigned*)(p.yS + ((size_t)TOK + r) * 384 + cs_);
    const unsigned* xs32 = (const unsigned*)(p.PS + (size_t)r * 912 + cs_);
    const unsigned* z32 = (const unsigned*)(p.PG + (size_t)r * 640 + 256 + cs_);
    const unsigned sa0 = s0[0], sa1 = s0[1], sa2 = s0[2], sb0 = s1[0], sb1 = s1[1], sb2 = s1[2];
    const unsigned xa0 = xs32[0], xa1 = xs32[1], xa2 = xs32[2], za0 = z32[0], za1 = z32[1], za2 = z32[2];
    {
      unsigned* d32 = (unsigned*)(mix + (size_t)r * 1024 + lane * 6);
      d32[0] = at0; d32[1] = at1; d32[2] = at2;
    }
    {
      float y[4] = {blo(ya.x) + blo(yb.x), bhi(ya.x) + bhi(yb.x), blo(ya.y) + blo(yb.y), bhi(ya.y) + bhi(yb.y)};
      const float sm = sum16(y[0] + y[1] + y[2] + y[3]);
      const float mean = sm * (1.f / 64.f);
      float vq = 0.f;
#pragma unroll
      for (int e = 0; e < 4; ++e) { y[e] -= mean; vq += y[e] * y[e]; }
      vq = sum16(vq);
      const float rstd = rsqrtf(vq * (1.f / 64.f) + 64e-5f);
      const float rs0 = blo(rc.x) + m0r.x * (blo(rp.x) - blo(rc.x)) + m1r.x * (blo(rn.x) - blo(rc.x));
      const float rs1 = bhi(rc.x) + m0r.y * (bhi(rp.x) - bhi(rc.x)) + m1r.y * (bhi(rn.x) - bhi(rc.x));
      const float rs2 = blo(rc.y) + m0r.z * (blo(rp.y) - blo(rc.y)) + m1r.z * (blo(rn.y) - blo(rc.y));
      const float rs3 = bhi(rc.y) + m0r.w * (bhi(rp.y) - bhi(rc.y)) + m1r.w * (bhi(rn.y) - bhi(rc.y));
      const float ks0 = blo(kc.x) + m0k.x * (blo(kp.x) - blo(kc.x)) + m1k.x * (blo(kn.x) - blo(kc.x));
      const float ks1 = bhi(kc.x) + m0k.y * (bhi(kp.x) - bhi(kc.x)) + m1k.y * (bhi(kn.x) - bhi(kc.x));
      const float ks2 = blo(kc.y) + m0k.z * (blo(kp.y) - blo(kc.y)) + m1k.z * (blo(kn.y) - blo(kc.y));
      const float ks3 = bhi(kc.y) + m0k.w * (bhi(kp.y) - bhi(kc.y)) + m1k.w * (bhi(kn.y) - bhi(kc.y));
      const float vs0 = blo(vc.x) + m0v.x * (blo(vp.x) - blo(vc.x)) + m1v.x * (blo(vn.x) - blo(vc.x));
      const float vs1 = bhi(vc.x) + m0v.y * (bhi(vp.x) - bhi(vc.x)) + m1v.y * (bhi(vn.x) - bhi(vc.x));
      const float vs2 = blo(vc.y) + m0v.z * (blo(vp.y) - blo(vc.y)) + m1v.z * (blo(vn.y) - blo(vc.y));
      const float vs3 = bhi(vc.y) + m0v.w * (bhi(vp.y) - bhi(vc.y)) + m1v.w * (bhi(vn.y) - bhi(vc.y));
      const float dot = sum16(rs0 * ks0 * rk4.x + rs1 * ks1 * rk4.y + rs2 * ks2 * rk4.z + rs3 * ks3 * rk4.w);
      const float o0 = (y[0] * rstd * lw4.x + lb4.x + dot * vs0) * siluf_(blo(g2.x));
      const float o1 = (y[1] * rstd * lw4.y + lb4.y + dot * vs1) * siluf_(bhi(g2.x));
      const float o2 = (y[2] * rstd * lw4.z + lb4.z + dot * vs2) * siluf_(blo(g2.y));
      const float o3 = (y[3] * rstd * lw4.w + lb4.w + dot * vs3) * siluf_(bhi(g2.y));
      uint2 ov;
      ov.x = pack2(o0, o1);
      ov.y = pack2(o2, o3);
      *(uint2*)(mix + (size_t)r * 1024 + 384 + cg_) = ov;
    }
    {
      const float y0 = (blo(sa0) + blo(sb0) + dsk0 * blo(xa0)) * siluf_(blo(za0));
      const float y1 = (bhi(sa0) + bhi(sb0) + dsk0 * bhi(xa0)) * siluf_(bhi(za0));
      const float y2 = (blo(sa1) + blo(sb1) + dsk1 * blo(xa1)) * siluf_(blo(za1));
      const float y3 = (bhi(sa1) + bhi(sb1) + dsk1 * bhi(xa1)) * siluf_(bhi(za1));
      const float y4 = (blo(sa2) + blo(sb2) + dsk2 * blo(xa2)) * siluf_(blo(za2));
      const float y5 = (bhi(sa2) + bhi(sb2) + dsk2 * bhi(xa2)) * siluf_(bhi(za2));
      float sq = sum16(y0 * y0 + y1 * y1 + y2 * y2 + y3 * y3 + y4 * y4 + y5 * y5);
      sq += __shfl_xor(sq, 16);
      const float rstd = rsqrtf(sq * (1.f / 192.f) + 1e-5f);
      unsigned* dd = (unsigned*)(mix + (size_t)r * 1024 + 640 + cs_);
      dd[0] = pack2(y0 * rstd * nw0.x, y1 * rstd * nw0.y);
      dd[1] = pack2(y2 * rstd * nw1.x, y3 * rstd * nw1.y);
      dd[2] = pack2(y4 * rstd * nw2.x, y5 * rstd * nw2.y);
    }
  }
}

#define XB_TMO      128
#define XB_XCNT(j)  (256  + 64 * (j))
#define XB_XSUB(j)  (1280 + 64 * (j))
#define XB_XGEN(j)  (2304 + 64 * (j))
#define XB_TOP      3328
#define XB_TOPGEN   3392
#define XCD_BAR_WORDS 3456
#define XB_SPIN_CAP (1u << 18)
#define LAS __attribute__((address_space(3)))

__device__ __forceinline__ unsigned xb_ld(unsigned* p)              { return __hip_atomic_load(p, __ATOMIC_RELAXED, __HIP_MEMORY_SCOPE_AGENT); }
__device__ __forceinline__ unsigned xb_add(unsigned* p, unsigned v) { return __hip_atomic_fetch_add(p, v, __ATOMIC_RELAXED, __HIP_MEMORY_SCOPE_AGENT); }
__device__ __forceinline__ unsigned xb_xcc_id() { return (unsigned)__builtin_amdgcn_s_getreg((3 << 11) | 20) & 0xFu; }
#define XB_SPIN(cond, bar) do { unsigned _sp = 0; while (cond) { __builtin_amdgcn_s_sleep(1); \
    if ((++_sp & 255u) == 0u) { if (xb_ld(&(bar)[XB_TMO])) break; if (_sp > XB_SPIN_CAP) { atomicAdd(&(bar)[XB_TMO], 1u); break; } } } } while (0)

struct XcdBarrier {
    unsigned* bar; unsigned x;
    volatile LAS unsigned* st;
};

__device__ __forceinline__ XcdBarrier xcd_barrier_post(unsigned* bar, volatile LAS unsigned* st) {
    XcdBarrier b; b.bar = bar; b.x = xb_xcc_id(); b.st = st;
    if (threadIdx.x == 0) (void)xb_add(&bar[XB_XCNT(b.x)], 1u);
    return b;
}
__device__ __forceinline__ void xcd_barrier_complete(unsigned* bar, unsigned x, unsigned& nloc, unsigned& nx) {
    const unsigned G = gridDim.x * gridDim.y * gridDim.z;
    unsigned sum, cnt, mine, sp = 0u;
    for (;;) {
        sum = 0u; cnt = 0u; mine = 0u;
#pragma unroll
        for (unsigned j = 0; j < 16; ++j) { const unsigned c = xb_ld(&bar[XB_XCNT(j)]); sum += c; cnt += (c > 0u) ? 1u : 0u; mine = (j == x) ? c : mine; }
        if (sum == G) break;
        __builtin_amdgcn_s_sleep(1);
        if ((++sp & 255u) == 0u) { if (xb_ld(&bar[XB_TMO])) break; if (sp > XB_SPIN_CAP) { atomicAdd(&bar[XB_TMO], 1u); break; } }
    }
    nloc = mine > 0u ? mine : 1u; nx = cnt > 0u ? cnt : 1u;
}

__device__ __forceinline__ void xcd_barrier(const XcdBarrier& b) {
    asm volatile("s_waitcnt vmcnt(0)" ::: "memory");
    __syncthreads();
    if (threadIdx.x == 0) {
        unsigned* bar = b.bar;
        __builtin_amdgcn_s_waitcnt(0);
        unsigned nloc = b.st[0], nx = b.st[1];
        if (nloc == 0u) { xcd_barrier_complete(bar, b.x, nloc, nx); b.st[0] = nloc; b.st[1] = nx; }
        const unsigned old = xb_add(&bar[XB_XSUB(b.x)], 1u);
        const unsigned gen = old / nloc;
        if (old + 1u == (gen + 1u) * nloc) {
            __builtin_amdgcn_fence(__ATOMIC_RELEASE, "agent");
            asm volatile("s_waitcnt vmcnt(0)" ::: "memory");
            const unsigned og = xb_add(&bar[XB_TOP], 1u);
            const unsigned tg = og / nx;
            if (og + 1u == (tg + 1u) * nx) xb_add(&bar[XB_TOPGEN], 1u);
            else XB_SPIN(xb_ld(&bar[XB_TOPGEN]) == tg, bar);
            __builtin_amdgcn_fence(__ATOMIC_ACQUIRE, "agent");
            xb_add(&bar[XB_XGEN(b.x)], 1u);
            asm volatile("s_waitcnt vmcnt(0)" ::: "memory");
        } else {
            XB_SPIN(xb_ld(&bar[XB_XGEN(b.x)]) == gen, bar);
            __builtin_amdgcn_fence(__ATOMIC_ACQUIRE, "agent");
            asm volatile("s_waitcnt vmcnt(0)" ::: "memory");
        }
    }
    __syncthreads();
}


__global__ void __launch_bounds__(NTHREADS, LBW) mega(Params p, int ph_lo, int ph_hi) {
  extern __shared__ __attribute__((aligned(16))) unsigned char smem[];
  volatile LAS unsigned* xst = (volatile LAS unsigned*)(smem + LDS_BYTES - 16);
  XcdBarrier xb;
  xb.bar = p.bar; xb.x = 0; xb.st = xst;
  if (ph_hi - ph_lo > 1) {
    if (threadIdx.x == 0) { xst[0] = 0u; xst[1] = 0u; }
    __syncthreads();
    xb = xcd_barrier_post(p.bar, xst);
  }
  for (int ph = ph_lo; ph < ph_hi; ++ph) {
    if (ph > ph_lo) {
      if (ph_hi > 1000) cg::this_grid().sync();
      xcd_barrier(xb);
    }
#ifndef TEST_PH
#define TEST_PH -1
#endif
    if (ph == 0) {
      if (PROBE_DUP == 4) { phase_setup(p, smem); cg::this_grid().sync(); }
      if (TEST_PH < 0 || TEST_PH == 0) phase_setup(p, smem);
    }
    else if (ph == NPHASES - 1) { if (TEST_PH < 0 || TEST_PH == 6) phase_final(p); }
    else {
      const int l = (ph - 1) / 7, s = (ph - 1) % 7;
      if (s == 0) { if (TEST_PH < 0 || TEST_PH == 1) phase_norm(p, l); }
      else if (s == 1) {
        if (PROBE_DUP == 3) { phase_inproj(p, l, smem); cg::this_grid().sync(); }
        if (TEST_PH < 0 || TEST_PH == 2) phase_inproj(p, l, smem);
      }
      else if (s == 2) {
        if (PROBE_DUP == 5) { phase_rwkvprep(p, l, smem); cg::this_grid().sync(); }
        if (TEST_PH < 0 || TEST_PH == 10) phase_rwkvprep(p, l, smem);
      }
      else if (s == 3) {
        if (PROBE_DUP == 1 || PROBE_DUP == 2) { phase_probe(p, l, smem); cg::this_grid().sync(); }
        if (TEST_PH < 0 || TEST_PH == 3 || (TEST_PH >= 7 && TEST_PH <= 9)) phase_mixers(p, l, smem);
      }
      else if (s == 4) { phase_rwkvfix(p); }
      else if (s == 5) { if (TEST_PH < 0 || TEST_PH == 4) phase_finish(p, l); }
      else { if (TEST_PH < 0 || TEST_PH == 5) phase_outproj(p, l, smem); }
    }
  }
}

extern "C" void kernel_launch(void* const* d_in, const int* in_sizes, int n_in, void* d_out, int out_size, void* d_ws,
                              size_t ws_size, hipStream_t stream) {
  static int grid_blocks = 0;
  if (!grid_blocks) {
    int dev = 0, cus = 0, per_cu = 0;
    hipGetDevice(&dev);
    hipDeviceGetAttribute(&cus, hipDeviceAttributeMultiprocessorCount, dev);
    hipFuncSetAttribute((const void*)mega, hipFuncAttributeMaxDynamicSharedMemorySize, LDS_BYTES);
    hipOccupancyMaxActiveBlocksPerMultiprocessor(&per_cu, (const void*)mega, NTHREADS, LDS_BYTES);
    if (per_cu < 1) per_cu = 1;
    if (per_cu > 2) per_cu = 2;
    grid_blocks = cus * per_cu;
  }
  Params p{};
  const float** fp = (const float**)&p;
  for (int i = 0; i < 27; ++i) fp[i] = (const float*)d_in[i];
  p.out = (float*)d_out;
  unsigned char* ws = (unsigned char*)d_ws;
  size_t off = 0;
  auto take = [&](size_t bytes) { unsigned char* r = ws + off; off += (bytes + 255) & ~(size_t)255; return r; };
  p.WtIn = (bf16_t*)take((size_t)2 * 3712 * 1024 * 2);
  p.WtOut = (bf16_t*)take((size_t)2 * 1024 * 1024 * 2);
  p.WupT = (bf16_t*)take((size_t)65536 * 2);
  p.AupT = (bf16_t*)take((size_t)65536 * 2);
  p.rope = (float*)take(1024 * 2 * 4);
  p.mod = (float*)take((size_t)2 * 5 * 3072 * 4);
  p.ctxcur = (float*)take((size_t)4 * 256 * 1024 * 4);
  p.PRE = (bf16_t*)take((size_t)3 * TOK * 512 * 2);
  p.hbuf = p.PRE;
  p.PA = (bf16_t*)take((size_t)TOK * 1024 * 2);
  p.PR = (bf16_t*)take((size_t)TOK * 1024 * 2);
  p.PG = (bf16_t*)take((size_t)TOK * 640 * 2);
  p.PS = (bf16_t*)take((size_t)TOK * 912 * 2);
  p.yR = (bf16_t*)take((size_t)2 * TOK * 256 * 2);
  p.HALO = (bf16_t*)take((size_t)512 * 2 * 896 * 2);
  p.DTC = (float2*)take((size_t)12 * TOK * 8);
  p.GID = (bf16_t*)take((size_t)8 * NSEG1 * 256 * 2);
  p.SMID = (float*)take((size_t)32 * 64 * 64 * 4);
  p.ctrs = (unsigned*)take(256);
  p.bar = (unsigned*)take((size_t)XCD_BAR_WORDS * 4);
  p.rstd = (float*)take((size_t)TOK * 4);
  p.yS = (bf16_t*)take((size_t)2 * TOK * 384 * 2);
  if (off > ws_size) { fprintf(stderr, "workspace too small: need %zu have %zu\n", off, ws_size); return; }
#if ONE_LAUNCH
  hipMemsetAsync(p.bar, 0, (size_t)XCD_BAR_WORDS * 4, stream);
  int lo = 0, hi = NPHASES;
  void* args[] = {&p, &lo, &hi};
  hipError_t e = hipLaunchCooperativeKernel((const void*)mega, dim3(grid_blocks), dim3(NTHREADS), args, LDS_BYTES, stream);
  if (e != hipSuccess) fprintf(stderr, "cooperative launch failed: %s (grid %d)\n", hipGetErrorString(e), grid_blocks);
#else
  for (int ph = 0; ph < NPHASES; ++ph)
    hipLaunchKernelGGL(mega, dim3(grid_blocks), dim3(NTHREADS), LDS_BYTES, stream, p, ph, ph + 1);
#endif
}
```
